# Optimizing an MI355X kernel written in HIP

```python
import jax, jax.numpy as jnp
from jax import lax
import numpy as np

D_MODEL = 1024
BATCH = 8
SEQ = 2048
DEPTH = 1
DEC_BATCH = 128
DEC_SEQ = 1
PAST_LEN = 16384
PAGE_SIZE = 128

HEAD_SIZE = 64
N_HEADS = D_MODEL // HEAD_SIZE
DECAY_LORA = 64
ICLR_LORA = 64
GATE_LORA = 128
CONV_WIDTH = 3
D_FF = ((8 * D_MODEL // 3 + 127) // 128) * 128
PLE_DIM = 256
SHIFT_COLS = 3 * D_MODEL + DECAY_LORA + ICLR_LORA + GATE_LORA
CONV_COLS = 3 * D_MODEL
GATE_COLS = 2 * D_MODEL
IN_COLS = SHIFT_COLS + CONV_COLS + GATE_COLS
RMS_EPS = 1e-6
GN_EPS = 64e-5
NORM_EPS = 1e-12

kernel_name = "rwkv7_shortconv_gated_hybrid_step"


def rmsnorm(x, g):
    xf = x.astype(jnp.float32)
    y = xf * lax.rsqrt(jnp.mean(xf * xf, axis=-1, keepdims=True) + RMS_EPS) * g.astype(jnp.float32)
    return y.astype(x.dtype)


def swiglu(h, w_gate, w_up, w_down):
    return (jax.nn.silu(h @ w_gate) * (h @ w_up)) @ w_down


def split_cols(z, sizes):
    idx = np.cumsum(sizes)[:-1].tolist()
    return jnp.split(z, idx, axis=-1)


def wkv_step(S, inp):
    r_t, decay_t, k_t, v_t, kk_t, b_t = inp
    sa = jnp.einsum('bhvk,bhk->bhv', S, kk_t)
    S = (S * decay_t[:, :, None, :]
         - sa[..., None] * b_t[:, :, None, :]
         + v_t[..., None] * k_t[:, :, None, :])
    y = jnp.einsum('bhvk,bhk->bhv', S, r_t)
    return S, y


def rwkv7_branch(zs, S0, w_decay_up, decay_bias, w_iclr_up, iclr_bias, w_gate_up,
                 k_k, k_a, r_k, gn_w, gn_b):
    B, T, _ = zs.shape
    r, k, v, wd, ad, gd = split_cols(zs, [D_MODEL, D_MODEL, D_MODEL, DECAY_LORA, ICLR_LORA, GATE_LORA])
    f32 = jnp.float32
    w = -jax.nn.softplus(-(decay_bias + jnp.tanh(wd) @ w_decay_up).astype(f32)) - 0.5
    decay = jnp.exp(-jnp.exp(w))
    a = jax.nn.sigmoid((iclr_bias + ad @ w_iclr_up).astype(f32))
    g = jax.nn.sigmoid(gd) @ w_gate_up
    heads = lambda t: t.astype(f32).reshape(B, T, N_HEADS, HEAD_SIZE)
    kk = heads(k * k_k)
    kk = kk / jnp.maximum(jnp.linalg.norm(kk, axis=-1, keepdims=True), NORM_EPS)
    k_mod = k.astype(f32) * (1.0 + (a - 1.0) * k_a.astype(f32))
    rh, kh, vh, ah, dh = heads(r), heads(k_mod), heads(v), heads(a), heads(decay)
    bh = kk * ah
    tm = lambda t: jnp.moveaxis(t, 1, 0)
    S_new, ys = lax.scan(wkv_step, S0.astype(f32), (tm(rh), tm(dh), tm(kh), tm(vh), tm(kk), tm(bh)))
    y = jnp.moveaxis(ys, 0, 1)
    mean = jnp.mean(y, axis=-1, keepdims=True)
    var = jnp.mean(jnp.square(y - mean), axis=-1, keepdims=True)
    y = (y - mean) * lax.rsqrt(var + GN_EPS)
    y = y.reshape(B, T, D_MODEL) * gn_w.astype(f32) + gn_b.astype(f32)
    bonus = jnp.sum(rh * kh * r_k.astype(f32), axis=-1, keepdims=True) * vh
    y = (y + bonus.reshape(B, T, D_MODEL)).astype(zs.dtype) * g
    return y, S_new


def short_conv_branch(zc, conv0, conv_w):
    gb, gc, u = split_cols(zc, [D_MODEL, D_MODEL, D_MODEL])
    T = zc.shape[1]
    cu = gc * u
    full = jnp.concatenate([conv0.astype(cu.dtype), cu], axis=1)
    y = full[:, 0:T] * conv_w[0]
    for j in range(1, CONV_WIDTH):
        y = y + full[:, j:j + T] * conv_w[j]
    return gb * y, full[:, T:]


def decoder_layer(x, p, S0, shift0, conv0,
                  norm_ffn1, w_ffn1_gate, w_ffn1_up, w_ffn1_down,
                  norm_mix, w_in, mu_shift, w_decay_up, decay_bias, w_iclr_up, iclr_bias,
                  w_gate_up, k_k, k_a, r_k, gn_w, gn_b, conv_w, w_out,
                  norm_ffn2, w_ffn2_gate, w_ffn2_up, w_ffn2_down,
                  norm_ple, w_ple_gate, w_ple_proj):
    x = x + 0.5 * swiglu(rmsnorm(x, norm_ffn1), w_ffn1_gate, w_ffn1_up, w_ffn1_down)
    h = rmsnorm(x, norm_mix)
    z = h @ w_in
    z_sh, z_conv, z_gate = split_cols(z, [SHIFT_COLS, CONV_COLS, GATE_COLS])
    z_prev = jnp.concatenate([shift0[:, None, :].astype(z_sh.dtype), z_sh[:, :-1]], axis=1)
    zs = z_sh + mu_shift * (z_prev - z_sh)
    new_shift = z_sh[:, -1]
    y_a, S_new = rwkv7_branch(zs, S0, w_decay_up, decay_bias, w_iclr_up, iclr_bias, w_gate_up,
                              k_k, k_a, r_k, gn_w, gn_b)
    y_b, conv_new = short_conv_branch(z_conv, conv0, conv_w)
    g_a, g_b = split_cols(jax.nn.sigmoid(z_gate), [D_MODEL, D_MODEL])
    x = x + (g_a * y_a + g_b * y_b) @ w_out
    x = x + 0.5 * swiglu(rmsnorm(x, norm_ffn2), w_ffn2_gate, w_ffn2_up, w_ffn2_down)
    x = x + jax.nn.sigmoid(rmsnorm(x, norm_ple) @ w_ple_gate) * (p @ w_ple_proj)
    return x, S_new, new_shift, conv_new


def setup_inputs(seed: int = 0) -> dict:
    key = jax.random.key(seed)
    ks = iter(jax.random.split(key, 48))
    f32 = jnp.float32
    nrm = lambda shape, scale: jax.random.normal(next(ks), shape, f32) * scale
    gain = lambda shape: 1.0 + 0.05 * jax.random.normal(next(ks), shape, f32)
    L, D = DEPTH, D_MODEL
    return {
        "x_prompt": nrm((BATCH, SEQ, D), 1.0),
        "x_sample": nrm((DEC_BATCH, DEC_SEQ, D), 1.0),
        "p_prompt": nrm((DEPTH, BATCH, SEQ, PLE_DIM), 1.0),
        "p_sample": nrm((DEPTH, DEC_BATCH, DEC_SEQ, PLE_DIM), 1.0),
        "state_wkv": nrm((L, DEC_BATCH, N_HEADS, HEAD_SIZE, HEAD_SIZE), 0.1),
        "state_shift": nrm((L, DEC_BATCH, SHIFT_COLS), 1.0),
        "state_conv": nrm((L, DEC_BATCH, CONV_WIDTH - 1, D), 0.5),
        "norm_ffn1": gain((L, D)),
        "w_ffn1_gate": nrm((L, D, D_FF), D ** -0.5),
        "w_ffn1_up": nrm((L, D, D_FF), D ** -0.5),
        "w_ffn1_down": nrm((L, D_FF, D), D_FF ** -0.5),
        "norm_mix": gain((L, D)),
        "w_in": nrm((L, D, IN_COLS), D ** -0.5),
        "mu_shift": jax.random.uniform(next(ks), (L, SHIFT_COLS), f32),
        "w_decay_up": nrm((L, DECAY_LORA, D), DECAY_LORA ** -0.5),
        "decay_bias": nrm((L, D), 0.5),
        "w_iclr_up": nrm((L, ICLR_LORA, D), ICLR_LORA ** -0.5),
        "iclr_bias": nrm((L, D), 0.1),
        "w_gate_up": nrm((L, GATE_LORA, D), GATE_LORA ** -0.5),
        "k_k": 0.85 + nrm((L, D), 0.05),
        "k_a": gain((L, D)),
        "r_k": nrm((L, N_HEADS, HEAD_SIZE), 0.1),
        "gn_w": gain((L, D)),
        "gn_b": nrm((L, D), 0.02),
        "conv_w": nrm((L, CONV_WIDTH, D), CONV_WIDTH ** -0.5),
        "w_out": nrm((L, D, D), D ** -0.5),
        "norm_ffn2": gain((L, D)),
        "w_ffn2_gate": nrm((L, D, D_FF), D ** -0.5),
        "w_ffn2_up": nrm((L, D, D_FF), D ** -0.5),
        "w_ffn2_down": nrm((L, D_FF, D), D_FF ** -0.5),
        "norm_ple": gain((L, D)),
        "w_ple_gate": nrm((L, D, D), D ** -0.5),
        "w_ple_proj": nrm((L, PLE_DIM, D), PLE_DIM ** -0.5),
        "norm_final": gain((D,)),
    }


def reference(x_prompt, x_sample, p_prompt, p_sample, state_wkv, state_shift, state_conv,
              norm_ffn1, w_ffn1_gate, w_ffn1_up, w_ffn1_down,
              norm_mix, w_in, mu_shift, w_decay_up, decay_bias, w_iclr_up, iclr_bias,
              w_gate_up, k_k, k_a, r_k, gn_w, gn_b, conv_w, w_out,
              norm_ffn2, w_ffn2_gate, w_ffn2_up, w_ffn2_down,
              norm_ple, w_ple_gate, w_ple_proj, norm_final):
    xp, xs = x_prompt, x_sample
    bp = x_prompt.shape[0]
    wkv_p, sh_p, cv_p, wkv_s, sh_s, cv_s = [], [], [], [], [], []
    for i in range(DEPTH):
        lw = (norm_ffn1[i], w_ffn1_gate[i], w_ffn1_up[i], w_ffn1_down[i],
              norm_mix[i], w_in[i], mu_shift[i], w_decay_up[i], decay_bias[i], w_iclr_up[i], iclr_bias[i],
              w_gate_up[i], k_k[i], k_a[i], r_k[i], gn_w[i], gn_b[i], conv_w[i], w_out[i],
              norm_ffn2[i], w_ffn2_gate[i], w_ffn2_up[i], w_ffn2_down[i],
              norm_ple[i], w_ple_gate[i], w_ple_proj[i])
        S0p = jnp.zeros((bp, N_HEADS, HEAD_SIZE, HEAD_SIZE), state_wkv.dtype)
        sh0p = jnp.zeros((bp, SHIFT_COLS), state_shift.dtype)
        cv0p = jnp.zeros((bp, CONV_WIDTH - 1, D_MODEL), state_conv.dtype)
        xp, Sp, shp, cvp = decoder_layer(xp, p_prompt[i], S0p, sh0p, cv0p, *lw)
        xs, Ss, shs, cvs = decoder_layer(xs, p_sample[i], state_wkv[i], state_shift[i], state_conv[i], *lw)
        wkv_p.append(Sp.astype(state_wkv.dtype)); sh_p.append(shp.astype(state_shift.dtype)); cv_p.append(cvp.astype(state_conv.dtype))
        wkv_s.append(Ss.astype(state_wkv.dtype)); sh_s.append(shs.astype(state_shift.dtype)); cv_s.append(cvs.astype(state_conv.dtype))
    y_prompt = rmsnorm(xp, norm_final)
    y_sample = rmsnorm(xs, norm_final)
    new_wkv_prompt = jnp.stack(wkv_p, 0)
    new_shift_prompt = jnp.stack(sh_p, 0)
    new_conv_prompt = jnp.stack(cv_p, 0)
    new_wkv_sample = jnp.stack(wkv_s, 0)
    new_shift_sample = jnp.stack(sh_s, 0)
    new_conv_sample = jnp.stack(cv_s, 0)
    return (y_prompt, y_sample, new_wkv_prompt, new_shift_prompt, new_conv_prompt, new_wkv_sample, new_shift_sample, new_conv_sample)
```

```cpp
#include <hip/hip_runtime.h>
#include <cstdio>
#include <cstdint>
namespace pg8 {
#define PG8_LAS __attribute__((address_space(3)))
typedef unsigned short bf16_t;
typedef short bf16x8 __attribute__((ext_vector_type(8)));
typedef float f32x4 __attribute__((ext_vector_type(4)));
typedef unsigned u32x4 __attribute__((ext_vector_type(4)));
constexpr int BM = 256, BK = 64, HALF = 128, HTB = HALF * BK * 2  , STAGE_BYTES = 8 * HTB, NXCD = 8, WGM = 8;

__host__ __device__ __forceinline__ int lds_byte(int r, int c) { const int st = (r >> 4) * 2 + (c >> 5), rr = r & 15, cc = c & 31, ob = rr * 64 + cc * 2; return st * 1024 + (ob ^ (((ob >> 9) & 1) << 5)); }
__host__ __device__ __forceinline__ void stage_rc(int b, int& R, int& C) { const int st = b / 1024, sb = b % 1024, swz = sb ^ (((sb >> 9) & 1) << 5); R = (st >> 1) * 16 + swz / 64; C = (st & 1) * 32 + (swz % 64) / 2; }
__host__ __device__ __forceinline__ int perm32(int rho) { const int n = rho >> 4, i = rho & 15; return 8 * (i >> 2) + 4 * n + (i & 3); }

struct Unit { int pm, pn; };
struct Gemm { const bf16_t* A; const bf16_t* Bt; int M, N, K; };

struct StaticOrder {
    int nM, nN, nwg, G, c;
    __host__ __device__ void init(int M, int N, int G_, int c_) { nM = M / BM; nN = N / BM; nwg = nM * nN; G = G_; c = c_; }
    __host__ __device__ bool next(int i, Unit& u) const {
        const long L = (long)i * G + c; if (L >= nwg) return false;
        int wgid = (int)L; { const int q = nwg / NXCD, r = nwg % NXCD, xcd = wgid % NXCD, off = wgid / NXCD; wgid = (xcd < r ? xcd * (q + 1) : r * (q + 1) + (xcd - r) * q) + off; }
        const int nig = WGM * nN, gid = wgid / nig, fm = gid * WGM, gsz = (nM - fm) < WGM ? (nM - fm) : WGM;
        u.pm = fm + ((wgid % nig) % gsz); u.pn = (wgid % nig) / gsz; return true;
    }
    __device__ __forceinline__ void a_ready(const Unit&) const {}
    __device__ __forceinline__ void done(const Unit&) const {}
};


#define PG8_GAS __attribute__((address_space(1)))
constexpr int MP = 16640;
constexpr int MV = 16512;
constexpr int MPR = 16384;
constexpr int PM_LAST = 64;
constexpr int DM = 1024, FFN = 2816, NINC = 8448, SHC = 3328;
constexpr size_t O_SHP = 17432576, O_SHS = 25864192;

struct ChunkOrder {
    int nM, nN, nwg, G, c, chunk;
    __host__ __device__ void init(int nM_, int nN_, int G_, int c_, int chunk_) { nM = nM_; nN = nN_; nwg = nM * nN; G = G_; c = c_; chunk = chunk_; }
    __host__ __device__ bool next(int i, Unit& u) const {
        const long L = (long)i * G + c; if (L >= nwg) return false;
        int wgid = (int)L; { const int q = nwg / NXCD, r = nwg % NXCD, xcd = wgid % NXCD, off = wgid / NXCD; wgid = (xcd < r ? xcd * (q + 1) : r * (q + 1) + (xcd - r) * q) + off; }
        const int nig = WGM * nN, gid = wgid / nig, fm = gid * WGM, gsz = (nM - fm) < WGM ? (nM - fm) : WGM;
        const int lm = fm + ((wgid % nig) % gsz); u.pn = (wgid % nig) / gsz;
        u.pm = (lm >= 32) ? PM_LAST : (8 * (lm >> 2) + 4 * chunk + (lm & 3)); return true;
    }
    __device__ __forceinline__ void a_ready(const Unit&) const {}
    __device__ __forceinline__ void done(const Unit&) const {}
};

typedef __bf16 bf16x2_t __attribute__((ext_vector_type(2)));
__device__ __forceinline__ unsigned cvt_pk_bf16(float lo, float hi) { bf16x2_t v; v[0] = (__bf16)lo; v[1] = (__bf16)hi; return __builtin_bit_cast(unsigned, v); }
typedef unsigned u32x2 __attribute__((ext_vector_type(2)));
__device__ __forceinline__ float fsigmoid(float x) { return __builtin_amdgcn_rcpf(1.0f + __expf(-x)); }

__device__ __forceinline__ void row_scales(const PG8_GAS float* ssq, int pm, int wr, int fr, int fq, float (&sc)[2][4]) {
#pragma unroll
    for (int ai = 0; ai < 2; ++ai) {
#pragma unroll
        for (int m = 0; m < 4; ++m) { const PG8_GAS float* q = ssq + (size_t)(4 * fq) * MP + (pm * BM + ai * HALF + wr * 64 + m * 16 + fr); sc[ai][m] = (q[0] + q[MP]) + (q[2 * MP] + q[3 * MP]); }
#pragma unroll
        for (int m = 0; m < 4; ++m) { float p = sc[ai][m]; p += __shfl_xor(p, 16); p += __shfl_xor(p, 32); sc[ai][m] = __builtin_amdgcn_rsqf(p * (1.0f / 1024.0f) + 1e-6f); }
        asm volatile("" ::: "memory");
    }
}

struct EpiSwiglu {
    static constexpr bool PERM = true, AFTER_DRAIN = false;
    PG8_GAS bf16_t* O; const PG8_GAS float* ssq;
    __device__ __forceinline__ void operator()(const f32x4 (&acc)[2][2][4][2], const Unit& u, int wr, int wc, int fr, int fq) const {
        float sc[2][4];
        if (ssq) row_scales(ssq, u.pm, wr, fr, fq, sc);
        else {
#pragma unroll
            for (int ai = 0; ai < 2; ++ai)
#pragma unroll
                for (int m = 0; m < 4; ++m) sc[ai][m] = 1.0f; }
        const int col0 = u.pn * HALF + wc * 32 + 8 * fq;
#pragma unroll
        for (int ai = 0; ai < 2; ++ai)
#pragma unroll
            for (int m = 0; m < 4; ++m) {
                const int row = u.pm * BM + ai * HALF + wr * 64 + m * 16 + fr; const float s = sc[ai][m];
                const f32x4 g0 = acc[ai][0][m][0] * s, g1 = acc[ai][0][m][1] * s, u0 = acc[ai][1][m][0] * s, u1 = acc[ai][1][m][1] * s;
                f32x4 v0, v1;
#pragma unroll
                for (int j = 0; j < 4; ++j) { v0[j] = g0[j] * fsigmoid(g0[j]) * u0[j]; v1[j] = g1[j] * fsigmoid(g1[j]) * u1[j]; }
                u32x4 w; w.x = cvt_pk_bf16(v0[0], v0[1]); w.y = cvt_pk_bf16(v0[2], v0[3]); w.z = cvt_pk_bf16(v1[0], v1[1]); w.w = cvt_pk_bf16(v1[2], v1[3]);
                *(PG8_GAS u32x4*)(O + (size_t)row * FFN + col0) = w; }
    }
};

struct EpiRes {
    static constexpr bool PERM = false, AFTER_DRAIN = false;
    const PG8_GAS float* inP; const PG8_GAS float* inS; PG8_GAS float* X; PG8_GAS bf16_t* XB; PG8_GAS float* ssq; float alpha;
    __device__ __forceinline__ void operator()(const f32x4 (&acc)[2][2][4][2], const Unit& u, int wr, int wc, int fr, int fq) const {
        const bool lastt = (u.pm == PM_LAST);
        const PG8_GAS float* sbase = lastt ? inS - (size_t)MPR * DM : inP;
        const int col0 = u.pn * BM + wc * 32 + 4 * fq;
#pragma unroll
        for (int ai = 0; ai < 2; ++ai) {
            if (lastt && ai == 1) break;
#pragma unroll
            for (int m = 0; m < 4; ++m) {
                const int row = u.pm * BM + ai * HALF + wr * 64 + m * 16 + fr; const size_t off = (size_t)row * DM + col0;
                f32x4 xin[2][2];
#pragma unroll
                for (int bj = 0; bj < 2; ++bj)
#pragma unroll
                    for (int n = 0; n < 2; ++n) xin[bj][n] = *(const PG8_GAS f32x4*)(sbase + off + bj * HALF + n * 16);
                float q = 0.f;
#pragma unroll
                for (int bj = 0; bj < 2; ++bj)
#pragma unroll
                    for (int n = 0; n < 2; ++n) { const f32x4 xo = xin[bj][n] + acc[ai][bj][m][n] * alpha;
                        *(PG8_GAS f32x4*)(X + off + bj * HALF + n * 16) = xo;
                        u32x2 w; w.x = cvt_pk_bf16(xo[0], xo[1]); w.y = cvt_pk_bf16(xo[2], xo[3]); *(PG8_GAS u32x2*)(XB + off + bj * HALF + n * 16) = w;
                        q += (xo[0] * xo[0] + xo[1] * xo[1]) + (xo[2] * xo[2] + xo[3] * xo[3]); }
                q += __shfl_xor(q, 16); q += __shfl_xor(q, 32);
                if (fq == 0) ssq[(size_t)(4 * u.pn + wc) * MP + row] = q;
                if (m & 1) asm volatile("" ::: "memory"); }
        }
    }
};

struct EpiZ {
    static constexpr bool PERM = true, AFTER_DRAIN = false;
    PG8_GAS bf16_t* Z; const PG8_GAS float* ssq; PG8_GAS float* out; int chunk;
    __device__ __forceinline__ void operator()(const f32x4 (&acc)[2][2][4][2], const Unit& u, int wr, int wc, int fr, int fq) const {
        float sc[2][4]; row_scales(ssq, u.pm, wr, fr, fq, sc);
        const int lm = (u.pm == PM_LAST) ? 32 : (4 * (u.pm >> 3) + (u.pm & 3));
        const int col0 = u.pn * BM + wc * 32 + 8 * fq;
#pragma unroll
        for (int ai = 0; ai < 2; ++ai)
#pragma unroll
            for (int m = 0; m < 4; ++m) {
                const int rt = ai * HALF + wr * 64 + m * 16 + fr, lrow = lm * BM + rt, grow = u.pm * BM + rt; const float s = sc[ai][m];
                PG8_GAS bf16_t* zp = Z + (size_t)lrow * NINC + col0;
#pragma unroll
                for (int bj = 0; bj < 2; ++bj) { const f32x4 v0 = acc[ai][bj][m][0] * s, v1 = acc[ai][bj][m][1] * s;
                    u32x4 w; w.x = cvt_pk_bf16(v0[0], v0[1]); w.y = cvt_pk_bf16(v0[2], v0[3]); w.z = cvt_pk_bf16(v1[0], v1[1]); w.w = cvt_pk_bf16(v1[2], v1[3]);
                    *(PG8_GAS u32x4*)(zp + bj * HALF) = w; }
            }
    }
};

struct EpiPP {
    static constexpr bool PERM = true, AFTER_DRAIN = false;
    PG8_GAS bf16_t* O; int ldc;
    __device__ __forceinline__ void operator()(const f32x4 (&acc)[2][2][4][2], const Unit& u, int wr, int wc, int fr, int fq) const {
        const int col0 = u.pn * BM + wc * 32 + 8 * fq;
#pragma unroll
        for (int ai = 0; ai < 2; ++ai)
#pragma unroll
            for (int m = 0; m < 4; ++m) { PG8_GAS bf16_t* rowp = O + (size_t)(u.pm * BM + ai * HALF + wr * 64 + m * 16 + fr) * ldc + col0;
#pragma unroll
                for (int bj = 0; bj < 2; ++bj) { const f32x4 v0 = acc[ai][bj][m][0], v1 = acc[ai][bj][m][1];
                    u32x4 w; w.x = cvt_pk_bf16(v0[0], v0[1]); w.y = cvt_pk_bf16(v0[2], v0[3]); w.z = cvt_pk_bf16(v1[0], v1[1]); w.w = cvt_pk_bf16(v1[2], v1[3]);
                    *(PG8_GAS u32x4*)(rowp + bj * HALF) = w; } }
    }
};

struct EpiPle {
    static constexpr bool PERM = false, AFTER_DRAIN = false;
    PG8_GAS float* X; const PG8_GAS bf16_t* PP; const PG8_GAS float* ssq;
    __device__ __forceinline__ void operator()(const f32x4 (&acc)[2][2][4][2], const Unit& u, int wr, int wc, int fr, int fq) const {
        float sc[2][4]; row_scales(ssq, u.pm, wr, fr, fq, sc);
        const bool lastt = (u.pm == PM_LAST);
        const int col0 = u.pn * BM + wc * 32 + 4 * fq;
#pragma unroll
        for (int ai = 0; ai < 2; ++ai) {
            if (lastt && ai == 1) break;
#pragma unroll
            for (int m = 0; m < 4; ++m) {
                const int row = u.pm * BM + ai * HALF + wr * 64 + m * 16 + fr; const size_t off = (size_t)row * DM + col0; const float s = sc[ai][m];
                f32x4 xin[2][2]; u32x2 pp[2][2];
#pragma unroll
                for (int bj = 0; bj < 2; ++bj)
#pragma unroll
                    for (int n = 0; n < 2; ++n) { xin[bj][n] = *(const PG8_GAS f32x4*)(X + off + bj * HALF + n * 16); pp[bj][n] = *(const PG8_GAS u32x2*)(PP + off + bj * HALF + n * 16); }
#pragma unroll
                for (int bj = 0; bj < 2; ++bj)
#pragma unroll
                    for (int n = 0; n < 2; ++n) { const f32x4 a = acc[ai][bj][m][n] * s; const u32x2 p = pp[bj][n];
                        f32x4 pv; pv[0] = __uint_as_float(p.x << 16); pv[1] = __uint_as_float(p.x & 0xffff0000u); pv[2] = __uint_as_float(p.y << 16); pv[3] = __uint_as_float(p.y & 0xffff0000u);
                        f32x4 xo;
#pragma unroll
                        for (int j = 0; j < 4; ++j) xo[j] = xin[bj][n][j] + fsigmoid(a[j]) * pv[j];
                        *(PG8_GAS f32x4*)(X + off + bj * HALF + n * 16) = xo; }
                if (m & 1) asm volatile("" ::: "memory"); }
        }
    }
};

template <class Epi, class Sched, bool ALIGN_EPI = false, bool SP2 = false>
__device__ __forceinline__ void gemm_phase(PG8_LAS unsigned char* lds, const Gemm g, const Sched& S, const Epi& E) {
    int tid_ = threadIdx.x; asm volatile("" : "+v"(tid_));
    const int tid = tid_, wid = __builtin_amdgcn_readfirstlane(tid >> 6), lane = tid & 63, wr = wid >> 2, wc = wid & 3, fr = lane & 15, fq = lane >> 4;
    const int K = g.K, nt = K / BK;
    unsigned voffA[2], voffB[2];
#pragma unroll
    for (int i = 0; i < 2; ++i) { int R, C; stage_rc(tid * 16 + i * 8192, R, C); const int Rb = Epi::PERM ? ((R & ~31) + perm32(R & 31)) : R;
        voffA[i] = (unsigned)(R * K + C) * 2u; voffB[i] = (unsigned)(Rb * K + C) * 2u; }
    const size_t kstep = (size_t)(BK * 2);
    const size_t hstep = (size_t)HALF * K * 2;
    const size_t tstep = 2 * hstep;
    const unsigned ldsw = (unsigned)wid * 1024u;
    const int aoff = lds_byte(wr * 64 + fr, fq * 8), boff = lds_byte(wc * 32 + fr, fq * 8);
#define PG8_SA(b, h) (((b) * 2 + (h)) * HTB)
#define PG8_SB(b, h) ((4 + (b) * 2 + (h)) * HTB)
#define PG8_STAGE(bufoff, gbase, voff) do { _Pragma("unroll") for (int _i = 0; _i < 2; ++_i) \
        __builtin_amdgcn_global_load_lds((const unsigned*)((const char*)(gbase) + (voff)[_i]), (PG8_LAS unsigned*)(lds + (bufoff) + ldsw + _i * 8192), 16, 0, 0); } while (0)
#define PG8_LDA(dst, b, h) do { _Pragma("unroll") for (int m = 0; m < 4; ++m) _Pragma("unroll") for (int k = 0; k < 2; ++k) dst[m][k] = *(const PG8_LAS bf16x8*)(lds + PG8_SA(b, h) + aoff + m * 2048 + k * 1024); } while (0)
#define PG8_LDB(dst, b, h) do { _Pragma("unroll") for (int n = 0; n < 2; ++n) _Pragma("unroll") for (int k = 0; k < 2; ++k) dst[n][k] = *(const PG8_LAS bf16x8*)(lds + PG8_SB(b, h) + boff + n * 2048 + k * 1024); } while (0)
#define PG8_MMA(ai, bj, At, Bt) do { __builtin_amdgcn_s_setprio(1); _Pragma("unroll") for (int m = 0; m < 4; ++m) _Pragma("unroll") for (int n = 0; n < 2; ++n) _Pragma("unroll") for (int k = 0; k < 2; ++k) \
        acc[ai][bj][m][n] = __builtin_amdgcn_mfma_f32_16x16x32_bf16(Bt[n][k], At[m][k], acc[ai][bj][m][n], 0, 0, 0); __builtin_amdgcn_s_setprio(0); } while (0)
#define PG8_WAIT_V(n) asm volatile("s_waitcnt vmcnt(" #n ")" ::: "memory")
#define PG8_WAIT_L(n) asm volatile("s_waitcnt lgkmcnt(" #n ")" ::: "memory")
#define PG8_BAR __builtin_amdgcn_s_barrier()
#define PG8_SCHED __builtin_amdgcn_sched_barrier(0)
    Unit cur, nxt; int ui = 0;
    if (!S.next(0, cur)) return;
    f32x4 acc[2][2][4][2];
#pragma unroll
    for (int a = 0; a < 2; ++a)
#pragma unroll
        for (int b = 0; b < 2; ++b)
#pragma unroll
            for (int m = 0; m < 4; ++m)
#pragma unroll
                for (int n = 0; n < 2; ++n) acc[a][b][m][n] = (f32x4){0.f, 0.f, 0.f, 0.f};
    bf16x8 At[4][2], B0[2][2], B1[2][2];
    const char* cA = (const char*)g.A + (size_t)cur.pm * tstep; const char* cB = (const char*)g.Bt + (size_t)cur.pn * tstep;
    S.a_ready(cur);
    if constexpr (SP2) {
        PG8_STAGE(PG8_SB(0, 0), cB, voffB); PG8_STAGE(PG8_SB(0, 1), cB + hstep, voffB); PG8_STAGE(PG8_SA(0, 0), cA, voffA); PG8_STAGE(PG8_SA(0, 1), cA + hstep, voffA);
        if (wr == 1) PG8_BAR;
        PG8_WAIT_V(2); PG8_BAR;
        PG8_STAGE(PG8_SB(1, 0), cB + kstep, voffB); PG8_STAGE(PG8_SA(1, 0), cA + kstep, voffA); PG8_STAGE(PG8_SB(1, 1), cB + hstep + kstep, voffB);
        PG8_WAIT_V(6); PG8_BAR;
    } else {
        PG8_STAGE(PG8_SB(0, 0), cB, voffB); PG8_STAGE(PG8_SA(0, 0), cA, voffA); PG8_STAGE(PG8_SB(0, 1), cB + hstep, voffB); PG8_STAGE(PG8_SA(0, 1), cA + hstep, voffA);
        if (wr == 1) PG8_BAR;
        PG8_WAIT_V(4); PG8_BAR;
        PG8_STAGE(PG8_SB(1, 0), cB + kstep, voffB); PG8_STAGE(PG8_SA(1, 0), cA + kstep, voffA); PG8_STAGE(PG8_SB(1, 1), cB + hstep + kstep, voffB);
        PG8_WAIT_V(6); PG8_BAR;
    }
    for (;;) {
        const bool has_next = S.next(ui + 1, nxt);
        const char* nA = has_next ? (const char*)g.A + (size_t)nxt.pm * tstep : cA; const char* nB = has_next ? (const char*)g.Bt + (size_t)nxt.pn * tstep : cB;
#pragma unroll 1
        for (int t = 0; t < nt; t += 2) {
            const bool last = (t == nt - 2);
            const char* a1 = cA + (size_t)(t + 1) * kstep;
            const char* a2 = last ? nA : cA + (size_t)(t + 2) * kstep; const char* b2 = last ? nB : cB + (size_t)(t + 2) * kstep;
            const char* a3 = a2 + kstep; const char* b3 = b2 + kstep;
            if (last && has_next) S.a_ready(nxt);
            if constexpr (SP2) {
            PG8_LDB(B0, 0, 0); PG8_LDB(B1, 0, 1); PG8_SCHED; PG8_LDA(At, 0, 0); PG8_STAGE(PG8_SA(1, 1), a1 + hstep, voffA);
            PG8_WAIT_V(8); PG8_WAIT_L(0); PG8_BAR; PG8_MMA(0, 0, At, B0); PG8_MMA(0, 1, At, B1); PG8_BAR; PG8_SCHED;
            PG8_LDA(At, 0, 1); PG8_STAGE(PG8_SB(0, 0), b2, voffB); PG8_STAGE(PG8_SB(0, 1), b2 + hstep, voffB); PG8_STAGE(PG8_SA(0, 0), a2, voffA);
            PG8_WAIT_V(8); PG8_WAIT_L(0); PG8_BAR; PG8_MMA(1, 0, At, B0); PG8_MMA(1, 1, At, B1); PG8_BAR; PG8_SCHED;
            PG8_LDB(B0, 1, 0); PG8_LDB(B1, 1, 1); PG8_SCHED; PG8_LDA(At, 1, 0); PG8_STAGE(PG8_SA(0, 1), a2 + hstep, voffA);
            PG8_WAIT_V(8); PG8_WAIT_L(0); PG8_BAR; PG8_MMA(0, 0, At, B0); PG8_MMA(0, 1, At, B1); PG8_BAR; PG8_SCHED;
            PG8_LDA(At, 1, 1); PG8_STAGE(PG8_SB(1, 0), b3, voffB); PG8_STAGE(PG8_SB(1, 1), b3 + hstep, voffB); PG8_STAGE(PG8_SA(1, 0), a3, voffA);
            PG8_WAIT_V(8); PG8_WAIT_L(0); PG8_BAR; PG8_MMA(1, 0, At, B0); PG8_MMA(1, 1, At, B1); PG8_BAR; PG8_SCHED;
            } else {
            PG8_LDB(B0, 0, 0); PG8_SCHED; PG8_LDA(At, 0, 0); PG8_STAGE(PG8_SA(1, 1), a1 + hstep, voffA);
            PG8_WAIT_L(8); PG8_BAR; PG8_WAIT_L(0); PG8_MMA(0, 0, At, B0); PG8_BAR; PG8_SCHED;
            PG8_LDB(B1, 0, 1); PG8_STAGE(PG8_SB(0, 0), b2, voffB);
            PG8_BAR; PG8_WAIT_L(0); PG8_MMA(0, 1, At, B1); PG8_BAR;
            PG8_LDA(At, 0, 1); PG8_STAGE(PG8_SA(0, 0), a2, voffA);
            PG8_BAR; PG8_WAIT_L(0); PG8_MMA(1, 0, At, B0); PG8_BAR; PG8_SCHED;
            PG8_STAGE(PG8_SB(0, 1), b2 + hstep, voffB);
            PG8_WAIT_V(6); PG8_BAR; PG8_MMA(1, 1, At, B1); PG8_BAR;
            PG8_LDB(B0, 1, 0); PG8_SCHED; PG8_LDA(At, 1, 0); PG8_STAGE(PG8_SA(0, 1), a2 + hstep, voffA);
            PG8_WAIT_L(8); PG8_BAR; PG8_WAIT_L(0); PG8_MMA(0, 0, At, B0); PG8_BAR; PG8_SCHED;
            PG8_LDB(B1, 1, 1); PG8_STAGE(PG8_SB(1, 0), b3, voffB);
            PG8_BAR; PG8_WAIT_L(0); PG8_MMA(0, 1, At, B1); PG8_BAR;
            PG8_LDA(At, 1, 1); PG8_STAGE(PG8_SA(1, 0), a3, voffA);
            PG8_BAR; PG8_WAIT_L(0); PG8_MMA(1, 0, At, B0); PG8_BAR; PG8_SCHED;
            PG8_STAGE(PG8_SB(1, 1), b3 + hstep, voffB);
            PG8_WAIT_V(6); PG8_BAR; PG8_MMA(1, 1, At, B1); PG8_BAR;
            }
        }
        if constexpr (ALIGN_EPI) { if (wr == 0) PG8_BAR; }
        if constexpr (!Epi::AFTER_DRAIN) { E(acc, cur, wr, wc, fr, fq); S.done(cur); }
        if (!has_next) break;
#pragma unroll
        for (int a = 0; a < 2; ++a)
#pragma unroll
            for (int b = 0; b < 2; ++b)
#pragma unroll
                for (int m = 0; m < 4; ++m)
#pragma unroll
                    for (int n = 0; n < 2; ++n) acc[a][b][m][n] = (f32x4){0.f, 0.f, 0.f, 0.f};
        cur = nxt; cA = nA; cB = nB; ++ui;
        if constexpr (ALIGN_EPI) { if (wr == 1) PG8_BAR; }
    }
    PG8_WAIT_V(0);
    if constexpr (!ALIGN_EPI) { if (wr == 0) PG8_BAR; }
    PG8_BAR;
    if constexpr (Epi::AFTER_DRAIN) { E.fused(acc, cur, wr, wc, fr, fq, lds, wid, lane); S.done(cur); }
#undef PG8_SA
#undef PG8_SB
#undef PG8_STAGE
#undef PG8_LDA
#undef PG8_LDB
#undef PG8_MMA
#undef PG8_WAIT_V
#undef PG8_WAIT_L
#undef PG8_BAR
#undef PG8_SCHED
}
}
#define GAS __attribute__((address_space(1)))
#define LAS __attribute__((address_space(3)))
typedef unsigned short bf16;
typedef unsigned v4u __attribute__((ext_vector_type(4)));
typedef float f32x4 __attribute__((ext_vector_type(4)));
typedef short bf16x8 __attribute__((ext_vector_type(8)));
typedef GAS unsigned gu32;
typedef GAS unsigned long long gu64;
#define RLX_AGENT __ATOMIC_RELAXED, __HIP_MEMORY_SCOPE_AGENT
#define LDS_WAIT() asm volatile("s_waitcnt lgkmcnt(0)" ::: "memory")
#define VM_WAIT() asm volatile("s_waitcnt vmcnt(0)" ::: "memory")
__device__ __forceinline__ unsigned long long rt() { return __builtin_amdgcn_s_memrealtime(); }
__device__ __forceinline__ unsigned f2bf(float f) { unsigned u = __builtin_bit_cast(unsigned, f); return (u + 0x7fffu + ((u >> 16) & 1u)) >> 16; }
__device__ __forceinline__ unsigned pk2(float lo, float hi) { return f2bf(lo) | (f2bf(hi) << 16); }

#define XB_TMO      128
#define XB_XCNT(j)  (256  + 64 * (j))
#define XB_XSUB(j)  (1280 + 64 * (j))
#define XB_XGEN(j)  (2304 + 64 * (j))
#define XB_TOP      3328
#define XB_TOPGEN   3392
#define XCD_BAR_WORDS 3456
#define XB_SPIN_CAP (1u << 18)

__device__ __forceinline__ unsigned xb_ld(unsigned* p)              { return __hip_atomic_load(p, __ATOMIC_RELAXED, __HIP_MEMORY_SCOPE_AGENT); }
__device__ __forceinline__ unsigned xb_add(unsigned* p, unsigned v) { return __hip_atomic_fetch_add(p, v, __ATOMIC_RELAXED, __HIP_MEMORY_SCOPE_AGENT); }
__device__ __forceinline__ unsigned xb_xcc_id() { return (unsigned)__builtin_amdgcn_s_getreg((3 << 11) | 20) & 0xFu; }
#define XB_SPIN(cond, bar) do { unsigned _sp = 0; while (cond) { __builtin_amdgcn_s_sleep(1); \
    if ((++_sp & 255u) == 0u) { if (xb_ld(&(bar)[XB_TMO])) break; if (_sp > XB_SPIN_CAP) { atomicAdd(&(bar)[XB_TMO], 1u); break; } } } } while (0)

struct XcdBarrier {
    unsigned* bar; unsigned x;
    volatile LAS unsigned* st;
};

__device__ __forceinline__ XcdBarrier xcd_barrier_post(unsigned* bar, volatile LAS unsigned* st) {
    XcdBarrier b; b.bar = bar; b.x = xb_xcc_id(); b.st = st;
    if (threadIdx.x == 0) (void)xb_add(&bar[XB_XCNT(b.x)], 1u);
    return b;
}
__device__ __forceinline__ void xcd_barrier_complete(unsigned* bar, unsigned x, unsigned& nloc, unsigned& nx) {
    const unsigned G = gridDim.x * gridDim.y * gridDim.z;
    unsigned sum, cnt, mine, sp = 0u;
    for (;;) {
        sum = 0u; cnt = 0u; mine = 0u;
#pragma unroll
        for (unsigned j = 0; j < 16; ++j) { const unsigned c = xb_ld(&bar[XB_XCNT(j)]); sum += c; cnt += (c > 0u) ? 1u : 0u; mine = (j == x) ? c : mine; }
        if (sum == G) break;
        __builtin_amdgcn_s_sleep(1);
        if ((++sp & 255u) == 0u) { if (xb_ld(&bar[XB_TMO])) break; if (sp > XB_SPIN_CAP) { atomicAdd(&bar[XB_TMO], 1u); break; } }
    }
    nloc = mine > 0u ? mine : 1u; nx = cnt > 0u ? cnt : 1u;
}

__device__ __forceinline__ void xcd_barrier(const XcdBarrier& b) {
    asm volatile("s_waitcnt vmcnt(0)" ::: "memory");
    __syncthreads();
    if (threadIdx.x == 0) {
        unsigned* bar = b.bar;
        __builtin_amdgcn_s_waitcnt(0);
        unsigned nloc = b.st[0], nx = b.st[1];
        if (nloc == 0u) { xcd_barrier_complete(bar, b.x, nloc, nx); b.st[0] = nloc; b.st[1] = nx; }
        const unsigned old = xb_add(&bar[XB_XSUB(b.x)], 1u);
        const unsigned gen = old / nloc;
        if (old + 1u == (gen + 1u) * nloc) {
            __builtin_amdgcn_fence(__ATOMIC_RELEASE, "agent");
            asm volatile("s_waitcnt vmcnt(0)" ::: "memory");
            const unsigned og = xb_add(&bar[XB_TOP], 1u);
            const unsigned tg = og / nx;
            if (og + 1u == (tg + 1u) * nx) xb_add(&bar[XB_TOPGEN], 1u);
            else XB_SPIN(xb_ld(&bar[XB_TOPGEN]) == tg, bar);
            __builtin_amdgcn_fence(__ATOMIC_ACQUIRE, "agent");
            xb_add(&bar[XB_XGEN(b.x)], 1u);
            asm volatile("s_waitcnt vmcnt(0)" ::: "memory");
        } else {
            XB_SPIN(xb_ld(&bar[XB_XGEN(b.x)]) == gen, bar);
            __builtin_amdgcn_fence(__ATOMIC_ACQUIRE, "agent");
            asm volatile("s_waitcnt vmcnt(0)" ::: "memory");
        }
    }
    __syncthreads();
}


constexpr int NWAVES = 8;
#ifndef DBG_MIX
#define DBG_MIX 0
#endif
#ifndef MK_N_LAUNCHES
#define MK_N_LAUNCHES 1
#endif
constexpr int N_PHASES = 13;
constexpr int N_LAUNCHES = MK_N_LAUNCHES;

constexpr int D = 1024, FF = 2816, NIN = 8448, SHIFTC = 3328, PLE = 256, TSEQ = 2048, NBATCH = 8, NSAMP = 128, NHEAD = 16;
constexpr int MP = pg8::MP, MV = pg8::MV, MPR = pg8::MPR;
constexpr float RMS_EPS = 1e-6f, GN_EPS = 64e-5f;
constexpr size_t O_YP = 0, O_YS = 16777216, O_WKVP = 16908288, O_SHP = 17432576, O_CVP = 17459200, O_WKVS = 17475584, O_SHS = 25864192, O_CVS = 26290176, O_END = 26552320;
constexpr size_t MiB = 1u << 20;
constexpr size_t WS_CTL = 0, CTL_ZERO_BYTES = 1 * MiB;
constexpr size_t WS_WIN = 1 * MiB;
constexpr size_t WS_WOUT = WS_WIN + (size_t)NIN * D * 2;
constexpr size_t WS_W2GU = WS_WOUT + (size_t)D * D * 2;
constexpr size_t WS_W2D = WS_W2GU + (size_t)2 * FF * D * 2;
constexpr size_t WS_WPG = WS_W2D + (size_t)D * FF * 2;
constexpr size_t WS_WPP = WS_WPG + (size_t)D * D * 2;
constexpr size_t WS_WDU = WS_WPP + (size_t)D * PLE * 2;
constexpr size_t WS_WIU = WS_WDU + (size_t)D * 64 * 2;
constexpr size_t WS_WGU = WS_WIU + (size_t)D * 64 * 2;
constexpr size_t WS_PB = WS_WGU + (size_t)D * 128 * 2;
constexpr size_t WS_XB = WS_PB + (size_t)MP * PLE * 2;
constexpr size_t WS_MIX = WS_XB + (size_t)MP * D * 2;
constexpr size_t WS_SSQ = WS_MIX + (size_t)MP * D * 2;
constexpr size_t WS_CAR = WS_SSQ + (size_t)16 * MP * 4;
constexpr size_t WS_R = (WS_CAR + (size_t)128 * 576 * 4 + 4095) / 4096 * 4096;
constexpr size_t WS_W1GU = WS_R;
constexpr size_t WS_W1D = WS_W1GU + (size_t)2 * FF * D * 2;
constexpr size_t WS_GU = WS_W1D + (size_t)D * FF * 2;
constexpr size_t WS_Z = WS_R;
constexpr size_t WS_END = 256 * MiB;
static_assert(WS_GU + (size_t)MP * FF * 2 <= WS_END && WS_Z + (size_t)8448 * NIN * 2 <= WS_END, "d_ws map");
constexpr int CW_BAR = 4096;
constexpr int RING_OFF = 0, RING_BYTES = 131072;
constexpr int LDSCTL_OFF = 139264, MISC_OFF = LDSCTL_OFF + 320, PTR_OFF = LDSCTL_OFF + 1024;
constexpr int LDS_BYTES = 147456;
static_assert(MISC_OFF + 128 <= LDS_BYTES, "LDS map");

#define WG_SYNC() do { asm volatile("s_waitcnt lgkmcnt(0)" ::: "memory"); __builtin_amdgcn_s_barrier(); asm volatile("" ::: "memory"); } while (0)

typedef unsigned u32x2v __attribute__((ext_vector_type(2)));
typedef float f32x2 __attribute__((ext_vector_type(2)));

struct Frame {
    LAS unsigned char* lds;
    volatile LAS unsigned* MISC;
    gu32* ctl;
    int tid, lane, wave, vcu, G;
    GAS float* out; GAS unsigned char* ws;
    __device__ __forceinline__ const GAS float* inp(int k) const { const u32x2v p = *(const LAS u32x2v*)(lds + PTR_OFF + 8 * k); const unsigned long long a = ((unsigned long long)(unsigned)__builtin_amdgcn_readfirstlane((int)p.y) << 32) | (unsigned)__builtin_amdgcn_readfirstlane((int)p.x); return (const GAS float*)a; }
};

__device__ __forceinline__ float wave_sum(float v) {
#pragma unroll
    for (int o = 1; o < 64; o <<= 1) v += __shfl_xor(v, o);
    return v;
}
__device__ __forceinline__ f32x4 unpk4(u32x2v p) { f32x4 r; r[0] = __uint_as_float(p.x << 16); r[1] = __uint_as_float(p.x & 0xffff0000u); r[2] = __uint_as_float(p.y << 16); r[3] = __uint_as_float(p.y & 0xffff0000u); return r; }
__device__ __forceinline__ float bf_lo(unsigned p) { return __uint_as_float(p << 16); }
__device__ __forceinline__ float bf_hi(unsigned p) { return __uint_as_float(p & 0xffff0000u); }
__device__ __forceinline__ float fsig(float x) { return __builtin_amdgcn_rcpf(1.0f + __expf(-x)); }
__device__ __forceinline__ float ftanh(float x) { return 1.0f - 2.0f * __builtin_amdgcn_rcpf(__expf(2.0f * x) + 1.0f); }
template <int CTRL> __device__ __forceinline__ float dppf(float x) { return __builtin_bit_cast(float, __builtin_amdgcn_update_dpp(0, __builtin_bit_cast(int, x), CTRL, 0xF, 0xF, true)); }
__device__ __forceinline__ float red16(float x) {
    x += dppf<0xB1>(x); x += dppf<0x4E>(x); x += dppf<0x141>(x); x += dppf<0x140>(x); return x; }
__device__ __forceinline__ float decay_of(float x) {
    const float w = fminf(x, 0.f) - __logf(1.0f + __expf(-fabsf(x))) - 0.5f;
    return __expf(-__expf(w));
}

__device__ __forceinline__ void p0_item(const GAS float* W, int K, int N, GAS bf16* WT, int mode, const GAS float* gain, LAS float* scr, int item, int lane) {
    const int nblk = N / 32, kb = item / nblk, nb = item % nblk, k0 = 64 * kb, n0 = 32 * nb;
#pragma unroll 8
    for (int i = 0; i < 32; ++i) { const int kk = 2 * i + (lane >> 5); float w = W[(size_t)(k0 + kk) * N + n0 + (lane & 31)]; if (gain) w *= gain[k0 + kk]; scr[kk * 33 + (lane & 31)] = w; }
    LDS_WAIT(); asm volatile("" ::: "memory");
    const int c = lane & 7;
    const int r0 = (mode == 0) ? n0 : ((n0 >> 7) * 256 + (n0 & 127) + (mode == 2 ? 128 : 0));
#pragma unroll
    for (int j = 0; j < 4; ++j) { const int n = (lane >> 3) + 8 * j; const LAS float* s = scr + (8 * c) * 33 + n;
        v4u o; o.x = pk2(s[0 * 33], s[1 * 33]); o.y = pk2(s[2 * 33], s[3 * 33]); o.z = pk2(s[4 * 33], s[5 * 33]); o.w = pk2(s[6 * 33], s[7 * 33]);
        *(GAS v4u*)(WT + (size_t)(r0 + n) * K + k0 + 8 * c) = o; }
    LDS_WAIT(); asm volatile("" ::: "memory");
}
__device__ __forceinline__ void rms_row_to_bf16(int lane, const GAS float* xrow, const GAS float* gain, GAS bf16* orow) {
    const GAS f32x4* xr = (const GAS f32x4*)xrow + lane; const GAS f32x4* gr = (const GAS f32x4*)gain + lane;
    f32x4 v[4]; float s = 0.f;
#pragma unroll
    for (int j = 0; j < 4; ++j) { v[j] = xr[64 * j]; s += (v[j].x * v[j].x + v[j].y * v[j].y) + (v[j].z * v[j].z + v[j].w * v[j].w); }
    const float rs = 1.0f / sqrtf(wave_sum(s) * (1.f / D) + RMS_EPS);
    GAS unsigned long long* o8 = (GAS unsigned long long*)orow + lane;
#pragma unroll
    for (int j = 0; j < 4; ++j) { const f32x4 g = gr[64 * j]; o8[64 * j] = (unsigned long long)pk2(v[j].x * rs * g.x, v[j].y * rs * g.y) | ((unsigned long long)pk2(v[j].z * rs * g.z, v[j].w * rs * g.w) << 32); }
}
__device__ __forceinline__ void p0_prologue(Frame& F) {
    LAS float* scr = (LAS float*)(F.lds + RING_OFF + F.wave * 16384);
    const int gw = F.vcu * NWAVES + F.wave, NGW = F.G * NWAVES;
    GAS unsigned char* ws = F.ws;
    constexpr int I_GU = (D / 64) * (FF / 32), I_DN = (FF / 64) * (D / 32), I_IN = (D / 64) * (NIN / 32), I_SQ = (D / 64) * (D / 32), I_PP = (PLE / 64) * (D / 32), I_L64 = (D / 32), I_L128 = 2 * (D / 32);
    constexpr int NITEMS = 4 * I_GU + 2 * I_DN + I_IN + 2 * I_SQ + I_PP + 2 * I_L64 + I_L128;
    for (int it = gw; it < NITEMS; it += NGW) {
        int r = it;
        if (r < I_IN) { p0_item(F.inp(12), D, NIN, (GAS bf16*)(ws + WS_WIN), 0, F.inp(11), scr, r, F.lane); continue; } r -= I_IN;
        if (r < I_GU) { p0_item(F.inp(8), D, FF, (GAS bf16*)(ws + WS_W1GU), 1, nullptr, scr, r, F.lane); continue; } r -= I_GU;
        if (r < I_GU) { p0_item(F.inp(9), D, FF, (GAS bf16*)(ws + WS_W1GU), 2, nullptr, scr, r, F.lane); continue; } r -= I_GU;
        if (r < I_DN) { p0_item(F.inp(10), FF, D, (GAS bf16*)(ws + WS_W1D), 0, nullptr, scr, r, F.lane); continue; } r -= I_DN;
        if (r < I_GU) { p0_item(F.inp(27), D, FF, (GAS bf16*)(ws + WS_W2GU), 1, F.inp(26), scr, r, F.lane); continue; } r -= I_GU;
        if (r < I_GU) { p0_item(F.inp(28), D, FF, (GAS bf16*)(ws + WS_W2GU), 2, F.inp(26), scr, r, F.lane); continue; } r -= I_GU;
        if (r < I_DN) { p0_item(F.inp(29), FF, D, (GAS bf16*)(ws + WS_W2D), 0, nullptr, scr, r, F.lane); continue; } r -= I_DN;
        if (r < I_SQ) { p0_item(F.inp(25), D, D, (GAS bf16*)(ws + WS_WOUT), 0, nullptr, scr, r, F.lane); continue; } r -= I_SQ;
        if (r < I_SQ) { p0_item(F.inp(31), D, D, (GAS bf16*)(ws + WS_WPG), 0, F.inp(30), scr, r, F.lane); continue; } r -= I_SQ;
        if (r < I_PP) { p0_item(F.inp(32), PLE, D, (GAS bf16*)(ws + WS_WPP), 0, nullptr, scr, r, F.lane); continue; } r -= I_PP;
        if (r < I_L64) { p0_item(F.inp(14), 64, D, (GAS bf16*)(ws + WS_WDU), 0, nullptr, scr, r, F.lane); continue; } r -= I_L64;
        if (r < I_L64) { p0_item(F.inp(16), 64, D, (GAS bf16*)(ws + WS_WIU), 0, nullptr, scr, r, F.lane); continue; } r -= I_L64;
        p0_item(F.inp(18), 128, D, (GAS bf16*)(ws + WS_WGU), 0, nullptr, scr, r, F.lane);
    }
    for (int m = gw; m < MV; m += NGW) {
        const GAS float* xr = (m < MPR) ? F.inp(0) + (size_t)m * D : F.inp(1) + (size_t)(m - MPR) * D;
        rms_row_to_bf16(F.lane, xr, F.inp(7), (GAS bf16*)(ws + WS_XB) + (size_t)m * D);
        const GAS float* pr = (m < MPR) ? F.inp(2) + (size_t)m * PLE : F.inp(3) + (size_t)(m - MPR) * PLE;
        const f32x4 pv = ((const GAS f32x4*)pr)[F.lane];
        ((GAS unsigned long long*)((GAS bf16*)(ws + WS_PB) + (size_t)m * PLE))[F.lane] = (unsigned long long)pk2(pv.x, pv.y) | ((unsigned long long)pk2(pv.z, pv.w) << 32);
    }
}
__device__ __forceinline__ void p9_final(Frame& F) {
    const int gw = F.vcu * NWAVES + F.wave, NGW = F.G * NWAVES;
    for (int m = gw; m < MV; m += NGW) {
        GAS f32x4* xr = (GAS f32x4*)(F.out + (size_t)m * D) + F.lane; const GAS f32x4* gr = (const GAS f32x4*)F.inp(33) + F.lane;
        f32x4 v[4]; float s = 0.f;
#pragma unroll
        for (int j = 0; j < 4; ++j) { v[j] = xr[64 * j]; s += (v[j].x * v[j].x + v[j].y * v[j].y) + (v[j].z * v[j].z + v[j].w * v[j].w); }
        const float rs = 1.0f / sqrtf(wave_sum(s) * (1.f / D) + RMS_EPS);
#pragma unroll
        for (int j = 0; j < 4; ++j) { const f32x4 g = gr[64 * j]; xr[64 * j] = v[j] * rs * g; }
    }
}

constexpr int MX_WDU = 0, MX_WIU = 9216, MX_WGU = 18432, MX_AT = 35840, MX_AA = 40448, MX_AG = 45056, MX_DD = 53760, MX_AL = 61952, MX_G = 70144,
              MX_KK = 78336, MX_BB = 86528, MX_KM = 94720, MX_RR = 102912, MX_VV = 111104, MX_Y = 119296, MX_BON = 127488, MX_CU = 127616, MX_END = 136320;
static_assert(MX_END <= LDSCTL_OFF, "mixer LDS map");
constexpr int SUBT = 32;
constexpr int CAR_STRIDE = 576;

struct RawZ { u32x2v r, k, v, rp, kp, vp, wd, ad, wdp, adp; v4u gd, gdp; u32x2v cB, cC, cU, gA, gB; };

__device__ __forceinline__ u32x2v ld8c(const GAS bf16* p) { const unsigned long long v = __hip_atomic_load((const GAS unsigned long long*)p, __ATOMIC_RELAXED, __HIP_MEMORY_SCOPE_AGENT); return (u32x2v){(unsigned)v, (unsigned)(v >> 32)}; }
__device__ __forceinline__ void mix_load(RawZ& R, const GAS bf16* Zc, int lrow, bool first, int h, int q) {
    const GAS bf16* zr = Zc + (size_t)lrow * NIN; const GAS bf16* zp = first ? zr : zr - NIN;
    const int hc = 64 * h + 4 * q;
    R.r = ld8c(zr + hc); R.k = ld8c(zr + 1024 + hc); R.v = ld8c(zr + 2048 + hc);
    R.rp = ld8c(zp + hc); R.kp = ld8c(zp + 1024 + hc); R.vp = ld8c(zp + 2048 + hc);
    R.wd = ld8c(zr + 3072 + 4 * q); R.ad = ld8c(zr + 3136 + 4 * q); { const u32x2v a = ld8c(zr + 3200 + 8 * q), b = ld8c(zr + 3204 + 8 * q); R.gd = (v4u){a.x, a.y, b.x, b.y}; }
    R.wdp = ld8c(zp + 3072 + 4 * q); R.adp = ld8c(zp + 3136 + 4 * q); { const u32x2v a = ld8c(zp + 3200 + 8 * q), b = ld8c(zp + 3204 + 8 * q); R.gdp = (v4u){a.x, a.y, b.x, b.y}; }
    R.cB = ld8c(zr + 3328 + hc); R.cC = ld8c(zr + 4352 + hc); R.cU = ld8c(zr + 5376 + hc);
    R.gA = ld8c(zr + 6400 + hc); R.gB = ld8c(zr + 7424 + hc);
}

__device__ __forceinline__ void mix_job(Frame& F, int b, int h, int chunk) {
    LAS unsigned char* lds = F.lds;
    asm volatile("" : "+s"(b), "+s"(h), "+s"(chunk));
    int tid = threadIdx.x; asm volatile("" : "+v"(tid));
    const int lane = tid & 63, wave = __builtin_amdgcn_readfirstlane(tid >> 6);
    const int tt = tid >> 4, q = tid & 15;
    const GAS bf16* Zc = (const GAS bf16*)(F.ws + WS_Z);
    GAS float* car = (GAS float*)(F.ws + WS_CAR) + (size_t)(b * NHEAD + h) * CAR_STRIDE;
    {
        const GAS bf16* wdu = (const GAS bf16*)(F.ws + WS_WDU) + (size_t)(64 * h) * 64; const GAS bf16* wiu = (const GAS bf16*)(F.ws + WS_WIU) + (size_t)(64 * h) * 64; const GAS bf16* wgu = (const GAS bf16*)(F.ws + WS_WGU) + (size_t)(64 * h) * 128;
        const int n = tid >> 3, k8 = (tid & 7) * 8;
        *(LAS v4u*)(lds + MX_WDU + n * 144 + k8 * 2) = *(const GAS v4u*)(wdu + tid * 8);
        *(LAS v4u*)(lds + MX_WIU + n * 144 + k8 * 2) = *(const GAS v4u*)(wiu + tid * 8);
#pragma unroll
        for (int i = 0; i < 2; ++i) { const int e = (tid + 512 * i) * 8, n2 = e >> 7, k2 = e & 127; *(LAS v4u*)(lds + MX_WGU + n2 * 272 + k2 * 2) = *(const GAS v4u*)(wgu + e); }
    }
    const int hc = 64 * h + 4 * q;
    const f32x4 mu_r = *(const GAS f32x4*)(F.inp(13) + hc), mu_k = *(const GAS f32x4*)(F.inp(13) + 1024 + hc), mu_v = *(const GAS f32x4*)(F.inp(13) + 2048 + hc);
    const f32x4 mu_wd = *(const GAS f32x4*)(F.inp(13) + 3072 + 4 * q), mu_ad = *(const GAS f32x4*)(F.inp(13) + 3136 + 4 * q);
    const f32x4 mu_g0 = *(const GAS f32x4*)(F.inp(13) + 3200 + 8 * q), mu_g1 = *(const GAS f32x4*)(F.inp(13) + 3204 + 8 * q);
    const f32x4 c_kk = *(const GAS f32x4*)(F.inp(19) + hc), c_ka = *(const GAS f32x4*)(F.inp(20) + hc), c_rk = *(const GAS f32x4*)(F.inp(21) + hc);
    const f32x4 c_gw = *(const GAS f32x4*)(F.inp(22) + hc), c_gb = *(const GAS f32x4*)(F.inp(23) + hc);
    const f32x4 c_w0 = *(const GAS f32x4*)(F.inp(24) + hc), c_w1 = *(const GAS f32x4*)(F.inp(24) + 1024 + hc), c_w2 = *(const GAS f32x4*)(F.inp(24) + 2048 + hc);
    const int mb = wave & 1, nb = wave >> 1, lr = lane & 15, lq = lane >> 4;
    const float dbias = F.inp(15)[64 * h + 16 * nb + lr], ibias = F.inp(17)[64 * h + 16 * nb + lr];
    const int v0 = 8 * wave + 2 * lq, kq = lr;
    GAS float* Sg = F.out + O_WKVP + ((size_t)(b * NHEAD + h) * 64 + v0) * 64 + 4 * kq;
    f32x4 S0 = (f32x4){0.f, 0.f, 0.f, 0.f}, S1 = (f32x4){0.f, 0.f, 0.f, 0.f};
    if (chunk) { S0 = *(const GAS f32x4*)Sg; S1 = *(const GAS f32x4*)(Sg + 64); }
    if (tt < 2) { f32x4 c0 = (f32x4){0.f, 0.f, 0.f, 0.f}; if (chunk) c0 = *(const GAS f32x4*)(car + 448 + tt * 64 + 4 * q); *(LAS f32x4*)(lds + MX_CU + tt * 256 + q * 16) = c0; }

    RawZ R; mix_load(R, Zc, b * 1024 + tt, (tt == 0), h, q);
    for (int sc = 0; sc < 1024 / SUBT; ++sc) {
        const bool first = (sc == 0 && tt == 0);
        f32x4 zr_ = unpk4(R.r), zk_ = unpk4(R.k), zv_ = unpk4(R.v), zwd = unpk4(R.wd), zad = unpk4(R.ad);
        f32x4 zg0 = unpk4((u32x2v){R.gd.x, R.gd.y}), zg1 = unpk4((u32x2v){R.gd.z, R.gd.w});
        f32x4 pr_ = unpk4(R.rp), pk_ = unpk4(R.kp), pv_ = unpk4(R.vp), pwd = unpk4(R.wdp), pad = unpk4(R.adp);
        f32x4 pg0 = unpk4((u32x2v){R.gdp.x, R.gdp.y}), pg1 = unpk4((u32x2v){R.gdp.z, R.gdp.w});
        if (first) {
            if (chunk) { pr_ = *(const GAS f32x4*)(car + 4 * q); pk_ = *(const GAS f32x4*)(car + 64 + 4 * q); pv_ = *(const GAS f32x4*)(car + 128 + 4 * q);
                         pwd = *(const GAS f32x4*)(car + 192 + 4 * q); pad = *(const GAS f32x4*)(car + 256 + 4 * q); pg0 = *(const GAS f32x4*)(car + 320 + 8 * q); pg1 = *(const GAS f32x4*)(car + 324 + 8 * q); }
            else { const f32x4 z4 = (f32x4){0.f, 0.f, 0.f, 0.f}; pr_ = z4; pk_ = z4; pv_ = z4; pwd = z4; pad = z4; pg0 = z4; pg1 = z4; }
        }
        if (chunk == 0 && sc == 1024 / SUBT - 1 && tt == SUBT - 1) {
            *(GAS f32x4*)(car + 4 * q) = zr_; *(GAS f32x4*)(car + 64 + 4 * q) = zk_; *(GAS f32x4*)(car + 128 + 4 * q) = zv_;
            *(GAS f32x4*)(car + 192 + 4 * q) = zwd; *(GAS f32x4*)(car + 256 + 4 * q) = zad; *(GAS f32x4*)(car + 320 + 8 * q) = zg0; *(GAS f32x4*)(car + 324 + 8 * q) = zg1;
        }
        if (chunk == 1 && sc == 1024 / SUBT - 1 && tt == SUBT - 1) {
            GAS float* d = F.out + O_SHP + (size_t)b * SHIFTC;
            *(GAS f32x4*)(d + hc) = zr_; *(GAS f32x4*)(d + 1024 + hc) = zk_; *(GAS f32x4*)(d + 2048 + hc) = zv_;
            if (h == 0) { *(GAS f32x4*)(d + 3072 + 4 * q) = zwd; *(GAS f32x4*)(d + 3136 + 4 * q) = zad; *(GAS f32x4*)(d + 3200 + 8 * q) = zg0; *(GAS f32x4*)(d + 3204 + 8 * q) = zg1; }
        }
        const f32x4 r_s = zr_ + mu_r * (pr_ - zr_), k_s = zk_ + mu_k * (pk_ - zk_), v_s = zv_ + mu_v * (pv_ - zv_);
        const f32x4 wd_s = zwd + mu_wd * (pwd - zwd), ad_s = zad + mu_ad * (pad - zad), g0_s = zg0 + mu_g0 * (pg0 - zg0), g1_s = zg1 + mu_g1 * (pg1 - zg1);
        { u32x2v w; w.x = pg8::cvt_pk_bf16(ftanh(wd_s[0]), ftanh(wd_s[1])); w.y = pg8::cvt_pk_bf16(ftanh(wd_s[2]), ftanh(wd_s[3])); *(LAS u32x2v*)(lds + MX_AT + tt * 144 + q * 8) = w; }
        { u32x2v w; w.x = pg8::cvt_pk_bf16(ad_s[0], ad_s[1]); w.y = pg8::cvt_pk_bf16(ad_s[2], ad_s[3]); *(LAS u32x2v*)(lds + MX_AA + tt * 144 + q * 8) = w; }
        { v4u w; w.x = pg8::cvt_pk_bf16(fsig(g0_s[0]), fsig(g0_s[1])); w.y = pg8::cvt_pk_bf16(fsig(g0_s[2]), fsig(g0_s[3])); w.z = pg8::cvt_pk_bf16(fsig(g1_s[0]), fsig(g1_s[1])); w.w = pg8::cvt_pk_bf16(fsig(g1_s[2]), fsig(g1_s[3]));
          *(LAS v4u*)(lds + MX_AG + tt * 272 + q * 16) = w; }
        const f32x4 cu = unpk4(R.cC) * unpk4(R.cU);
        *(LAS f32x4*)(lds + MX_CU + (tt + 2) * 256 + q * 16) = cu;
        const u32x2v kB = R.cB, kgA = R.gA, kgB = R.gB;
        WG_SYNC();
        {
            f32x4 a1 = (f32x4){0.f, 0.f, 0.f, 0.f}, a2 = a1, a3 = a1;
#pragma unroll
            for (int ks = 0; ks < 2; ++ks) {
                const bf16x8 At = *(const LAS bf16x8*)(lds + MX_AT + (16 * mb + lr) * 144 + (32 * ks + 8 * lq) * 2), Bd = *(const LAS bf16x8*)(lds + MX_WDU + (16 * nb + lr) * 144 + (32 * ks + 8 * lq) * 2);
                const bf16x8 Aa = *(const LAS bf16x8*)(lds + MX_AA + (16 * mb + lr) * 144 + (32 * ks + 8 * lq) * 2), Bi = *(const LAS bf16x8*)(lds + MX_WIU + (16 * nb + lr) * 144 + (32 * ks + 8 * lq) * 2);
                a1 = __builtin_amdgcn_mfma_f32_16x16x32_bf16(At, Bd, a1, 0, 0, 0); a2 = __builtin_amdgcn_mfma_f32_16x16x32_bf16(Aa, Bi, a2, 0, 0, 0); }
#pragma unroll
            for (int ks = 0; ks < 4; ++ks) {
                const bf16x8 Ag = *(const LAS bf16x8*)(lds + MX_AG + (16 * mb + lr) * 272 + (32 * ks + 8 * lq) * 2), Bg = *(const LAS bf16x8*)(lds + MX_WGU + (16 * nb + lr) * 272 + (32 * ks + 8 * lq) * 2);
                a3 = __builtin_amdgcn_mfma_f32_16x16x32_bf16(Ag, Bg, a3, 0, 0, 0); }
#pragma unroll
            for (int j = 0; j < 4; ++j) { const int o = ((16 * mb + 4 * lq + j) * 64 + 16 * nb + lr) * 4;
                *(LAS float*)(lds + MX_DD + o) = decay_of(dbias + a1[j]); *(LAS float*)(lds + MX_AL + o) = fsig(ibias + a2[j]); *(LAS float*)(lds + MX_G + o) = a3[j]; }
        }
        WG_SYNC();
        {
            const f32x4 a4 = *(const LAS f32x4*)(lds + MX_AL + tt * 256 + q * 16);
            f32x4 kkr = k_s * c_kk; float ss = (kkr[0] * kkr[0] + kkr[1] * kkr[1]) + (kkr[2] * kkr[2] + kkr[3] * kkr[3]); ss = red16(ss);
            const float inv = 1.0f / fmaxf(sqrtf(ss), 1e-12f);
            const f32x4 kk = kkr * inv, km = k_s * (1.0f + (a4 - 1.0f) * c_ka), bb = kk * a4;
            float bo = (r_s[0] * km[0] * c_rk[0] + r_s[1] * km[1] * c_rk[1]) + (r_s[2] * km[2] * c_rk[2] + r_s[3] * km[3] * c_rk[3]); bo = red16(bo);
            *(LAS f32x4*)(lds + MX_KK + tt * 256 + q * 16) = kk; *(LAS f32x4*)(lds + MX_BB + tt * 256 + q * 16) = bb; *(LAS f32x4*)(lds + MX_KM + tt * 256 + q * 16) = km;
            *(LAS f32x4*)(lds + MX_RR + tt * 256 + q * 16) = r_s; *(LAS f32x4*)(lds + MX_VV + tt * 256 + q * 16) = v_s;
            if (q == 0) *(LAS float*)(lds + MX_BON + tt * 4) = bo;
        }
        if (sc + 1 < 1024 / SUBT) mix_load(R, Zc, b * 1024 + (sc + 1) * SUBT + tt, false, h, q);
        WG_SYNC();
#pragma unroll 2
        for (int s = 0; s < SUBT; ++s) {
            const f32x4 kk4 = *(const LAS f32x4*)(lds + MX_KK + s * 256 + kq * 16), b4 = *(const LAS f32x4*)(lds + MX_BB + s * 256 + kq * 16), d4 = *(const LAS f32x4*)(lds + MX_DD + s * 256 + kq * 16);
            const f32x4 km4 = *(const LAS f32x4*)(lds + MX_KM + s * 256 + kq * 16), r4 = *(const LAS f32x4*)(lds + MX_RR + s * 256 + kq * 16);
            const f32x2 v2 = *(const LAS f32x2*)(lds + MX_VV + s * 256 + v0 * 4);
            float p0 = (S0[0] * kk4[0] + S0[1] * kk4[1]) + (S0[2] * kk4[2] + S0[3] * kk4[3]), p1 = (S1[0] * kk4[0] + S1[1] * kk4[1]) + (S1[2] * kk4[2] + S1[3] * kk4[3]);
            p0 = red16(p0); p1 = red16(p1);
#pragma unroll
            for (int j = 0; j < 4; ++j) { S0[j] = S0[j] * d4[j] + (v2.x * km4[j] - p0 * b4[j]); S1[j] = S1[j] * d4[j] + (v2.y * km4[j] - p1 * b4[j]); }
            float y0 = (S0[0] * r4[0] + S0[1] * r4[1]) + (S0[2] * r4[2] + S0[3] * r4[3]), y1 = (S1[0] * r4[0] + S1[1] * r4[1]) + (S1[2] * r4[2] + S1[3] * r4[3]);
            y0 = red16(y0); y1 = red16(y1);
            if (kq == 0) *(LAS f32x2*)(lds + MX_Y + s * 256 + v0 * 4) = (f32x2){y0, y1};
        }
        WG_SYNC();
        {
            const f32x4 y4 = *(const LAS f32x4*)(lds + MX_Y + tt * 256 + q * 16), g4 = *(const LAS f32x4*)(lds + MX_G + tt * 256 + q * 16);
            const float bo = *(const LAS float*)(lds + MX_BON + tt * 4);
            float sm = (y4[0] + y4[1]) + (y4[2] + y4[3]); sm = red16(sm); const float mean = sm * (1.0f / 64.0f);
            const f32x4 dy = y4 - mean; float sv = (dy[0] * dy[0] + dy[1] * dy[1]) + (dy[2] * dy[2] + dy[3] * dy[3]); sv = red16(sv);
            const float rstd = __builtin_amdgcn_rsqf(sv * (1.0f / 64.0f) + GN_EPS);
            const f32x4 ya = (dy * rstd * c_gw + c_gb + bo * v_s) * g4;
            const f32x4 cu0 = *(const LAS f32x4*)(lds + MX_CU + tt * 256 + q * 16), cu1 = *(const LAS f32x4*)(lds + MX_CU + (tt + 1) * 256 + q * 16);
            const f32x4 yb = unpk4(kB) * (c_w0 * cu0 + c_w1 * cu1 + c_w2 * cu);
            const f32x4 ga = unpk4(kgA), gb = unpk4(kgB);
            f32x4 mo;
#pragma unroll
#if DBG_MIX == 1
            for (int j = 0; j < 4; ++j) mo[j] = ya[j];
#elif DBG_MIX == 2
            for (int j = 0; j < 4; ++j) mo[j] = yb[j] + fsig(ga[j]) + fsig(gb[j]);
#elif DBG_MIX == 3
            for (int j = 0; j < 4; ++j) mo[j] = y4[j];
#elif DBG_MIX == 4
            for (int j = 0; j < 4; ++j) mo[j] = g4[j] + bo;
#elif DBG_MIX == 5
            for (int j = 0; j < 4; ++j) mo[j] = g4[j];
#elif DBG_MIX == 6
            for (int j = 0; j < 4; ++j) mo[j] = bo;
#else
            for (int j = 0; j < 4; ++j) mo[j] = fsig(ga[j]) * ya[j] + fsig(gb[j]) * yb[j];
#endif
            u32x2v w; w.x = pg8::cvt_pk_bf16(mo[0], mo[1]); w.y = pg8::cvt_pk_bf16(mo[2], mo[3]);
            const int t = chunk * 1024 + sc * SUBT + tt;
            *(GAS u32x2v*)((GAS bf16*)(F.ws + WS_MIX) + (size_t)(b * TSEQ + t) * D + hc) = w;
        }
        WG_SYNC();
        if (tt >= SUBT - 2) {
            *(LAS f32x4*)(lds + MX_CU + (tt - (SUBT - 2)) * 256 + q * 16) = cu;
            if (sc == 1024 / SUBT - 1) {
                if (chunk == 0) *(GAS f32x4*)(car + 448 + (tt - (SUBT - 2)) * 64 + 4 * q) = cu;
                else *(GAS f32x4*)(F.out + O_CVP + (size_t)(b * 2 + (tt - (SUBT - 2))) * D + hc) = cu;
            }
        }
    }
    *(GAS f32x4*)Sg = S0; *(GAS f32x4*)(Sg + 64) = S1;
    WG_SYNC();
}

constexpr int SJ_TW = 0, SJ_AD = 256, SJ_SG = 512, SJ_KK = 1024, SJ_BB = 5120, SJ_DD = 9216, SJ_KM = 13312, SJ_RR = 17408, SJ_VV = 21504, SJ_Y = 25600;
__device__ __forceinline__ void sample_job(Frame& F, int s) {
    LAS unsigned char* lds = F.lds;
    asm volatile("" : "+s"(s));
    int tid = threadIdx.x; asm volatile("" : "+v"(tid));
    const int lane = tid & 63, wave = __builtin_amdgcn_readfirstlane(tid >> 6), c0 = 2 * tid;
    const GAS bf16* zr = (const GAS bf16*)(F.ws + WS_Z) + (size_t)(8192 + s) * NIN;
    const GAS float* sh = F.inp(5) + (size_t)s * SHIFTC; const GAS float* mu = F.inp(13);
    float r_s[2], k_s[2], v_s[2];
    {
        const unsigned zr2 = *(const GAS unsigned*)(zr + c0), zk2 = *(const GAS unsigned*)(zr + 1024 + c0), zv2 = *(const GAS unsigned*)(zr + 2048 + c0);
        const f32x2 pr = *(const GAS f32x2*)(sh + c0), pk = *(const GAS f32x2*)(sh + 1024 + c0), pv = *(const GAS f32x2*)(sh + 2048 + c0);
        const f32x2 mr = *(const GAS f32x2*)(mu + c0), mk = *(const GAS f32x2*)(mu + 1024 + c0), mv = *(const GAS f32x2*)(mu + 2048 + c0);
        float z;
        z = bf_lo(zr2); r_s[0] = z + mr.x * (pr.x - z); z = bf_hi(zr2); r_s[1] = z + mr.y * (pr.y - z);
        z = bf_lo(zk2); k_s[0] = z + mk.x * (pk.x - z); z = bf_hi(zk2); k_s[1] = z + mk.y * (pk.y - z);
        z = bf_lo(zv2); v_s[0] = z + mv.x * (pv.x - z); z = bf_hi(zv2); v_s[1] = z + mv.y * (pv.y - z);
    }
    for (int c = 2 * tid; c < SHIFTC; c += 2 * NWAVES * 64) { const unsigned z2 = *(const GAS unsigned*)(zr + c); *(GAS f32x2*)(F.out + O_SHS + (size_t)s * SHIFTC + c) = (f32x2){bf_lo(z2), bf_hi(z2)}; }
    if (tid < 128) {
        const int i = 2 * tid; const unsigned z2 = *(const GAS unsigned*)(zr + 3072 + i); const f32x2 p = *(const GAS f32x2*)(sh + 3072 + i), m = *(const GAS f32x2*)(mu + 3072 + i);
        float a = bf_lo(z2), b2 = bf_hi(z2); a = a + m.x * (p.x - a); b2 = b2 + m.y * (p.y - b2);
        if (i < 64) { a = ftanh(a); b2 = ftanh(b2); } else if (i >= 128) { a = fsig(a); b2 = fsig(b2); }
        *(LAS f32x2*)(lds + SJ_TW + i * 4) = (f32x2){a, b2};
    }
    WG_SYNC();
    float dd[2], al[2], gg[2];
#pragma unroll
    for (int e = 0; e < 2; ++e) {
        const int n = c0 + e;
        const GAS bf16* wd = (const GAS bf16*)(F.ws + WS_WDU) + (size_t)n * 64; const GAS bf16* wi = (const GAS bf16*)(F.ws + WS_WIU) + (size_t)n * 64; const GAS bf16* wg = (const GAS bf16*)(F.ws + WS_WGU) + (size_t)n * 128;
        float s1 = 0.f, s2 = 0.f, s3 = 0.f;
#pragma unroll 2
        for (int k8 = 0; k8 < 8; ++k8) { const v4u a = *(const GAS v4u*)(wd + 8 * k8), b4 = *(const GAS v4u*)(wi + 8 * k8);
            const f32x4 t0 = *(const LAS f32x4*)(lds + SJ_TW + k8 * 32), t1 = *(const LAS f32x4*)(lds + SJ_TW + k8 * 32 + 16), u0 = *(const LAS f32x4*)(lds + SJ_AD + k8 * 32), u1 = *(const LAS f32x4*)(lds + SJ_AD + k8 * 32 + 16);
            s1 += (bf_lo(a.x) * t0[0] + bf_hi(a.x) * t0[1]) + (bf_lo(a.y) * t0[2] + bf_hi(a.y) * t0[3]) + (bf_lo(a.z) * t1[0] + bf_hi(a.z) * t1[1]) + (bf_lo(a.w) * t1[2] + bf_hi(a.w) * t1[3]);
            s2 += (bf_lo(b4.x) * u0[0] + bf_hi(b4.x) * u0[1]) + (bf_lo(b4.y) * u0[2] + bf_hi(b4.y) * u0[3]) + (bf_lo(b4.z) * u1[0] + bf_hi(b4.z) * u1[1]) + (bf_lo(b4.w) * u1[2] + bf_hi(b4.w) * u1[3]); }
#pragma unroll 4
        for (int k8 = 0; k8 < 16; ++k8) { const v4u a = *(const GAS v4u*)(wg + 8 * k8);
            const f32x4 t0 = *(const LAS f32x4*)(lds + SJ_SG + k8 * 32), t1 = *(const LAS f32x4*)(lds + SJ_SG + k8 * 32 + 16);
            s3 += (bf_lo(a.x) * t0[0] + bf_hi(a.x) * t0[1]) + (bf_lo(a.y) * t0[2] + bf_hi(a.y) * t0[3]) + (bf_lo(a.z) * t1[0] + bf_hi(a.z) * t1[1]) + (bf_lo(a.w) * t1[2] + bf_hi(a.w) * t1[3]); }
        dd[e] = decay_of(F.inp(15)[n] + s1); al[e] = fsig(F.inp(17)[n] + s2); gg[e] = s3;
    }
    float bon;
    {
        const f32x2 ck = *(const GAS f32x2*)(F.inp(19) + c0), ca = *(const GAS f32x2*)(F.inp(20) + c0), crk = *(const GAS f32x2*)(F.inp(21) + c0);
        const float k0r = k_s[0] * ck.x, k1r = k_s[1] * ck.y; float ss = k0r * k0r + k1r * k1r;
#pragma unroll
        for (int o = 1; o < 32; o <<= 1) ss += __shfl_xor(ss, o);
        const float inv = 1.0f / fmaxf(sqrtf(ss), 1e-12f);
        const float kk0 = k0r * inv, kk1 = k1r * inv, km0 = k_s[0] * (1.0f + (al[0] - 1.0f) * ca.x), km1 = k_s[1] * (1.0f + (al[1] - 1.0f) * ca.y);
        bon = r_s[0] * km0 * crk.x + r_s[1] * km1 * crk.y;
#pragma unroll
        for (int o = 1; o < 32; o <<= 1) bon += __shfl_xor(bon, o);
        *(LAS f32x2*)(lds + SJ_KK + c0 * 4) = (f32x2){kk0, kk1}; *(LAS f32x2*)(lds + SJ_BB + c0 * 4) = (f32x2){kk0 * al[0], kk1 * al[1]}; *(LAS f32x2*)(lds + SJ_DD + c0 * 4) = (f32x2){dd[0], dd[1]};
        *(LAS f32x2*)(lds + SJ_KM + c0 * 4) = (f32x2){km0, km1}; *(LAS f32x2*)(lds + SJ_RR + c0 * 4) = (f32x2){r_s[0], r_s[1]}; *(LAS f32x2*)(lds + SJ_VV + c0 * 4) = (f32x2){v_s[0], v_s[1]};
    }
    WG_SYNC();
    {
        const int kq = lane & 15, rg = lane >> 4;
#pragma unroll 1
        for (int hh = 0; hh < 2; ++hh) {
            const int h = 2 * wave + hh;
            const f32x4 kk4 = *(const LAS f32x4*)(lds + SJ_KK + (64 * h + 4 * kq) * 4), b4 = *(const LAS f32x4*)(lds + SJ_BB + (64 * h + 4 * kq) * 4), d4 = *(const LAS f32x4*)(lds + SJ_DD + (64 * h + 4 * kq) * 4);
            const f32x4 km4 = *(const LAS f32x4*)(lds + SJ_KM + (64 * h + 4 * kq) * 4), r4 = *(const LAS f32x4*)(lds + SJ_RR + (64 * h + 4 * kq) * 4);
            const size_t sbase = ((size_t)(s * NHEAD + h) * 64) * 64;
#pragma unroll 2
            for (int ps = 0; ps < 8; ++ps) {
                const int v0 = 8 * ps + 2 * rg;
                f32x4 S0 = *(const GAS f32x4*)(F.inp(4) + sbase + (size_t)v0 * 64 + 4 * kq), S1 = *(const GAS f32x4*)(F.inp(4) + sbase + (size_t)(v0 + 1) * 64 + 4 * kq);
                const f32x2 v2 = *(const LAS f32x2*)(lds + SJ_VV + (64 * h + v0) * 4);
                float p0 = (S0[0] * kk4[0] + S0[1] * kk4[1]) + (S0[2] * kk4[2] + S0[3] * kk4[3]), p1 = (S1[0] * kk4[0] + S1[1] * kk4[1]) + (S1[2] * kk4[2] + S1[3] * kk4[3]);
                p0 = red16(p0); p1 = red16(p1);
#pragma unroll
                for (int j = 0; j < 4; ++j) { S0[j] = S0[j] * d4[j] + (v2.x * km4[j] - p0 * b4[j]); S1[j] = S1[j] * d4[j] + (v2.y * km4[j] - p1 * b4[j]); }
                float y0 = (S0[0] * r4[0] + S0[1] * r4[1]) + (S0[2] * r4[2] + S0[3] * r4[3]), y1 = (S1[0] * r4[0] + S1[1] * r4[1]) + (S1[2] * r4[2] + S1[3] * r4[3]);
                y0 = red16(y0); y1 = red16(y1);
                *(GAS f32x4*)(F.out + O_WKVS + sbase + (size_t)v0 * 64 + 4 * kq) = S0; *(GAS f32x4*)(F.out + O_WKVS + sbase + (size_t)(v0 + 1) * 64 + 4 * kq) = S1;
                if (kq == 0) *(LAS f32x2*)(lds + SJ_Y + (64 * h + v0) * 4) = (f32x2){y0, y1};
            }
        }
    }
    WG_SYNC();
    {
        const f32x2 y2 = *(const LAS f32x2*)(lds + SJ_Y + c0 * 4);
        float sm = y2.x + y2.y;
#pragma unroll
        for (int o = 1; o < 32; o <<= 1) sm += __shfl_xor(sm, o);
        const float mean = sm * (1.0f / 64.0f), d0 = y2.x - mean, d1 = y2.y - mean; float sv = d0 * d0 + d1 * d1;
#pragma unroll
        for (int o = 1; o < 32; o <<= 1) sv += __shfl_xor(sv, o);
        const float rstd = __builtin_amdgcn_rsqf(sv * (1.0f / 64.0f) + GN_EPS);
        const f32x2 gw = *(const GAS f32x2*)(F.inp(22) + c0), gb = *(const GAS f32x2*)(F.inp(23) + c0);
        const float ya0 = (d0 * rstd * gw.x + gb.x + bon * v_s[0]) * gg[0], ya1 = (d1 * rstd * gw.y + gb.y + bon * v_s[1]) * gg[1];
        const unsigned zB = *(const GAS unsigned*)(zr + 3328 + c0), zC = *(const GAS unsigned*)(zr + 4352 + c0), zU = *(const GAS unsigned*)(zr + 5376 + c0), zgA = *(const GAS unsigned*)(zr + 6400 + c0), zgB = *(const GAS unsigned*)(zr + 7424 + c0);
        const f32x2 cv0 = *(const GAS f32x2*)(F.inp(6) + (size_t)(s * 2) * D + c0), cv1 = *(const GAS f32x2*)(F.inp(6) + (size_t)(s * 2 + 1) * D + c0);
        const f32x2 w0 = *(const GAS f32x2*)(F.inp(24) + c0), w1 = *(const GAS f32x2*)(F.inp(24) + 1024 + c0), w2 = *(const GAS f32x2*)(F.inp(24) + 2048 + c0);
        const float cu0 = bf_lo(zC) * bf_lo(zU), cu1 = bf_hi(zC) * bf_hi(zU);
        const float yb0 = bf_lo(zB) * (w0.x * cv0.x + w1.x * cv1.x + w2.x * cu0), yb1 = bf_hi(zB) * (w0.y * cv0.y + w1.y * cv1.y + w2.y * cu1);
        const float m0 = fsig(bf_lo(zgA)) * ya0 + fsig(bf_lo(zgB)) * yb0, m1 = fsig(bf_hi(zgA)) * ya1 + fsig(bf_hi(zgB)) * yb1;
#if DBG_MIX
        *(GAS unsigned*)((GAS bf16*)(F.ws + WS_MIX) + (size_t)(MPR + s) * D + c0) = 0u; (void)m0; (void)m1;
#else
        *(GAS unsigned*)((GAS bf16*)(F.ws + WS_MIX) + (size_t)(MPR + s) * D + c0) = pg8::cvt_pk_bf16(m0, m1);
#endif
        *(GAS f32x2*)(F.out + O_CVS + (size_t)(s * 2) * D + c0) = cv1; *(GAS f32x2*)(F.out + O_CVS + (size_t)(s * 2 + 1) * D + c0) = (f32x2){cu0, cu1};
    }
    WG_SYNC();
}

struct Args { const float* in[34]; float* out; unsigned char* ws; int ph_lo, ph_hi, li, pad; };
__global__ void __launch_bounds__(NWAVES * 64, 2) mk_fwd(Args args) {
    extern __shared__ __attribute__((aligned(16))) unsigned char lds[];
    Frame F;
    F.lds = (LAS unsigned char*)lds;
    F.MISC = (volatile LAS unsigned*)(F.lds + MISC_OFF);
    F.tid = threadIdx.x; F.lane = F.tid & 63; F.wave = __builtin_amdgcn_readfirstlane(F.tid >> 6);
    F.G = gridDim.x; { const int bx = blockIdx.x; F.vcu = (F.G % 8 == 0) ? (bx % 8) * (F.G / 8) + bx / 8 : bx; }
    GAS unsigned char* ws = (GAS unsigned char*)args.ws; F.ws = ws; F.out = (GAS float*)args.out;
    F.ctl = (gu32*)(ws + WS_CTL);
    for (int u = F.tid; u < (LDS_BYTES - LDSCTL_OFF) / 4; u += NWAVES * 64) ((LAS unsigned*)(F.lds + LDSCTL_OFF))[u] = 0u;
    __syncthreads();
#pragma unroll
    for (int i = 0; i < 34; ++i) if (F.tid == i) *(LAS unsigned long long*)(F.lds + PTR_OFF + 8 * i) = (unsigned long long)args.in[i];
    __syncthreads();
    XcdBarrier bar; bar.bar = (unsigned*)(F.ctl + CW_BAR); bar.x = 0; bar.st = nullptr;
    if (N_LAUNCHES == 1) bar = xcd_barrier_post((unsigned*)(F.ctl + CW_BAR), F.MISC + 8);
#define GRID_BAR() do { if (N_LAUNCHES == 1) xcd_barrier(bar); } while (0)
    const int lo = args.ph_lo, hi = args.ph_hi;
#ifndef PH_MASK
#define PH_MASK 0x1fff
#endif
#define IN(k) (((PH_MASK >> (k)) & 1) && lo <= (k) && (k) < hi)
#define BOTH(k) (IN(k) && IN((k) + 1))
    GAS bf16* const XB = (GAS bf16*)(ws + WS_XB); GAS bf16* const MIXB = (GAS bf16*)(ws + WS_MIX); GAS bf16* const GU = (GAS bf16*)(ws + WS_GU); GAS float* const SSQ = (GAS float*)(ws + WS_SSQ);
    GAS float* const X = F.out;
#define GP(p) ((const bf16*)(p))

    if (IN(0)) { asm volatile("; MARK P0"); p0_prologue(F); if (BOTH(0)) GRID_BAR(); }
    if (IN(1)) { asm volatile("; MARK P1");
        pg8::Gemm g{GP(XB), GP(ws + WS_W1GU), MP, 2 * FF, D}; pg8::StaticOrder S; S.init(MP, 2 * FF, F.G, (int)blockIdx.x);
        pg8::EpiSwiglu E{GU, nullptr};
        pg8::gemm_phase<pg8::EpiSwiglu, pg8::StaticOrder, true, true>(F.lds + RING_OFF, g, S, E);
        if (BOTH(1)) GRID_BAR();
    }
    if (IN(2)) { asm volatile("; MARK P2");
        pg8::Gemm g{GP(GU), GP(ws + WS_W1D), MP, D, FF}; pg8::StaticOrder S; S.init(MP, D, F.G, (int)blockIdx.x);
        pg8::EpiRes E{F.inp(0), F.inp(1), X, XB, SSQ, 0.5f};
        pg8::gemm_phase<pg8::EpiRes, pg8::StaticOrder, true, true>(F.lds + RING_OFF, g, S, E);
        if (BOTH(2)) GRID_BAR();
    }
#pragma unroll 1
    for (int ch = 0; ch < 2; ++ch) {
        if (IN(3 + 2 * ch)) { asm volatile("; MARK P3");
            pg8::Gemm g{GP(XB), GP(ws + WS_WIN), MP, NIN, D}; pg8::ChunkOrder S; S.init(ch ? 33 : 32, NIN / 256, F.G, (int)blockIdx.x, ch);
            pg8::EpiZ E{(GAS bf16*)(ws + WS_Z), SSQ, F.out, ch};
            pg8::gemm_phase<pg8::EpiZ, pg8::ChunkOrder, true, true>(F.lds + RING_OFF, g, S, E);
            if (BOTH(3 + 2 * ch)) GRID_BAR();
        }
        if (IN(4 + 2 * ch)) { asm volatile("; MARK P4");
            for (int job = F.vcu; job < 256; job += F.G) {
                const int x = job >> 5, i = job & 31;
                if (i < 16) mix_job(F, x, i, ch);
                else if (ch) sample_job(F, 16 * x + (i - 16));
            }
            if (BOTH(4 + 2 * ch)) GRID_BAR();
        }
    }
#ifdef DBG_DUMP_MIX
    { GRID_BAR(); const int gw = F.vcu * NWAVES + F.wave, NGW = F.G * NWAVES;
      const GAS bf16* src = (DBG_DUMP_MIX == 2) ? (const GAS bf16*)(ws + WS_Z) : (const GAS bf16*)MIXB; const int ld = (DBG_DUMP_MIX == 2) ? NIN : D; const int nr = (DBG_DUMP_MIX == 2) ? 8192 : MV;
      for (int m = gw; m < nr; m += NGW) {
        for (int j = 0; j < 4; ++j) { const u32x2v w = *(const GAS u32x2v*)(src + (size_t)m * ld + DBG_COL0 + 256 * j + 4 * F.lane); *(GAS f32x4*)(F.out + (size_t)m * D + 256 * j + 4 * F.lane) = unpk4(w); } } }
#endif
    if (IN(7)) { asm volatile("; MARK P5");
        pg8::Gemm g{GP(MIXB), GP(ws + WS_WOUT), MP, D, D}; pg8::StaticOrder S; S.init(MP, D, F.G, (int)blockIdx.x);
        pg8::EpiRes E{X, X + (size_t)MPR * D, X, XB, SSQ, 1.0f};
        pg8::gemm_phase<pg8::EpiRes, pg8::StaticOrder, true, true>(F.lds + RING_OFF, g, S, E);
        if (BOTH(7)) GRID_BAR();
    }
    if (IN(8)) { asm volatile("; MARK P6");
        pg8::Gemm g{GP(XB), GP(ws + WS_W2GU), MP, 2 * FF, D}; pg8::StaticOrder S; S.init(MP, 2 * FF, F.G, (int)blockIdx.x);
        pg8::EpiSwiglu E{GU, SSQ};
        pg8::gemm_phase<pg8::EpiSwiglu, pg8::StaticOrder, true, true>(F.lds + RING_OFF, g, S, E);
        if (BOTH(8)) GRID_BAR();
    }
    if (IN(9)) { asm volatile("; MARK P7");
        pg8::Gemm g{GP(GU), GP(ws + WS_W2D), MP, D, FF}; pg8::StaticOrder S; S.init(MP, D, F.G, (int)blockIdx.x);
        pg8::EpiRes E{X, X + (size_t)MPR * D, X, XB, SSQ, 0.5f};
        pg8::gemm_phase<pg8::EpiRes, pg8::StaticOrder, true, true>(F.lds + RING_OFF, g, S, E);
        if (BOTH(9)) GRID_BAR();
    }
    if (IN(10)) { asm volatile("; MARK P8a");
        pg8::Gemm g{GP(ws + WS_PB), GP(ws + WS_WPP), MP, D, PLE}; pg8::StaticOrder S; S.init(MP, D, F.G, (int)blockIdx.x);
        pg8::EpiPP E{MIXB, D};
        pg8::gemm_phase<pg8::EpiPP, pg8::StaticOrder, true, true>(F.lds + RING_OFF, g, S, E);
        if (BOTH(10)) GRID_BAR();
    }
    if (IN(11)) { asm volatile("; MARK P8");
        pg8::Gemm g{GP(XB), GP(ws + WS_WPG), MP, D, D}; pg8::StaticOrder S; S.init(MP, D, F.G, (int)blockIdx.x);
        pg8::EpiPle E{X, MIXB, SSQ};
        pg8::gemm_phase<pg8::EpiPle, pg8::StaticOrder, true, true>(F.lds + RING_OFF, g, S, E);
        if (BOTH(11)) GRID_BAR();
    }
    if (IN(12)) { asm volatile("; MARK P9"); p9_final(F); }
#undef IN
#undef BOTH
}

extern "C" void kernel_launch(void* const* d_in, const int* in_sizes, int n_in, void* d_out, int out_size, void* d_ws, size_t ws_size, hipStream_t stream) {
    static int grid = 0;
    if (grid == 0) {
        if (n_in != 34 || in_sizes[0] != MPR * D || (size_t)out_size != O_END || ws_size < WS_END) { fprintf(stderr, "kernel_launch: unexpected shapes (n_in %d, in0 %d, out %d, ws %zu); nothing launched\n", n_in, n_in > 0 ? in_sizes[0] : -1, out_size, ws_size); grid = -1; return; }
        int dev = 0, cus = 0, per_cu = 0;
        if (hipGetDevice(&dev) != hipSuccess || hipDeviceGetAttribute(&cus, hipDeviceAttributeMultiprocessorCount, dev) != hipSuccess) { grid = -1; return; }
        if (hipFuncSetAttribute((const void*)mk_fwd, hipFuncAttributeMaxDynamicSharedMemorySize, LDS_BYTES) != hipSuccess) { fprintf(stderr, "kernel_launch: hipFuncSetAttribute failed\n"); grid = -1; return; }
        if (hipOccupancyMaxActiveBlocksPerMultiprocessor(&per_cu, (const void*)mk_fwd, NWAVES * 64, LDS_BYTES) != hipSuccess || per_cu < 1) { fprintf(stderr, "kernel_launch: occupancy query says %d blocks per CU\n", per_cu); (void)hipGetLastError(); grid = -1; return; }
        grid = cus;
        if (grid != 256) fprintf(stderr, "kernel_launch: note: %d CUs\n", grid);
    }
    if (grid < 0) return;
    if (hipMemsetAsync((char*)d_ws + WS_CTL, 0, CTL_ZERO_BYTES, stream) != hipSuccess) return;
    Args a{};
    for (int i = 0; i < 34; ++i) a.in[i] = (const float*)d_in[i];
    a.out = (float*)d_out; a.ws = (unsigned char*)d_ws;
    for (int li = 0; li < N_LAUNCHES; ++li) {
        a.ph_lo = (N_LAUNCHES == 1) ? 0 : li; a.ph_hi = (N_LAUNCHES == 1) ? N_PHASES : li + 1; a.li = li;
        hipLaunchKernelGGL(mk_fwd, dim3(grid), dim3(NWAVES * 64), LDS_BYTES, stream, a);
    }
}
```

```cpp
#include <hip/hip_runtime.h>
#include <cstdio>
#include <cstdint>
namespace pg8 {
#define PG8_LAS __attribute__((address_space(3)))
typedef unsigned short bf16_t;
typedef short bf16x8 __attribute__((ext_vector_type(8)));
typedef float f32x4 __attribute__((ext_vector_type(4)));
typedef unsigned u32x4 __attribute__((ext_vector_type(4)));
constexpr int BM = 256, BK = 64, HALF = 128, HTB = HALF * BK * 2  , STAGE_BYTES = 8 * HTB, NXCD = 8, WGM = 8;

__host__ __device__ __forceinline__ int lds_byte(int r, int c) { const int st = (r >> 4) * 2 + (c >> 5), rr = r & 15, cc = c & 31, ob = rr * 64 + cc * 2; return st * 1024 + (ob ^ (((ob >> 9) & 1) << 5)); }
__host__ __device__ __forceinline__ void stage_rc(int b, int& R, int& C) { const int st = b / 1024, sb = b % 1024, swz = sb ^ (((sb >> 9) & 1) << 5); R = (st >> 1) * 16 + swz / 64; C = (st & 1) * 32 + (swz % 64) / 2; }
__host__ __device__ __forceinline__ int perm32(int rho) { const int n = rho >> 4, i = rho & 15; return 8 * (i >> 2) + 4 * n + (i & 3); }

struct Unit { int pm, pn; };
struct Gemm { const bf16_t* A; const bf16_t* Bt; int M, N, K; };

struct StaticOrder {
    int nM, nN, nwg, G, c;
    __host__ __device__ void init(int M, int N, int G_, int c_) { nM = M / BM; nN = N / BM; nwg = nM * nN; G = G_; c = c_; }
    __host__ __device__ bool next(int i, Unit& u) const {
        const long L = (long)i * G + c; if (L >= nwg) return false;
        int wgid = (int)L; { const int q = nwg / NXCD, r = nwg % NXCD, xcd = wgid % NXCD, off = wgid / NXCD; wgid = (xcd < r ? xcd * (q + 1) : r * (q + 1) + (xcd - r) * q) + off; }
        const int nig = WGM * nN, gid = wgid / nig, fm = gid * WGM, gsz = (nM - fm) < WGM ? (nM - fm) : WGM;
        u.pm = fm + ((wgid % nig) % gsz); u.pn = (wgid % nig) / gsz; return true;
    }
    __device__ __forceinline__ void a_ready(const Unit&) const {}
    __device__ __forceinline__ void done(const Unit&) const {}
};


#define PG8_GAS __attribute__((address_space(1)))
constexpr int MP = 16640;
constexpr int MV = 16512;
constexpr int MPR = 16384;
constexpr int PM_LAST = 64;
constexpr int DM = 1024, FFN = 2816, NINC = 8448, SHC = 3328;
constexpr size_t O_SHP = 17432576, O_SHS = 25864192;

struct ChunkOrder {
    int nM, nN, nwg, G, c, chunk;
    __host__ __device__ void init(int nM_, int nN_, int G_, int c_, int chunk_) { nM = nM_; nN = nN_; nwg = nM * nN; G = G_; c = c_; chunk = chunk_; }
    __host__ __device__ bool next(int i, Unit& u) const {
        const long L = (long)i * G + c; if (L >= nwg) return false;
        int wgid = (int)L; { const int q = nwg / NXCD, r = nwg % NXCD, xcd = wgid % NXCD, off = wgid / NXCD; wgid = (xcd < r ? xcd * (q + 1) : r * (q + 1) + (xcd - r) * q) + off; }
        const int nig = WGM * nN, gid = wgid / nig, fm = gid * WGM, gsz = (nM - fm) < WGM ? (nM - fm) : WGM;
        const int lm = fm + ((wgid % nig) % gsz); u.pn = (wgid % nig) / gsz;
        u.pm = 8 * (lm >> 1) + 2 * chunk + (lm & 1); return true;
    }
    __device__ __forceinline__ void a_ready(const Unit&) const {}
    __device__ __forceinline__ void done(const Unit&) const {}
};

struct TailOrder {
    int c;
    __host__ __device__ void init(int c_) { c = c_; }
    __host__ __device__ bool next(int i, Unit& u) const {
        if (i > 0 || c < 16 || c >= 64) return false;
        const int L = c - 16, ch = 1 + (L >> 4), lm = L & 15; u.pn = 32; u.pm = 8 * (lm >> 1) + 2 * ch + (lm & 1); return true;
    }
    __device__ __forceinline__ void a_ready(const Unit&) const {}
    __device__ __forceinline__ void done(const Unit&) const {}
};

typedef __bf16 bf16x2_t __attribute__((ext_vector_type(2)));
__device__ __forceinline__ unsigned cvt_pk_bf16(float lo, float hi) { bf16x2_t v; v[0] = (__bf16)lo; v[1] = (__bf16)hi; return __builtin_bit_cast(unsigned, v); }
typedef unsigned u32x2 __attribute__((ext_vector_type(2)));
__device__ __forceinline__ float fsigmoid(float x) { return __builtin_amdgcn_rcpf(1.0f + __expf(-x)); }

constexpr int SCL_MAP_OFF = 131072, SCL_TAB_OFF = 131328, SCL_MAX_UNITS = 12;
template <class Sched> __device__ __forceinline__ void precompute_scales(PG8_LAS unsigned char* lds, const Sched& S, const PG8_GAS float* ssq) {
    int t = threadIdx.x; asm volatile("" : "+v"(t));
    const int row = t >> 1, half = t & 1;
    Unit u;
    for (int i = 0; i < SCL_MAX_UNITS && S.next(i, u); ++i) {
        const PG8_GAS float* q = ssq + (size_t)(8 * half) * MP + (u.pm * BM + row);
        float p = ((q[0] + q[MP]) + (q[2 * MP] + q[3 * MP])) + ((q[4 * (size_t)MP] + q[5 * (size_t)MP]) + (q[6 * (size_t)MP] + q[7 * (size_t)MP]));
        p += __shfl_xor(p, 1);
        if (half == 0) *(PG8_LAS float*)(lds + SCL_TAB_OFF + (i * 256 + row) * 4) = __builtin_amdgcn_rsqf(p * (1.0f / 1024.0f) + 1e-6f);
        if (t == 0) *(PG8_LAS int*)(lds + SCL_MAP_OFF + u.pm * 4) = i;
    }
    asm volatile("s_waitcnt lgkmcnt(0)" ::: "memory"); __builtin_amdgcn_s_barrier(); asm volatile("" ::: "memory");
}
__device__ __forceinline__ void row_scales(const PG8_LAS unsigned char* lds, int pm, int wr, int fr, float (&sc)[2][4]) {
    const int slot = *(const PG8_LAS int*)(lds + SCL_MAP_OFF + pm * 4);
    const PG8_LAS float* tb = (const PG8_LAS float*)(lds + SCL_TAB_OFF) + slot * 256 + wr * 64 + fr;
#pragma unroll
    for (int ai = 0; ai < 2; ++ai)
#pragma unroll
        for (int m = 0; m < 4; ++m) sc[ai][m] = tb[ai * HALF + m * 16];
}

struct EpiSwiglu {
    static constexpr bool PERM = true, AFTER_DRAIN = false;
    PG8_GAS bf16_t* O; const PG8_LAS unsigned char* sl; bool scaled;
    __device__ __forceinline__ void operator()(const f32x4 (&acc)[2][2][4][2], const Unit& u, int wr, int wc, int fr, int fq) const {
        float sc[2][4];
        if (scaled) row_scales(sl, u.pm, wr, fr, sc);
        else {
#pragma unroll
            for (int ai = 0; ai < 2; ++ai)
#pragma unroll
                for (int m = 0; m < 4; ++m) sc[ai][m] = 1.0f; }
        const int col0 = u.pn * HALF + wc * 32 + 8 * fq;
#pragma unroll
        for (int ai = 0; ai < 2; ++ai)
#pragma unroll
            for (int m = 0; m < 4; ++m) {
                const int row = u.pm * BM + ai * HALF + wr * 64 + m * 16 + fr; const float s = sc[ai][m];
                const f32x4 g0 = acc[ai][0][m][0] * s, g1 = acc[ai][0][m][1] * s, u0 = acc[ai][1][m][0] * s, u1 = acc[ai][1][m][1] * s;
                f32x4 v0, v1;
#pragma unroll
                for (int j = 0; j < 4; ++j) { v0[j] = g0[j] * fsigmoid(g0[j]) * u0[j]; v1[j] = g1[j] * fsigmoid(g1[j]) * u1[j]; }
                u32x4 w; w.x = cvt_pk_bf16(v0[0], v0[1]); w.y = cvt_pk_bf16(v0[2], v0[3]); w.z = cvt_pk_bf16(v1[0], v1[1]); w.w = cvt_pk_bf16(v1[2], v1[3]);
                *(PG8_GAS u32x4*)(O + (size_t)row * FFN + col0) = w; }
    }
};

struct EpiRes {
    static constexpr bool PERM = true, AFTER_DRAIN = false;
    const PG8_GAS float* inF; PG8_GAS bf16_t* XB; PG8_GAS float* ssq; float alpha;
    __device__ __forceinline__ void operator()(const f32x4 (&acc)[2][2][4][2], const Unit& u, int wr, int wc, int fr, int fq) const {
        const int col0 = u.pn * BM + wc * 32 + 8 * fq;
#pragma unroll
        for (int ai = 0; ai < 2; ++ai) {
#pragma unroll
            for (int m = 0; m < 4; ++m) {
                const int row = u.pm * BM + ai * HALF + wr * 64 + m * 16 + fr; const size_t off = (size_t)row * DM + col0;
                f32x4 xin[2][2];
                if (inF) {
#pragma unroll
                    for (int bj = 0; bj < 2; ++bj) { xin[bj][0] = *(const PG8_GAS f32x4*)(inF + off + bj * HALF); xin[bj][1] = *(const PG8_GAS f32x4*)(inF + off + bj * HALF + 4); }
                } else {
#pragma unroll
                    for (int bj = 0; bj < 2; ++bj) { const u32x4 p = *(const PG8_GAS u32x4*)(XB + off + bj * HALF);
                        xin[bj][0][0] = __uint_as_float(p.x << 16); xin[bj][0][1] = __uint_as_float(p.x & 0xffff0000u); xin[bj][0][2] = __uint_as_float(p.y << 16); xin[bj][0][3] = __uint_as_float(p.y & 0xffff0000u);
                        xin[bj][1][0] = __uint_as_float(p.z << 16); xin[bj][1][1] = __uint_as_float(p.z & 0xffff0000u); xin[bj][1][2] = __uint_as_float(p.w << 16); xin[bj][1][3] = __uint_as_float(p.w & 0xffff0000u); }
                }
                float q = 0.f;
#pragma unroll
                for (int bj = 0; bj < 2; ++bj) { const f32x4 x0 = xin[bj][0] + acc[ai][bj][m][0] * alpha, x1 = xin[bj][1] + acc[ai][bj][m][1] * alpha;
                    u32x4 w; w.x = cvt_pk_bf16(x0[0], x0[1]); w.y = cvt_pk_bf16(x0[2], x0[3]); w.z = cvt_pk_bf16(x1[0], x1[1]); w.w = cvt_pk_bf16(x1[2], x1[3]);
                    *(PG8_GAS u32x4*)(XB + off + bj * HALF) = w;
                    q += ((x0[0] * x0[0] + x0[1] * x0[1]) + (x0[2] * x0[2] + x0[3] * x0[3])) + ((x1[0] * x1[0] + x1[1] * x1[1]) + (x1[2] * x1[2] + x1[3] * x1[3])); }
                q += __shfl_xor(q, 16); q += __shfl_xor(q, 32);
                if (fq == 0) ssq[(size_t)(4 * u.pn + wc) * MP + row] = q;
                if (m & 1) asm volatile("" ::: "memory"); }
        }
    }
};

struct EpiZ {
    static constexpr bool PERM = true, AFTER_DRAIN = false;
    PG8_GAS bf16_t* Z; const PG8_LAS unsigned char* sl; PG8_GAS bf16_t* ZX;
    __device__ __forceinline__ void operator()(const f32x4 (&acc)[2][2][4][2], const Unit& u, int wr, int wc, int fr, int fq) const {
        float sc[2][4]; row_scales(sl, u.pm, wr, fr, sc);
        const int lm = 2 * (u.pm >> 3) + (u.pm & 1);
        const int col0 = u.pn * BM + wc * 32 + 8 * fq;
#pragma unroll
        for (int ai = 0; ai < 2; ++ai)
#pragma unroll
            for (int m = 0; m < 4; ++m) {
                const int rt = ai * HALF + wr * 64 + m * 16 + fr, lrow = lm * BM + rt, grow = u.pm * BM + rt; const float s = sc[ai][m];
                PG8_GAS bf16_t* zp = (u.pn == 32) ? ZX + ((size_t)(((u.pm & 7) >> 1) * 16 * BM + lrow) * 256 + wc * 32 + 8 * fq) : Z + (size_t)lrow * NINC + col0;
#pragma unroll
                for (int bj = 0; bj < 2; ++bj) { const f32x4 v0 = acc[ai][bj][m][0] * s, v1 = acc[ai][bj][m][1] * s;
                    u32x4 w; w.x = cvt_pk_bf16(v0[0], v0[1]); w.y = cvt_pk_bf16(v0[2], v0[3]); w.z = cvt_pk_bf16(v1[0], v1[1]); w.w = cvt_pk_bf16(v1[2], v1[3]);
                    *(PG8_GAS u32x4*)(zp + bj * HALF) = w; }
            }
    }
};

struct EpiPP {
    static constexpr bool PERM = true, AFTER_DRAIN = false;
    PG8_GAS bf16_t* O; int ldc;
    __device__ __forceinline__ void operator()(const f32x4 (&acc)[2][2][4][2], const Unit& u, int wr, int wc, int fr, int fq) const {
        const int col0 = u.pn * BM + wc * 32 + 8 * fq;
#pragma unroll
        for (int ai = 0; ai < 2; ++ai)
#pragma unroll
            for (int m = 0; m < 4; ++m) { PG8_GAS bf16_t* rowp = O + (size_t)(u.pm * BM + ai * HALF + wr * 64 + m * 16 + fr) * ldc + col0;
#pragma unroll
                for (int bj = 0; bj < 2; ++bj) { const f32x4 v0 = acc[ai][bj][m][0], v1 = acc[ai][bj][m][1];
                    u32x4 w; w.x = cvt_pk_bf16(v0[0], v0[1]); w.y = cvt_pk_bf16(v0[2], v0[3]); w.z = cvt_pk_bf16(v1[0], v1[1]); w.w = cvt_pk_bf16(v1[2], v1[3]);
                    *(PG8_GAS u32x4*)(rowp + bj * HALF) = w; } }
    }
};

struct EpiPle {
    static constexpr bool PERM = true, AFTER_DRAIN = false;
    const PG8_GAS bf16_t* XB; PG8_GAS bf16_t* XF; const PG8_GAS bf16_t* PP; const PG8_LAS unsigned char* sl;
    __device__ __forceinline__ void operator()(const f32x4 (&acc)[2][2][4][2], const Unit& u, int wr, int wc, int fr, int fq) const {
        float sc[2][4]; row_scales(sl, u.pm, wr, fr, sc);
        const int col0 = u.pn * BM + wc * 32 + 8 * fq;
#pragma unroll
        for (int ai = 0; ai < 2; ++ai) {
#pragma unroll
            for (int m = 0; m < 4; ++m) {
                const int row = u.pm * BM + ai * HALF + wr * 64 + m * 16 + fr; const size_t off = (size_t)row * DM + col0; const float s = sc[ai][m];
                u32x4 xr[2], pr[2];
#pragma unroll
                for (int bj = 0; bj < 2; ++bj) { xr[bj] = *(const PG8_GAS u32x4*)(XB + off + bj * HALF); pr[bj] = *(const PG8_GAS u32x4*)(PP + off + bj * HALF); }
#pragma unroll
                for (int bj = 0; bj < 2; ++bj) {
                    const unsigned xs[4] = {xr[bj].x, xr[bj].y, xr[bj].z, xr[bj].w}, ps[4] = {pr[bj].x, pr[bj].y, pr[bj].z, pr[bj].w};
                    unsigned o[4];
#pragma unroll
                    for (int j = 0; j < 4; ++j) { const float a0 = acc[ai][bj][m][j >> 1][2 * (j & 1)] * s, a1 = acc[ai][bj][m][j >> 1][2 * (j & 1) + 1] * s;
                        const float y0 = __uint_as_float(xs[j] << 16) + fsigmoid(a0) * __uint_as_float(ps[j] << 16), y1 = __uint_as_float(xs[j] & 0xffff0000u) + fsigmoid(a1) * __uint_as_float(ps[j] & 0xffff0000u);
                        o[j] = cvt_pk_bf16(y0, y1); }
                    u32x4 w; w.x = o[0]; w.y = o[1]; w.z = o[2]; w.w = o[3];
                    *(PG8_GAS u32x4*)(XF + off + bj * HALF) = w; }
                if (m & 1) asm volatile("" ::: "memory"); }
        }
    }
};

template <class Epi, class Sched, bool ALIGN_EPI = false, bool SP2 = false>
__device__ __forceinline__ void gemm_phase(PG8_LAS unsigned char* lds, const Gemm g, const Sched& S, const Epi& E) {
    int tid_ = threadIdx.x; asm volatile("" : "+v"(tid_));
    const int tid = tid_, wid = __builtin_amdgcn_readfirstlane(tid >> 6), lane = tid & 63, wr = wid >> 2, wc = wid & 3, fr = lane & 15, fq = lane >> 4;
    const int K = g.K, nt = K / BK;
    unsigned voffA[2], voffB[2];
#pragma unroll
    for (int i = 0; i < 2; ++i) { int R, C; stage_rc(tid * 16 + i * 8192, R, C); const int Rb = Epi::PERM ? ((R & ~31) + perm32(R & 31)) : R;
        voffA[i] = (unsigned)(R * K + C) * 2u; voffB[i] = (unsigned)(Rb * K + C) * 2u; }
    const size_t kstep = (size_t)(BK * 2);
    const size_t hstep = (size_t)HALF * K * 2;
    const size_t tstep = 2 * hstep;
    const unsigned ldsw = (unsigned)wid * 1024u;
    const int aoff = lds_byte(wr * 64 + fr, fq * 8), boff = lds_byte(wc * 32 + fr, fq * 8);
#define PG8_SA(b, h) (((b) * 2 + (h)) * HTB)
#define PG8_SB(b, h) ((4 + (b) * 2 + (h)) * HTB)
#define PG8_STAGE(bufoff, gbase, voff) do { _Pragma("unroll") for (int _i = 0; _i < 2; ++_i) \
        __builtin_amdgcn_global_load_lds((const unsigned*)((const char*)(gbase) + (voff)[_i]), (PG8_LAS unsigned*)(lds + (bufoff) + ldsw + _i * 8192), 16, 0, 0); } while (0)
#define PG8_LDA(dst, b, h) do { _Pragma("unroll") for (int m = 0; m < 4; ++m) _Pragma("unroll") for (int k = 0; k < 2; ++k) dst[m][k] = *(const PG8_LAS bf16x8*)(lds + PG8_SA(b, h) + aoff + m * 2048 + k * 1024); } while (0)
#define PG8_LDB(dst, b, h) do { _Pragma("unroll") for (int n = 0; n < 2; ++n) _Pragma("unroll") for (int k = 0; k < 2; ++k) dst[n][k] = *(const PG8_LAS bf16x8*)(lds + PG8_SB(b, h) + boff + n * 2048 + k * 1024); } while (0)
#define PG8_MMA(ai, bj, At, Bt) do { __builtin_amdgcn_s_setprio(1); _Pragma("unroll") for (int m = 0; m < 4; ++m) _Pragma("unroll") for (int n = 0; n < 2; ++n) _Pragma("unroll") for (int k = 0; k < 2; ++k) \
        acc[ai][bj][m][n] = __builtin_amdgcn_mfma_f32_16x16x32_bf16(Bt[n][k], At[m][k], acc[ai][bj][m][n], 0, 0, 0); __builtin_amdgcn_s_setprio(0); } while (0)
#define PG8_WAIT_V(n) asm volatile("s_waitcnt vmcnt(" #n ")" ::: "memory")
#define PG8_WAIT_L(n) asm volatile("s_waitcnt lgkmcnt(" #n ")" ::: "memory")
#define PG8_BAR __builtin_amdgcn_s_barrier()
#define PG8_SCHED __builtin_amdgcn_sched_barrier(0)
    Unit cur, nxt; int ui = 0;
    if (!S.next(0, cur)) return;
    f32x4 acc[2][2][4][2];
#pragma unroll
    for (int a = 0; a < 2; ++a)
#pragma unroll
        for (int b = 0; b < 2; ++b)
#pragma unroll
            for (int m = 0; m < 4; ++m)
#pragma unroll
                for (int n = 0; n < 2; ++n) acc[a][b][m][n] = (f32x4){0.f, 0.f, 0.f, 0.f};
    bf16x8 At[4][2], B0[2][2], B1[2][2];
    const char* cA = (const char*)g.A + (size_t)cur.pm * tstep; const char* cB = (const char*)g.Bt + (size_t)cur.pn * tstep;
    S.a_ready(cur);
    if constexpr (SP2) {
        PG8_STAGE(PG8_SB(0, 0), cB, voffB); PG8_STAGE(PG8_SB(0, 1), cB + hstep, voffB); PG8_STAGE(PG8_SA(0, 0), cA, voffA); PG8_STAGE(PG8_SA(0, 1), cA + hstep, voffA);
        if (wr == 1) PG8_BAR;
        PG8_WAIT_V(2); PG8_BAR;
        PG8_STAGE(PG8_SB(1, 0), cB + kstep, voffB); PG8_STAGE(PG8_SA(1, 0), cA + kstep, voffA); PG8_STAGE(PG8_SB(1, 1), cB + hstep + kstep, voffB);
        PG8_WAIT_V(6); PG8_BAR;
    } else {
        PG8_STAGE(PG8_SB(0, 0), cB, voffB); PG8_STAGE(PG8_SA(0, 0), cA, voffA); PG8_STAGE(PG8_SB(0, 1), cB + hstep, voffB); PG8_STAGE(PG8_SA(0, 1), cA + hstep, voffA);
        if (wr == 1) PG8_BAR;
        PG8_WAIT_V(4); PG8_BAR;
        PG8_STAGE(PG8_SB(1, 0), cB + kstep, voffB); PG8_STAGE(PG8_SA(1, 0), cA + kstep, voffA); PG8_STAGE(PG8_SB(1, 1), cB + hstep + kstep, voffB);
        PG8_WAIT_V(6); PG8_BAR;
    }
    for (;;) {
        const bool has_next = S.next(ui + 1, nxt);
        const bool full_a = (cur.pm != PM_LAST);
        const char* nA = has_next ? (const char*)g.A + (size_t)nxt.pm * tstep : cA; const char* nB = has_next ? (const char*)g.Bt + (size_t)nxt.pn * tstep : cB;
#pragma unroll 1
        for (int t = 0; t < nt; t += 2) {
            const bool last = (t == nt - 2);
            const char* a1 = cA + (size_t)(t + 1) * kstep;
            const char* a2 = last ? nA : cA + (size_t)(t + 2) * kstep; const char* b2 = last ? nB : cB + (size_t)(t + 2) * kstep;
            const char* a3 = a2 + kstep; const char* b3 = b2 + kstep;
            if (last && has_next) S.a_ready(nxt);
            if constexpr (SP2) {
            PG8_LDB(B0, 0, 0); PG8_LDB(B1, 0, 1); PG8_SCHED; PG8_LDA(At, 0, 0); PG8_STAGE(PG8_SA(1, 1), a1 + hstep, voffA);
            PG8_WAIT_V(8); PG8_WAIT_L(0); PG8_BAR; PG8_MMA(0, 0, At, B0); PG8_MMA(0, 1, At, B1); PG8_BAR; PG8_SCHED;
            PG8_LDA(At, 0, 1); PG8_STAGE(PG8_SB(0, 0), b2, voffB); PG8_STAGE(PG8_SB(0, 1), b2 + hstep, voffB); PG8_STAGE(PG8_SA(0, 0), a2, voffA);
            PG8_WAIT_V(8); PG8_WAIT_L(0); PG8_BAR; if (full_a) { PG8_MMA(1, 0, At, B0); PG8_MMA(1, 1, At, B1); } PG8_BAR; PG8_SCHED;
            PG8_LDB(B0, 1, 0); PG8_LDB(B1, 1, 1); PG8_SCHED; PG8_LDA(At, 1, 0); PG8_STAGE(PG8_SA(0, 1), a2 + hstep, voffA);
            PG8_WAIT_V(8); PG8_WAIT_L(0); PG8_BAR; PG8_MMA(0, 0, At, B0); PG8_MMA(0, 1, At, B1); PG8_BAR; PG8_SCHED;
            PG8_LDA(At, 1, 1); PG8_STAGE(PG8_SB(1, 0), b3, voffB); PG8_STAGE(PG8_SB(1, 1), b3 + hstep, voffB); PG8_STAGE(PG8_SA(1, 0), a3, voffA);
            PG8_WAIT_V(8); PG8_WAIT_L(0); PG8_BAR; if (full_a) { PG8_MMA(1, 0, At, B0); PG8_MMA(1, 1, At, B1); } PG8_BAR; PG8_SCHED;
            } else {
            PG8_LDB(B0, 0, 0); PG8_SCHED; PG8_LDA(At, 0, 0); PG8_STAGE(PG8_SA(1, 1), a1 + hstep, voffA);
            PG8_WAIT_L(8); PG8_BAR; PG8_WAIT_L(0); PG8_MMA(0, 0, At, B0); PG8_BAR; PG8_SCHED;
            PG8_LDB(B1, 0, 1); PG8_STAGE(PG8_SB(0, 0), b2, voffB);
            PG8_BAR; PG8_WAIT_L(0); PG8_MMA(0, 1, At, B1); PG8_BAR;
            PG8_LDA(At, 0, 1); PG8_STAGE(PG8_SA(0, 0), a2, voffA);
            PG8_BAR; PG8_WAIT_L(0); PG8_MMA(1, 0, At, B0); PG8_BAR; PG8_SCHED;
            PG8_STAGE(PG8_SB(0, 1), b2 + hstep, voffB);
            PG8_WAIT_V(6); PG8_BAR; PG8_MMA(1, 1, At, B1); PG8_BAR;
            PG8_LDB(B0, 1, 0); PG8_SCHED; PG8_LDA(At, 1, 0); PG8_STAGE(PG8_SA(0, 1), a2 + hstep, voffA);
            PG8_WAIT_L(8); PG8_BAR; PG8_WAIT_L(0); PG8_MMA(0, 0, At, B0); PG8_BAR; PG8_SCHED;
            PG8_LDB(B1, 1, 1); PG8_STAGE(PG8_SB(1, 0), b3, voffB);
            PG8_BAR; PG8_WAIT_L(0); PG8_MMA(0, 1, At, B1); PG8_BAR;
            PG8_LDA(At, 1, 1); PG8_STAGE(PG8_SA(1, 0), a3, voffA);
            PG8_BAR; PG8_WAIT_L(0); PG8_MMA(1, 0, At, B0); PG8_BAR; PG8_SCHED;
            PG8_STAGE(PG8_SB(1, 1), b3 + hstep, voffB);
            PG8_WAIT_V(6); PG8_BAR; PG8_MMA(1, 1, At, B1); PG8_BAR;
            }
        }
        if constexpr (ALIGN_EPI) { if (wr == 0) PG8_BAR; }
        if constexpr (!Epi::AFTER_DRAIN) { E(acc, cur, wr, wc, fr, fq); S.done(cur); }
        if (!has_next) break;
#pragma unroll
        for (int a = 0; a < 2; ++a)
#pragma unroll
            for (int b = 0; b < 2; ++b)
#pragma unroll
                for (int m = 0; m < 4; ++m)
#pragma unroll
                    for (int n = 0; n < 2; ++n) acc[a][b][m][n] = (f32x4){0.f, 0.f, 0.f, 0.f};
        cur = nxt; cA = nA; cB = nB; ++ui;
        if constexpr (ALIGN_EPI) { if (wr == 1) PG8_BAR; }
    }
    PG8_WAIT_V(0);
    if constexpr (!ALIGN_EPI) { if (wr == 0) PG8_BAR; }
    PG8_BAR;
    if constexpr (Epi::AFTER_DRAIN) { E.fused(acc, cur, wr, wc, fr, fq, lds, wid, lane); S.done(cur); }
#undef PG8_SA
#undef PG8_SB
#undef PG8_STAGE
#undef PG8_LDA
#undef PG8_LDB
#undef PG8_MMA
#undef PG8_WAIT_V
#undef PG8_WAIT_L
#undef PG8_BAR
#undef PG8_SCHED
}
}
#define GAS __attribute__((address_space(1)))
#define LAS __attribute__((address_space(3)))
typedef unsigned short bf16;
typedef unsigned v4u __attribute__((ext_vector_type(4)));
typedef float f32x4 __attribute__((ext_vector_type(4)));
typedef short bf16x8 __attribute__((ext_vector_type(8)));
typedef GAS unsigned gu32;
typedef GAS unsigned long long gu64;
#define RLX_AGENT __ATOMIC_RELAXED, __HIP_MEMORY_SCOPE_AGENT
#define LDS_WAIT() asm volatile("s_waitcnt lgkmcnt(0)" ::: "memory")
#define VM_WAIT() asm volatile("s_waitcnt vmcnt(0)" ::: "memory")
__device__ __forceinline__ unsigned long long rt() { return __builtin_amdgcn_s_memrealtime(); }
__device__ __forceinline__ unsigned f2bf(float f) { unsigned u = __builtin_bit_cast(unsigned, f); return (u + 0x7fffu + ((u >> 16) & 1u)) >> 16; }
__device__ __forceinline__ unsigned pk2(float lo, float hi) { return f2bf(lo) | (f2bf(hi) << 16); }

#define XB_TMO      128
#define XB_XCNT(j)  (256  + 64 * (j))
#define XB_XSUB(j)  (1280 + 64 * (j))
#define XB_XGEN(j)  (2304 + 64 * (j))
#define XB_TOP      3328
#define XB_TOPGEN   3392
#define XCD_BAR_WORDS 3456
#define XB_SPIN_CAP (1u << 18)

__device__ __forceinline__ unsigned xb_ld(unsigned* p)              { return __hip_atomic_load(p, __ATOMIC_RELAXED, __HIP_MEMORY_SCOPE_AGENT); }
__device__ __forceinline__ unsigned xb_add(unsigned* p, unsigned v) { return __hip_atomic_fetch_add(p, v, __ATOMIC_RELAXED, __HIP_MEMORY_SCOPE_AGENT); }
__device__ __forceinline__ unsigned xb_xcc_id() { return (unsigned)__builtin_amdgcn_s_getreg((3 << 11) | 20) & 0xFu; }
#define XB_SPIN(cond, bar) do { unsigned _sp = 0; while (cond) { __builtin_amdgcn_s_sleep(1); \
    if ((++_sp & 255u) == 0u) { if (xb_ld(&(bar)[XB_TMO])) break; if (_sp > XB_SPIN_CAP) { atomicAdd(&(bar)[XB_TMO], 1u); break; } } } } while (0)

struct XcdBarrier {
    unsigned* bar; unsigned x;
    volatile LAS unsigned* st;
};

__device__ __forceinline__ XcdBarrier xcd_barrier_post(unsigned* bar, volatile LAS unsigned* st) {
    XcdBarrier b; b.bar = bar; b.x = xb_xcc_id(); b.st = st;
    if (threadIdx.x == 0) (void)xb_add(&bar[XB_XCNT(b.x)], 1u);
    return b;
}
__device__ __forceinline__ void xcd_barrier_complete(unsigned* bar, unsigned x, unsigned& nloc, unsigned& nx) {
    const unsigned G = gridDim.x * gridDim.y * gridDim.z;
    unsigned sum, cnt, mine, sp = 0u;
    for (;;) {
        sum = 0u; cnt = 0u; mine = 0u;
#pragma unroll
        for (unsigned j = 0; j < 16; ++j) { const unsigned c = xb_ld(&bar[XB_XCNT(j)]); sum += c; cnt += (c > 0u) ? 1u : 0u; mine = (j == x) ? c : mine; }
        if (sum == G) break;
        __builtin_amdgcn_s_sleep(1);
        if ((++sp & 255u) == 0u) { if (xb_ld(&bar[XB_TMO])) break; if (sp > XB_SPIN_CAP) { atomicAdd(&bar[XB_TMO], 1u); break; } }
    }
    nloc = mine > 0u ? mine : 1u; nx = cnt > 0u ? cnt : 1u;
}

__device__ __forceinline__ void xcd_barrier(const XcdBarrier& b) {
    asm volatile("s_waitcnt vmcnt(0)" ::: "memory");
    __syncthreads();
    if (threadIdx.x == 0) {
        unsigned* bar = b.bar;
        __builtin_amdgcn_s_waitcnt(0);
        unsigned nloc = b.st[0], nx = b.st[1];
        if (nloc == 0u) { xcd_barrier_complete(bar, b.x, nloc, nx); b.st[0] = nloc; b.st[1] = nx; }
        const unsigned old = xb_add(&bar[XB_XSUB(b.x)], 1u);
        const unsigned gen = old / nloc;
        if (old + 1u == (gen + 1u) * nloc) {
            __builtin_amdgcn_fence(__ATOMIC_RELEASE, "agent");
            asm volatile("s_waitcnt vmcnt(0)" ::: "memory");
            const unsigned og = xb_add(&bar[XB_TOP], 1u);
            const unsigned tg = og / nx;
            if (og + 1u == (tg + 1u) * nx) xb_add(&bar[XB_TOPGEN], 1u);
            else XB_SPIN(xb_ld(&bar[XB_TOPGEN]) == tg, bar);
            __builtin_amdgcn_fence(__ATOMIC_ACQUIRE, "agent");
            xb_add(&bar[XB_XGEN(b.x)], 1u);
            asm volatile("s_waitcnt vmcnt(0)" ::: "memory");
        } else {
            XB_SPIN(xb_ld(&bar[XB_XGEN(b.x)]) == gen, bar);
            __builtin_amdgcn_fence(__ATOMIC_ACQUIRE, "agent");
            asm volatile("s_waitcnt vmcnt(0)" ::: "memory");
        }
    }
    __syncthreads();
}


constexpr int NWAVES = 8;
#ifndef REP_P5
#define REP_P5 1
#define REP_P6 1
#define REP_P3 1
#define REP_P8A 1
#endif
#ifndef DBG_MIX
#define DBG_MIX 0
#endif
#ifndef MK_N_LAUNCHES
#define MK_N_LAUNCHES 1
#endif
constexpr int N_PHASES = 14;
constexpr int N_LAUNCHES = MK_N_LAUNCHES;

constexpr int D = 1024, FF = 2816, NIN = 8448, SHIFTC = 3328, PLE = 256, TSEQ = 2048, NBATCH = 8, NSAMP = 128, NHEAD = 16;
constexpr int MP = pg8::MP, MV = pg8::MV, MPR = pg8::MPR;
constexpr float RMS_EPS = 1e-6f, GN_EPS = 64e-5f;
constexpr size_t O_YP = 0, O_YS = 16777216, O_WKVP = 16908288, O_SHP = 17432576, O_CVP = 17459200, O_WKVS = 17475584, O_SHS = 25864192, O_CVS = 26290176, O_END = 26552320;
constexpr size_t MiB = 1u << 20;
constexpr size_t WS_CTL = 0, CTL_ZERO_BYTES = 1 * MiB;
constexpr size_t WS_WIN = 1 * MiB;
constexpr size_t WS_WOUT = WS_WIN + (size_t)NIN * D * 2;
constexpr size_t WS_W2GU = WS_WOUT + (size_t)D * D * 2;
constexpr size_t WS_W2D = WS_W2GU + (size_t)2 * FF * D * 2;
constexpr size_t WS_WPG = WS_W2D + (size_t)D * FF * 2;
constexpr size_t WS_WPP = WS_WPG + (size_t)D * D * 2;
constexpr size_t WS_WDU = WS_WPP + (size_t)D * PLE * 2;
constexpr size_t WS_WIU = WS_WDU + (size_t)D * 64 * 2;
constexpr size_t WS_WGU = WS_WIU + (size_t)D * 64 * 2;
constexpr size_t WS_PB = WS_WGU + (size_t)D * 128 * 2;
constexpr size_t WS_XB = WS_PB + (size_t)MP * PLE * 2;
constexpr size_t WS_MIX = WS_XB + (size_t)MP * D * 2;
constexpr size_t WS_SSQ = WS_MIX + (size_t)MP * D * 2;
constexpr size_t WS_CAR = WS_SSQ + (size_t)16 * MP * 4;
constexpr size_t WS_R = (WS_CAR + (size_t)128 * 576 * 4 + 4095) / 4096 * 4096;
constexpr size_t WS_W1GU = WS_R;
constexpr size_t WS_W1D = WS_W1GU + (size_t)2 * FF * D * 2;
constexpr size_t WS_GU = WS_W1D + (size_t)D * FF * 2;
constexpr int NTC = 4, TCH = TSEQ / NTC;
constexpr size_t ZCH_BYTES = (size_t)NBATCH * TCH * NIN * 2;
constexpr size_t WS_Z = WS_R;
constexpr size_t WS_ZS = WS_Z + 2 * ZCH_BYTES;
constexpr size_t WS_ZX = WS_ZS + (size_t)NSAMP * NIN * 2;
constexpr size_t WS_END = 256 * MiB;
static_assert(WS_GU + (size_t)MP * FF * 2 <= WS_END && WS_ZX + (size_t)NTC * NBATCH * TCH * 256 * 2 <= WS_END, "d_ws map");
constexpr int CW_BAR = 4096;
constexpr int RING_OFF = 0, RING_BYTES = 131072;
constexpr int LDSCTL_OFF = 155648, MISC_OFF = LDSCTL_OFF + 320, PTR_OFF = LDSCTL_OFF + 1024;
constexpr int LDS_BYTES = 163840;
static_assert(MISC_OFF + 128 <= LDS_BYTES, "LDS map");

#define WG_SYNC() do { asm volatile("s_waitcnt lgkmcnt(0)" ::: "memory"); __builtin_amdgcn_s_barrier(); asm volatile("" ::: "memory"); } while (0)

typedef unsigned u32x2v __attribute__((ext_vector_type(2)));
typedef float f32x2 __attribute__((ext_vector_type(2)));

struct Frame {
    LAS unsigned char* lds;
    volatile LAS unsigned* MISC;
    gu32* ctl;
    int tid, lane, wave, vcu, G;
    GAS float* out; GAS unsigned char* ws;
    __device__ __forceinline__ const GAS float* inp(int k) const { const u32x2v p = *(const LAS u32x2v*)(lds + PTR_OFF + 8 * k); const unsigned long long a = ((unsigned long long)(unsigned)__builtin_amdgcn_readfirstlane((int)p.y) << 32) | (unsigned)__builtin_amdgcn_readfirstlane((int)p.x); return (const GAS float*)a; }
};

__device__ __forceinline__ float wave_sum(float v) {
#pragma unroll
    for (int o = 1; o < 64; o <<= 1) v += __shfl_xor(v, o);
    return v;
}
__device__ __forceinline__ f32x4 unpk4(u32x2v p) { f32x4 r; r[0] = __uint_as_float(p.x << 16); r[1] = __uint_as_float(p.x & 0xffff0000u); r[2] = __uint_as_float(p.y << 16); r[3] = __uint_as_float(p.y & 0xffff0000u); return r; }
__device__ __forceinline__ float bf_lo(unsigned p) { return __uint_as_float(p << 16); }
__device__ __forceinline__ float bf_hi(unsigned p) { return __uint_as_float(p & 0xffff0000u); }
__device__ __forceinline__ float fsig(float x) { return __builtin_amdgcn_rcpf(1.0f + __expf(-x)); }
__device__ __forceinline__ float ftanh(float x) { return 1.0f - 2.0f * __builtin_amdgcn_rcpf(__expf(2.0f * x) + 1.0f); }
template <int CTRL> __device__ __forceinline__ float dppf(float x) { return __builtin_bit_cast(float, __builtin_amdgcn_update_dpp(0, __builtin_bit_cast(int, x), CTRL, 0xF, 0xF, true)); }
__device__ __forceinline__ float red16(float x) {
    x += dppf<0xB1>(x); x += dppf<0x4E>(x); x += dppf<0x141>(x); x += dppf<0x140>(x); return x; }
__device__ __forceinline__ float decay_of(float x) {
    const float w = fminf(x, 0.f) - __logf(1.0f + __expf(-fabsf(x))) - 0.5f;
    return __expf(-__expf(w));
}

constexpr int P0_SCR = 17408;
__device__ __forceinline__ void p0_item(const GAS float* W, int K, int N, GAS bf16* WT, int mode, const GAS float* gain, LAS float* scr, int item, int lane) {
    const int nblk = N / 64, kb = item / nblk, nb = item % nblk, k0 = 64 * kb, n0 = 64 * nb;
    f32x4 w[16];
#pragma unroll
    for (int i = 0; i < 16; ++i) { const int kk = 4 * i + (lane >> 4); w[i] = *(const GAS f32x4*)(W + (size_t)(k0 + kk) * N + n0 + 4 * (lane & 15)); }
    if (gain) {
#pragma unroll
        for (int i = 0; i < 16; ++i) w[i] = w[i] * gain[k0 + 4 * i + (lane >> 4)]; }
#pragma unroll
    for (int i = 0; i < 16; ++i) { const int kk = 4 * i + (lane >> 4); *(LAS f32x4*)(scr + kk * 68 + ((4 * (lane & 15)) ^ (4 * (kk >> 3)))) = w[i]; }
    LDS_WAIT(); asm volatile("" ::: "memory");
    const int c = lane & 7;
    const int r0 = (mode == 0) ? n0 : ((n0 >> 7) * 256 + (n0 & 127) + (mode == 2 ? 128 : 0));
#pragma unroll
    for (int j = 0; j < 8; ++j) { const int n = (lane >> 3) + 8 * j; const LAS float* s = scr + (8 * c) * 68 + (n ^ (4 * c));
        v4u o; o.x = pk2(s[0 * 68], s[1 * 68]); o.y = pk2(s[2 * 68], s[3 * 68]); o.z = pk2(s[4 * 68], s[5 * 68]); o.w = pk2(s[6 * 68], s[7 * 68]);
        *(GAS v4u*)(WT + (size_t)(r0 + n) * K + k0 + 8 * c) = o; }
    LDS_WAIT(); asm volatile("" ::: "memory");
}
__device__ __forceinline__ void rms_row_to_bf16(int lane, const GAS float* xrow, const GAS float* gain, GAS bf16* orow) {
    const GAS f32x4* xr = (const GAS f32x4*)xrow + lane; const GAS f32x4* gr = (const GAS f32x4*)gain + lane;
    f32x4 v[4]; float s = 0.f;
#pragma unroll
    for (int j = 0; j < 4; ++j) { v[j] = xr[64 * j]; s += (v[j].x * v[j].x + v[j].y * v[j].y) + (v[j].z * v[j].z + v[j].w * v[j].w); }
    const float rs = 1.0f / sqrtf(wave_sum(s) * (1.f / D) + RMS_EPS);
    GAS unsigned long long* o8 = (GAS unsigned long long*)orow + lane;
#pragma unroll
    for (int j = 0; j < 4; ++j) { const f32x4 g = gr[64 * j]; o8[64 * j] = (unsigned long long)pk2(v[j].x * rs * g.x, v[j].y * rs * g.y) | ((unsigned long long)pk2(v[j].z * rs * g.z, v[j].w * rs * g.w) << 32); }
}
__device__ __forceinline__ void convert_group(Frame& F, int group, int gw, int NGW) {
    int tidl = threadIdx.x; asm volatile("" : "+v"(tidl)); const int lane_ = tidl & 63;
    LAS float* scr = (LAS float*)(F.lds + RING_OFF + F.wave * P0_SCR);
    GAS unsigned char* ws = F.ws;
    constexpr int I_GU = (D / 64) * (FF / 64), I_DN = (FF / 64) * (D / 64), I_IN = (D / 64) * (NIN / 64), I_SQ = (D / 64) * (D / 64), I_PP = (PLE / 64) * (D / 64), I_L64 = (D / 64), I_L128 = 2 * (D / 64);
    constexpr int I_LORA = 2 * I_L64 + I_L128 + I_PP;
    const int nitems = group == 0 ? 2 * I_GU : (group == 1 ? I_DN + I_IN : (group == 2 ? I_LORA : 2 * I_GU + I_DN + 2 * I_SQ));
#pragma unroll 1
    for (int it = gw; it < nitems; it += NGW) {
        int r = (group == 3) ? it + I_LORA : it, wi, gi = -1, K, N, mode = 0; size_t dst;
        if (group == 0) {
            if (r < I_GU) { wi = 8; K = D; N = FF; dst = WS_W1GU; mode = 1; } else { r -= I_GU; wi = 9; K = D; N = FF; dst = WS_W1GU; mode = 2; }
        } else if (group == 1) {
            if (r < I_DN) { wi = 10; K = FF; N = D; dst = WS_W1D; } else { r -= I_DN; wi = 12; gi = 11; K = D; N = NIN; dst = WS_WIN; }
        } else {
            if (r < I_L64) { wi = 14; K = 64; N = D; dst = WS_WDU; }
            else if ((r -= I_L64) < I_L64) { wi = 16; K = 64; N = D; dst = WS_WIU; }
            else if ((r -= I_L64) < I_L128) { wi = 18; K = 128; N = D; dst = WS_WGU; }
            else if ((r -= I_L128) < I_PP) { wi = 32; K = PLE; N = D; dst = WS_WPP; }
            else if ((r -= I_PP) < I_SQ) { wi = 25; K = D; N = D; dst = WS_WOUT; }
            else if ((r -= I_SQ) < I_GU) { wi = 27; gi = 26; K = D; N = FF; dst = WS_W2GU; mode = 1; }
            else if ((r -= I_GU) < I_GU) { wi = 28; gi = 26; K = D; N = FF; dst = WS_W2GU; mode = 2; }
            else if ((r -= I_GU) < I_DN) { wi = 29; K = FF; N = D; dst = WS_W2D; }
            else { r -= I_DN; wi = 31; gi = 30; K = D; N = D; dst = WS_WPG; }
        }
        const GAS float* gp = nullptr; if (gi >= 0) gp = F.inp(gi);
        p0_item(F.inp(wi), K, N, (GAS bf16*)(ws + dst), mode, gp, scr, r, lane_);
    }
}
__device__ __forceinline__ void p0_prologue(Frame& F) {
    const int gw = F.vcu * NWAVES + F.wave, NGW = F.G * NWAVES;
    GAS unsigned char* ws = F.ws;
    convert_group(F, 0, gw, NGW);
    for (int m = gw; m < MV; m += NGW) {
        const GAS float* xr = (m < MPR) ? F.inp(0) + (size_t)m * D : F.inp(1) + (size_t)(m - MPR) * D;
        rms_row_to_bf16(F.lane, xr, F.inp(7), (GAS bf16*)(ws + WS_XB) + (size_t)m * D);
        const GAS float* pr = (m < MPR) ? F.inp(2) + (size_t)m * PLE : F.inp(3) + (size_t)(m - MPR) * PLE;
        const f32x4 pv = ((const GAS f32x4*)pr)[F.lane];
        ((GAS unsigned long long*)((GAS bf16*)(ws + WS_PB) + (size_t)m * PLE))[F.lane] = (unsigned long long)pk2(pv.x, pv.y) | ((unsigned long long)pk2(pv.z, pv.w) << 32);
    }
}
__device__ __forceinline__ void p9_final(Frame& F) {
    const int gw = F.vcu * NWAVES + F.wave, NGW = F.G * NWAVES;
    const GAS bf16* XF = (const GAS bf16*)(F.ws + WS_GU);
    for (int m = gw; m < MV; m += NGW) {
        const GAS v4u* xr = (const GAS v4u*)(XF + (size_t)m * D) + F.lane; const GAS f32x4* gr = (const GAS f32x4*)F.inp(33) + 2 * F.lane;
        f32x4 v[4]; float s = 0.f;
#pragma unroll
        for (int j = 0; j < 2; ++j) { const v4u p = xr[64 * j]; v[2 * j] = (f32x4){bf_lo(p.x), bf_hi(p.x), bf_lo(p.y), bf_hi(p.y)}; v[2 * j + 1] = (f32x4){bf_lo(p.z), bf_hi(p.z), bf_lo(p.w), bf_hi(p.w)}; }
#pragma unroll
        for (int j = 0; j < 4; ++j) s += (v[j].x * v[j].x + v[j].y * v[j].y) + (v[j].z * v[j].z + v[j].w * v[j].w);
        const float rs = 1.0f / sqrtf(wave_sum(s) * (1.f / D) + RMS_EPS);
        GAS f32x4* yr = (GAS f32x4*)(F.out + (size_t)m * D) + 2 * F.lane;
#pragma unroll
        for (int j = 0; j < 2; ++j) { const f32x4 g0 = gr[128 * j], g1 = gr[128 * j + 1]; yr[128 * j] = v[2 * j] * rs * g0; yr[128 * j + 1] = v[2 * j + 1] * rs * g1; }
    }
}

constexpr int MX_WGU = 0, MX_AT = 17408, MX_AA = 22016, MX_AG = 26624, MX_LD = 35328, MX_AL = 43520, MX_LG = 51712, MX_LGT = 59904, MX_G = 60416  ,
              MX_KT = 76800, MX_RT = 81408, MX_KH = 86016, MX_BH = 90624, MX_KB = 95232, MX_VT = 104448, MX_TP = 109568, MX_AR = 111872, MX_AKK = 114176, MX_ABK = 116224,
              MX_G16 = 118272  , MX_Y = 119296, MX_BON = 127488  , MX_CU = 127744  , MX_CT = 145152, MX_CAR = 148992, MX_ID = 150784  , MX_END = 151808;
static_assert(MX_END <= LDSCTL_OFF, "mixer LDS map");
constexpr int SUBT = 32;
constexpr int CAR_STRIDE = 576;
constexpr int KT_ST = 144, KB_ST = 72, VT_ST = 40, TP_ST = 72;
__device__ __forceinline__ float logdecay_of(float x) { return -0.60653065971263342f * __builtin_amdgcn_rcpf(1.0f + __expf(-x)); }

struct RawZ { u32x2v r, k, v, rp, kp, vp, wd, ad, wdp, adp; v4u gd, gdp; u32x2v cC, cU; };

__device__ __forceinline__ void mix_load(RawZ& R, const GAS bf16* Zc, int lrow, bool first, int h, int q) {
    const GAS unsigned char* zb = (const GAS unsigned char*)Zc;
    const unsigned ro = (unsigned)lrow * (unsigned)(NIN * 2), po = first ? ro : ro - (unsigned)(NIN * 2);
    const unsigned hb = (unsigned)(64 * h + 4 * q) * 2u, qb = (unsigned)q * 8u;
    R.r = *(const GAS u32x2v*)(zb + (ro + hb)); R.k = *(const GAS u32x2v*)(zb + (ro + hb + 2048u)); R.v = *(const GAS u32x2v*)(zb + (ro + hb + 4096u));
    R.rp = *(const GAS u32x2v*)(zb + (po + hb)); R.kp = *(const GAS u32x2v*)(zb + (po + hb + 2048u)); R.vp = *(const GAS u32x2v*)(zb + (po + hb + 4096u));
    R.wd = *(const GAS u32x2v*)(zb + (ro + qb + 6144u)); R.ad = *(const GAS u32x2v*)(zb + (ro + qb + 6272u)); R.gd = *(const GAS v4u*)(zb + (ro + 2u * qb + 6400u));
    R.wdp = *(const GAS u32x2v*)(zb + (po + qb + 6144u)); R.adp = *(const GAS u32x2v*)(zb + (po + qb + 6272u)); R.gdp = *(const GAS v4u*)(zb + (po + 2u * qb + 6400u));
    R.cC = *(const GAS u32x2v*)(zb + (ro + hb + 8704u)); R.cU = *(const GAS u32x2v*)(zb + (ro + hb + 10752u));
}

#ifdef PROBE_TS_A
#define PROBE_MIX
#endif
__device__ __forceinline__ void mix_job(Frame& F, int b, int h, int chunk) {
    LAS unsigned char* lds = F.lds;
    asm volatile("" : "+s"(b), "+s"(h), "+s"(chunk));
    int tid = threadIdx.x; asm volatile("" : "+v"(tid));
    const int lane = tid & 63, wave = __builtin_amdgcn_readfirstlane(tid >> 6);
    const int tt = tid >> 4, q = tid & 15;
    const GAS bf16* Zc = (const GAS bf16*)(F.ws + WS_Z + (size_t)(chunk & 1) * ZCH_BYTES);
    GAS float* car = (GAS float*)(F.ws + WS_CAR) + (size_t)(b * NHEAD + h) * CAR_STRIDE;
    const GAS bf16* GBb = (h >= 12) ? (const GAS bf16*)(F.ws + WS_ZX) + (size_t)chunk * (NBATCH * TCH) * 256 + 64 * (h - 12) : Zc + 7424 + 64 * h; const int gbs = (h >= 12) ? 256 : NIN;
    const int hc = 64 * h + 4 * q;
    const int mb = wave & 1, nb = wave >> 1, lr = lane & 15, lq = lane >> 4;
    const bool cont = (chunk != 0);
    const GAS bf16* wgu = (const GAS bf16*)(F.ws + WS_WGU) + (size_t)(64 * h) * 128;
    f32x4 ctv[2];
#pragma unroll
    for (int i = 0; i < 2; ++i) {
        const int rw = (wave + 8 * i < 15) ? wave + 8 * i : 14;
        const int idx = rw < 7 ? 13 : (rw < 12 ? rw + 12 : 24);
        const int off = rw < 3 ? rw * 1024 + 64 * h : (rw < 7 ? 3072 + 64 * (rw - 3) : (rw < 12 ? 64 * h : (rw - 12) * 1024 + 64 * h));
        ctv[i] = *(const GAS f32x4*)(F.inp(idx) + off + 4 * (lane & 15));
    }
    const float dbias = F.inp(15)[64 * h + 16 * nb + lr], ibias = F.inp(17)[64 * h + 16 * nb + lr];
    bf16x8 bfD[2], bfI[2];
    { const GAS bf16* wdu = (const GAS bf16*)(F.ws + WS_WDU) + (size_t)(64 * h + 16 * nb + lr) * 64 + 8 * lq; const GAS bf16* wiu = (const GAS bf16*)(F.ws + WS_WIU) + (size_t)(64 * h + 16 * nb + lr) * 64 + 8 * lq;
      bfD[0] = *(const GAS bf16x8*)wdu; bfD[1] = *(const GAS bf16x8*)(wdu + 32); bfI[0] = *(const GAS bf16x8*)wiu; bfI[1] = *(const GAS bf16x8*)(wiu + 32); }
    GAS float* Sg = F.out + O_WKVP + (size_t)(b * NHEAD + h) * 4096;
    f32x4 Hs[4];
#pragma unroll
    for (int kb = 0; kb < 4; ++kb) Hs[kb] = *(const GAS f32x4*)(Sg + (size_t)(16 * (wave & 3) + lr) * 64 + 16 * kb + 4 * lq);
    const f32x4 ch0 = *(const GAS f32x4*)(car + 448 + (tt & 1) * 64 + 4 * q);
    f32x4 c7[7];
#pragma unroll
    for (int i = 0; i < 7; ++i) c7[i] = *(const GAS f32x4*)(car + 64 * i + 4 * q);
    RawZ R; mix_load(R, Zc, b * TCH + tt, (tt == 0), h, q);
    const v4u wg0 = *(const GAS v4u*)(wgu + tid * 8), wg1 = *(const GAS v4u*)(wgu + (tid + 512) * 8);
    __builtin_amdgcn_sched_barrier(0);
    *(LAS v4u*)(lds + MX_WGU + (tid >> 4) * 272 + (tid & 15) * 16) = wg0; *(LAS v4u*)(lds + MX_WGU + ((tid + 512) >> 4) * 272 + (tid & 15) * 16) = wg1;
    if (tid < 256) *(LAS float*)(lds + MX_ID + tid * 4) = ((tid >> 4) == (tid & 15)) ? 1.0f : 0.0f;
    if (lane < 16) { *(LAS f32x4*)(lds + MX_CT + wave * 256 + lane * 16) = ctv[0]; if (wave < 7) *(LAS f32x4*)(lds + MX_CT + (wave + 8) * 256 + lane * 16) = ctv[1]; }
    { const f32x4 z4 = (f32x4){0.f, 0.f, 0.f, 0.f};
#pragma unroll
      for (int kb = 0; kb < 4; ++kb) Hs[kb] = (cont && wave < 4) ? Hs[kb] : z4;
      if (tt < 2) *(LAS f32x4*)(lds + MX_CU + tt * 256 + q * 16) = cont ? ch0 : z4;
      if (tt == 0) {
#pragma unroll
          for (int i = 0; i < 7; ++i) *(LAS f32x4*)(lds + MX_CAR + i * 256 + q * 16) = cont ? c7[i] : z4;
      } }
    const int tid0 = tid;
    WG_SYNC();
    constexpr int NSC = TCH / SUBT;
    f32x4 v_c = (f32x4){0.f, 0.f, 0.f, 0.f}, cu_c = v_c; u32x2v mo_w = (u32x2v){0u, 0u};
#ifdef PROBE_MIX
    unsigned tacc0 = 0, tacc1 = 0, tacc2 = 0, tacc3 = 0, tprev = (unsigned)__builtin_amdgcn_s_memrealtime(); const unsigned tstart = tprev;
#endif
    for (int j = -1; j < NSC; ++j) {
        int tid = tid0; asm volatile("" : "+v"(tid));
        const int lane = tid & 63, tt = tid >> 4, q = tid & 15, lr = lane & 15, lq = lane >> 4, hc = 64 * h + 4 * q;
        const bool front = (j + 1 < NSC), back = (j >= 0);
        const int sf = j + 1, pf = sf & 1, pb = j & 1;
        f32x4 r_s, k_s, v_n, cu_n; u32x2v fB, fA, fG;
        if (back)
        if (wave < 4) {
            const int g = wave & 1, kind = wave >> 1;
            const LAS unsigned char* As = lds + (kind ? MX_RT : MX_KT) + g * 16 * KT_ST; const LAS unsigned char* Bk = lds + MX_KH + g * 16 * KT_ST; const LAS unsigned char* Bb = lds + MX_BH + g * 16 * KT_ST;
            f32x4 accK = (f32x4){0.f, 0.f, 0.f, 0.f}, accB = accK;
#pragma unroll
            for (int ks = 0; ks < 2; ++ks) { const bf16x8 af = *(const LAS bf16x8*)(As + lr * KT_ST + (32 * ks + 8 * lq) * 2), bk = *(const LAS bf16x8*)(Bk + lr * KT_ST + (32 * ks + 8 * lq) * 2), bb = *(const LAS bf16x8*)(Bb + lr * KT_ST + (32 * ks + 8 * lq) * 2);
                accK = __builtin_amdgcn_mfma_f32_16x16x32_bf16(af, bk, accK, 0, 0, 0); accB = __builtin_amdgcn_mfma_f32_16x16x32_bf16(af, bb, accB, 0, 0, 0); }
            if (kind == 0) {
                LAS float* akk = (LAS float*)(lds + MX_AKK + g * 1024); LAS float* abk = (LAS float*)(lds + MX_ABK + g * 1024);
#pragma unroll
                for (int rg = 0; rg < 4; ++rg) { const int i = 4 * lq + rg; const bool keep = (lr < i); akk[i * 16 + lr] = keep ? accK[rg] : 0.f;
                    abk[i * 16 + lr] = keep ? accB[rg] : 0.f;
                }
                const int wh = (lane >> 4) & 1, jc = lane & 15;
                float t[16];
                { const LAS float* ini = wh ? (const LAS float*)akk : (const LAS float*)(lds + MX_ID);
#pragma unroll
                  for (int i = 0; i < 16; ++i) t[i] = ini[i * 16 + jc]; }
                {
                    f32x4 c[12];
                    c[0] = *(const LAS f32x4*)(abk + 16);
                    c[1] = *(const LAS f32x4*)(abk + 32);
                    c[2] = *(const LAS f32x4*)(abk + 48);
                    c[3] = *(const LAS f32x4*)(abk + 64);
                    c[4] = *(const LAS f32x4*)(abk + 80);
                    c[5] = *(const LAS f32x4*)(abk + 84);
                    c[6] = *(const LAS f32x4*)(abk + 96);
                    c[7] = *(const LAS f32x4*)(abk + 100);
                    c[8] = *(const LAS f32x4*)(abk + 112);
                    c[9] = *(const LAS f32x4*)(abk + 116);
                    c[10] = *(const LAS f32x4*)(abk + 128);
                    c[11] = *(const LAS f32x4*)(abk + 132);
                    __builtin_amdgcn_sched_barrier(0);
                    t[1] -= c[0][0] * t[0];
                    t[2] -= c[1][0] * t[0];
                    t[2] -= c[1][1] * t[1];
                    t[3] -= c[2][0] * t[0];
                    t[3] -= c[2][1] * t[1];
                    t[3] -= c[2][2] * t[2];
                    t[4] -= c[3][0] * t[0];
                    t[4] -= c[3][1] * t[1];
                    t[4] -= c[3][2] * t[2];
                    t[4] -= c[3][3] * t[3];
                    t[5] -= c[4][0] * t[0];
                    t[5] -= c[4][1] * t[1];
                    t[5] -= c[4][2] * t[2];
                    t[5] -= c[4][3] * t[3];
                    t[5] -= c[5][0] * t[4];
                    t[6] -= c[6][0] * t[0];
                    t[6] -= c[6][1] * t[1];
                    t[6] -= c[6][2] * t[2];
                    t[6] -= c[6][3] * t[3];
                    t[6] -= c[7][0] * t[4];
                    t[6] -= c[7][1] * t[5];
                    t[7] -= c[8][0] * t[0];
                    t[7] -= c[8][1] * t[1];
                    t[7] -= c[8][2] * t[2];
                    t[7] -= c[8][3] * t[3];
                    t[7] -= c[9][0] * t[4];
                    t[7] -= c[9][1] * t[5];
                    t[7] -= c[9][2] * t[6];
                    t[8] -= c[10][0] * t[0];
                    t[8] -= c[10][1] * t[1];
                    t[8] -= c[10][2] * t[2];
                    t[8] -= c[10][3] * t[3];
                    t[8] -= c[11][0] * t[4];
                    t[8] -= c[11][1] * t[5];
                    t[8] -= c[11][2] * t[6];
                    t[8] -= c[11][3] * t[7];
                    __builtin_amdgcn_sched_barrier(0);
                }
                {
                    f32x4 c[12];
                    c[0] = *(const LAS f32x4*)(abk + 144);
                    c[1] = *(const LAS f32x4*)(abk + 148);
                    c[2] = *(const LAS f32x4*)(abk + 152);
                    c[3] = *(const LAS f32x4*)(abk + 160);
                    c[4] = *(const LAS f32x4*)(abk + 164);
                    c[5] = *(const LAS f32x4*)(abk + 168);
                    c[6] = *(const LAS f32x4*)(abk + 176);
                    c[7] = *(const LAS f32x4*)(abk + 180);
                    c[8] = *(const LAS f32x4*)(abk + 184);
                    c[9] = *(const LAS f32x4*)(abk + 192);
                    c[10] = *(const LAS f32x4*)(abk + 196);
                    c[11] = *(const LAS f32x4*)(abk + 200);
                    __builtin_amdgcn_sched_barrier(0);
                    t[9] -= c[0][0] * t[0];
                    t[9] -= c[0][1] * t[1];
                    t[9] -= c[0][2] * t[2];
                    t[9] -= c[0][3] * t[3];
                    t[9] -= c[1][0] * t[4];
                    t[9] -= c[1][1] * t[5];
                    t[9] -= c[1][2] * t[6];
                    t[9] -= c[1][3] * t[7];
                    t[9] -= c[2][0] * t[8];
                    t[10] -= c[3][0] * t[0];
                    t[10] -= c[3][1] * t[1];
                    t[10] -= c[3][2] * t[2];
                    t[10] -= c[3][3] * t[3];
                    t[10] -= c[4][0] * t[4];
                    t[10] -= c[4][1] * t[5];
                    t[10] -= c[4][2] * t[6];
                    t[10] -= c[4][3] * t[7];
                    t[10] -= c[5][0] * t[8];
                    t[10] -= c[5][1] * t[9];
                    t[11] -= c[6][0] * t[0];
                    t[11] -= c[6][1] * t[1];
                    t[11] -= c[6][2] * t[2];
                    t[11] -= c[6][3] * t[3];
                    t[11] -= c[7][0] * t[4];
                    t[11] -= c[7][1] * t[5];
                    t[11] -= c[7][2] * t[6];
                    t[11] -= c[7][3] * t[7];
                    t[11] -= c[8][0] * t[8];
                    t[11] -= c[8][1] * t[9];
                    t[11] -= c[8][2] * t[10];
                    t[12] -= c[9][0] * t[0];
                    t[12] -= c[9][1] * t[1];
                    t[12] -= c[9][2] * t[2];
                    t[12] -= c[9][3] * t[3];
                    t[12] -= c[10][0] * t[4];
                    t[12] -= c[10][1] * t[5];
                    t[12] -= c[10][2] * t[6];
                    t[12] -= c[10][3] * t[7];
                    t[12] -= c[11][0] * t[8];
                    t[12] -= c[11][1] * t[9];
                    t[12] -= c[11][2] * t[10];
                    t[12] -= c[11][3] * t[11];
                    __builtin_amdgcn_sched_barrier(0);
                }
                {
                    f32x4 c[12];
                    c[0] = *(const LAS f32x4*)(abk + 208);
                    c[1] = *(const LAS f32x4*)(abk + 212);
                    c[2] = *(const LAS f32x4*)(abk + 216);
                    c[3] = *(const LAS f32x4*)(abk + 220);
                    c[4] = *(const LAS f32x4*)(abk + 224);
                    c[5] = *(const LAS f32x4*)(abk + 228);
                    c[6] = *(const LAS f32x4*)(abk + 232);
                    c[7] = *(const LAS f32x4*)(abk + 236);
                    c[8] = *(const LAS f32x4*)(abk + 240);
                    c[9] = *(const LAS f32x4*)(abk + 244);
                    c[10] = *(const LAS f32x4*)(abk + 248);
                    c[11] = *(const LAS f32x4*)(abk + 252);
                    __builtin_amdgcn_sched_barrier(0);
                    t[13] -= c[0][0] * t[0];
                    t[13] -= c[0][1] * t[1];
                    t[13] -= c[0][2] * t[2];
                    t[13] -= c[0][3] * t[3];
                    t[13] -= c[1][0] * t[4];
                    t[13] -= c[1][1] * t[5];
                    t[13] -= c[1][2] * t[6];
                    t[13] -= c[1][3] * t[7];
                    t[13] -= c[2][0] * t[8];
                    t[13] -= c[2][1] * t[9];
                    t[13] -= c[2][2] * t[10];
                    t[13] -= c[2][3] * t[11];
                    t[13] -= c[3][0] * t[12];
                    t[14] -= c[4][0] * t[0];
                    t[14] -= c[4][1] * t[1];
                    t[14] -= c[4][2] * t[2];
                    t[14] -= c[4][3] * t[3];
                    t[14] -= c[5][0] * t[4];
                    t[14] -= c[5][1] * t[5];
                    t[14] -= c[5][2] * t[6];
                    t[14] -= c[5][3] * t[7];
                    t[14] -= c[6][0] * t[8];
                    t[14] -= c[6][1] * t[9];
                    t[14] -= c[6][2] * t[10];
                    t[14] -= c[6][3] * t[11];
                    t[14] -= c[7][0] * t[12];
                    t[14] -= c[7][1] * t[13];
                    t[15] -= c[8][0] * t[0];
                    t[15] -= c[8][1] * t[1];
                    t[15] -= c[8][2] * t[2];
                    t[15] -= c[8][3] * t[3];
                    t[15] -= c[9][0] * t[4];
                    t[15] -= c[9][1] * t[5];
                    t[15] -= c[9][2] * t[6];
                    t[15] -= c[9][3] * t[7];
                    t[15] -= c[10][0] * t[8];
                    t[15] -= c[10][1] * t[9];
                    t[15] -= c[10][2] * t[10];
                    t[15] -= c[10][3] * t[11];
                    t[15] -= c[11][0] * t[12];
                    t[15] -= c[11][1] * t[13];
                    t[15] -= c[11][2] * t[14];
                    __builtin_amdgcn_sched_barrier(0);
                }
#pragma unroll
                for (int i = 0; i < 16; ++i) *(LAS unsigned short*)(lds + MX_TP + g * 16 * TP_ST + i * TP_ST + wh * 32 + jc * 2) = (unsigned short)pg8::cvt_pk_bf16(t[i], 0.f);
            } else {
#pragma unroll
                for (int rg = 0; rg < 4; ++rg) { const int i = 4 * lq + rg; const bool keep = (lr <= i);
                    *(LAS unsigned short*)(lds + MX_AR + g * 16 * TP_ST + i * TP_ST + lr * 2) = (unsigned short)pg8::cvt_pk_bf16(keep ? accK[rg] : 0.f, 0.f);
                    *(LAS unsigned short*)(lds + MX_AR + g * 16 * TP_ST + i * TP_ST + 32 + lr * 2) = (unsigned short)pg8::cvt_pk_bf16(keep ? -accB[rg] : 0.f, 0.f); }
            }
        }
        if (front) {
            const bool first = (sf == 0 && tt == 0);
            const f32x4 mu_r = *(const LAS f32x4*)(lds + MX_CT + 0 * 256 + q * 16), mu_k = *(const LAS f32x4*)(lds + MX_CT + 1 * 256 + q * 16), mu_v = *(const LAS f32x4*)(lds + MX_CT + 2 * 256 + q * 16);
            const f32x4 mu_wd = *(const LAS f32x4*)(lds + MX_CT + 3 * 256 + q * 16), mu_ad = *(const LAS f32x4*)(lds + MX_CT + 4 * 256 + q * 16);
            const f32x4 mu_g0 = *(const LAS f32x4*)(lds + MX_CT + 5 * 256 + q * 32), mu_g1 = *(const LAS f32x4*)(lds + MX_CT + 5 * 256 + q * 32 + 16);
            f32x4 zr_ = unpk4(R.r), zk_ = unpk4(R.k), zv_ = unpk4(R.v), zwd = unpk4(R.wd), zad = unpk4(R.ad);
            f32x4 zg0 = unpk4((u32x2v){R.gd.x, R.gd.y}), zg1 = unpk4((u32x2v){R.gd.z, R.gd.w});
            f32x4 pr_ = unpk4(R.rp), pk_ = unpk4(R.kp), pv_ = unpk4(R.vp), pwd = unpk4(R.wdp), pad = unpk4(R.adp);
            f32x4 pg0 = unpk4((u32x2v){R.gdp.x, R.gdp.y}), pg1 = unpk4((u32x2v){R.gdp.z, R.gdp.w});
            if (first) { const LAS float* cl = (const LAS float*)(lds + MX_CAR);
                pr_ = *(const LAS f32x4*)(cl + 4 * q); pk_ = *(const LAS f32x4*)(cl + 64 + 4 * q); pv_ = *(const LAS f32x4*)(cl + 128 + 4 * q);
                pwd = *(const LAS f32x4*)(cl + 192 + 4 * q); pad = *(const LAS f32x4*)(cl + 256 + 4 * q); pg0 = *(const LAS f32x4*)(cl + 320 + 8 * q); pg1 = *(const LAS f32x4*)(cl + 324 + 8 * q); }
            if (chunk < NTC - 1 && sf == NSC - 1 && tt == SUBT - 1) {
                *(GAS f32x4*)(car + 4 * q) = zr_; *(GAS f32x4*)(car + 64 + 4 * q) = zk_; *(GAS f32x4*)(car + 128 + 4 * q) = zv_;
                *(GAS f32x4*)(car + 192 + 4 * q) = zwd; *(GAS f32x4*)(car + 256 + 4 * q) = zad; *(GAS f32x4*)(car + 320 + 8 * q) = zg0; *(GAS f32x4*)(car + 324 + 8 * q) = zg1;
            }
            if (chunk == NTC - 1 && sf == NSC - 1 && tt == SUBT - 1) {
                GAS float* d = F.out + O_SHP + (size_t)b * SHIFTC;
                *(GAS f32x4*)(d + hc) = zr_; *(GAS f32x4*)(d + 1024 + hc) = zk_; *(GAS f32x4*)(d + 2048 + hc) = zv_;
                if (h == 0) { *(GAS f32x4*)(d + 3072 + 4 * q) = zwd; *(GAS f32x4*)(d + 3136 + 4 * q) = zad; *(GAS f32x4*)(d + 3200 + 8 * q) = zg0; *(GAS f32x4*)(d + 3204 + 8 * q) = zg1; }
            }
            r_s = zr_ + mu_r * (pr_ - zr_); k_s = zk_ + mu_k * (pk_ - zk_); v_n = zv_ + mu_v * (pv_ - zv_);
            const f32x4 wd_s = zwd + mu_wd * (pwd - zwd), ad_s = zad + mu_ad * (pad - zad), g0_s = zg0 + mu_g0 * (pg0 - zg0), g1_s = zg1 + mu_g1 * (pg1 - zg1);
            { u32x2v w; w.x = pg8::cvt_pk_bf16(ftanh(wd_s[0]), ftanh(wd_s[1])); w.y = pg8::cvt_pk_bf16(ftanh(wd_s[2]), ftanh(wd_s[3])); *(LAS u32x2v*)(lds + MX_AT + tt * 144 + q * 8) = w; }
            { u32x2v w; w.x = pg8::cvt_pk_bf16(ad_s[0], ad_s[1]); w.y = pg8::cvt_pk_bf16(ad_s[2], ad_s[3]); *(LAS u32x2v*)(lds + MX_AA + tt * 144 + q * 8) = w; }
            { v4u w; w.x = pg8::cvt_pk_bf16(fsig(g0_s[0]), fsig(g0_s[1])); w.y = pg8::cvt_pk_bf16(fsig(g0_s[2]), fsig(g0_s[3])); w.z = pg8::cvt_pk_bf16(fsig(g1_s[0]), fsig(g1_s[1])); w.w = pg8::cvt_pk_bf16(fsig(g1_s[2]), fsig(g1_s[3]));
              *(LAS v4u*)(lds + MX_AG + tt * 272 + q * 16) = w; }
            cu_n = unpk4(R.cC) * unpk4(R.cU);
            *(LAS f32x4*)(lds + MX_CU + pf * 8704 + (tt + 2) * 256 + q * 16) = cu_n;
        } else {
            asm volatile("" :: "v"(R.r.x), "v"(R.r.y), "v"(R.k.x), "v"(R.k.y), "v"(R.v.x), "v"(R.v.y), "v"(R.rp.x), "v"(R.rp.y), "v"(R.kp.x), "v"(R.kp.y), "v"(R.vp.x), "v"(R.vp.y), "v"(R.wd.x), "v"(R.wd.y));
            asm volatile("" :: "v"(R.ad.x), "v"(R.ad.y), "v"(R.wdp.x), "v"(R.wdp.y), "v"(R.adp.x), "v"(R.adp.y), "v"(R.gd.x), "v"(R.gd.y), "v"(R.gd.z), "v"(R.gd.w), "v"(R.gdp.x), "v"(R.gdp.y), "v"(R.gdp.z), "v"(R.gdp.w));
            asm volatile("" :: "v"(R.cC.x), "v"(R.cC.y), "v"(R.cU.x), "v"(R.cU.y));
            r_s = (f32x4){0.f, 0.f, 0.f, 0.f}; k_s = r_s; v_n = r_s; cu_n = r_s;
        }
        __builtin_amdgcn_sched_barrier(0);
        if (j >= 1) *(GAS u32x2v*)((GAS bf16*)(F.ws + WS_MIX) + (size_t)(b * TSEQ + chunk * TCH + (j - 1) * SUBT + tt) * D + hc) = mo_w;
        mix_load(R, Zc, b * TCH + (sf + 1 < NSC ? sf + 1 : NSC - 1) * SUBT + tt, false, h, q);
        { const int lrow = b * TCH + (j < 0 ? 0 : j) * SUBT + tt; const unsigned ro = (unsigned)lrow * (unsigned)(NIN * 2) + (unsigned)hc * 2u;
            fB = *(const GAS u32x2v*)((const GAS unsigned char*)Zc + (ro + 6656u)); fA = *(const GAS u32x2v*)((const GAS unsigned char*)Zc + (ro + 12800u));
            fG = *(const GAS u32x2v*)((const GAS unsigned char*)GBb + ((unsigned)lrow * (unsigned)(gbs * 2) + (unsigned)q * 8u)); }
        WG_SYNC();
#ifdef PROBE_MIX
        { const unsigned tn = (unsigned)__builtin_amdgcn_s_memrealtime(); tacc0 += tn - tprev; tprev = tn; }
#endif
        if (front)
        {
            f32x4 a1 = (f32x4){0.f, 0.f, 0.f, 0.f}, a2 = a1, a3 = a1;
#pragma unroll
            for (int ks = 0; ks < 2; ++ks) {
                const bf16x8 At = *(const LAS bf16x8*)(lds + MX_AT + (16 * mb + lr) * 144 + (32 * ks + 8 * lq) * 2);
                const bf16x8 Aa = *(const LAS bf16x8*)(lds + MX_AA + (16 * mb + lr) * 144 + (32 * ks + 8 * lq) * 2);
                a1 = __builtin_amdgcn_mfma_f32_16x16x32_bf16(At, bfD[ks], a1, 0, 0, 0); a2 = __builtin_amdgcn_mfma_f32_16x16x32_bf16(Aa, bfI[ks], a2, 0, 0, 0); }
#pragma unroll
            for (int ks = 0; ks < 4; ++ks) {
                const bf16x8 Ag = *(const LAS bf16x8*)(lds + MX_AG + (16 * mb + lr) * 272 + (32 * ks + 8 * lq) * 2), Bg = *(const LAS bf16x8*)(lds + MX_WGU + (16 * nb + lr) * 272 + (32 * ks + 8 * lq) * 2);
                a3 = __builtin_amdgcn_mfma_f32_16x16x32_bf16(Ag, Bg, a3, 0, 0, 0); }
            float ldv[4], pfx[4];
#pragma unroll
            for (int j = 0; j < 4; ++j) { ldv[j] = logdecay_of(dbias + a1[j]); pfx[j] = (j ? pfx[j - 1] : 0.f) + ldv[j]; }
            const float T = pfx[3]; const float t1 = __shfl_up(T, 16); float sI = T + (lq >= 1 ? t1 : 0.f); const float t2 = __shfl_up(sI, 32); sI += (lq >= 2 ? t2 : 0.f);
            const float excl = sI - T, tot = __shfl(sI, 48 + lr);
#pragma unroll
            for (int j = 0; j < 4; ++j) { const int o = ((16 * mb + 4 * lq + j) * 64 + 16 * nb + lr) * 4;
                *(LAS float*)(lds + MX_LD + o) = ldv[j]; *(LAS float*)(lds + MX_LG + o) = excl + pfx[j]; *(LAS float*)(lds + MX_AL + o) = fsig(ibias + a2[j]); *(LAS float*)(lds + MX_G + pf * 8192 + o) = a3[j]; }
            if (lq == 0) *(LAS float*)(lds + MX_G16 + pf * 512 + (mb * 64 + 16 * nb + lr) * 4) = __expf(tot);
        }
        if (back && wave < 4) {
            const int cb = wave;
            f32x4 Hl[4];
#pragma unroll
            for (int kb = 0; kb < 4; ++kb) Hl[kb] = Hs[kb];
            v4u kaw[2][2], raw[2][2], taw[2], aaw[2], caw[4]; u32x2v vtw[2]; f32x4 g4w[4];
#define E_LD8(base) ({ const LAS unsigned char* p_ = (base); const u32x2v x0_ = *(const LAS u32x2v*)p_, x1_ = *(const LAS u32x2v*)(p_ + 32); (v4u){x0_.x, x0_.y, x1_.x, x1_.y}; })
#pragma unroll
            for (int g = 0; g < 2; ++g) {
#pragma unroll
                for (int s2 = 0; s2 < 2; ++s2) { kaw[g][s2] = E_LD8(lds + MX_KT + g * 16 * KT_ST + lr * KT_ST + (32 * s2 + 4 * lq) * 2); raw[g][s2] = E_LD8(lds + MX_RT + g * 16 * KT_ST + lr * KT_ST + (32 * s2 + 4 * lq) * 2); }
                taw[g] = E_LD8(lds + MX_TP + g * 16 * TP_ST + lr * TP_ST + 4 * lq * 2); aaw[g] = E_LD8(lds + MX_AR + g * 16 * TP_ST + lr * TP_ST + 4 * lq * 2);
                vtw[g] = *(const LAS u32x2v*)(lds + MX_VT + g * 64 * VT_ST + (16 * cb + lr) * VT_ST + 4 * lq * 2);
            }
#pragma unroll
            for (int kb = 0; kb < 4; ++kb) { caw[kb] = E_LD8(lds + MX_KB + (16 * kb + lr) * KB_ST + 4 * lq * 2); g4w[kb] = *(const LAS f32x4*)(lds + MX_G16 + pb * 512 + (16 * kb + 4 * lq) * 4); }
            __builtin_amdgcn_sched_barrier(0);
#pragma unroll
            for (int g = 0; g < 2; ++g) {
                f32x4 Wa = (f32x4){0.f, 0.f, 0.f, 0.f}, Za = Wa;
#pragma unroll
                for (int s2 = 0; s2 < 2; ++s2) {
                    const f32x4 lo = Hl[2 * s2], hi = Hl[2 * s2 + 1];
                    const bf16x8 hb = __builtin_bit_cast(bf16x8, (v4u){pg8::cvt_pk_bf16(lo[0], lo[1]), pg8::cvt_pk_bf16(lo[2], lo[3]), pg8::cvt_pk_bf16(hi[0], hi[1]), pg8::cvt_pk_bf16(hi[2], hi[3])});
                    Wa = __builtin_amdgcn_mfma_f32_16x16x32_bf16(__builtin_bit_cast(bf16x8, kaw[g][s2]), hb, Wa, 0, 0, 0); Za = __builtin_amdgcn_mfma_f32_16x16x32_bf16(__builtin_bit_cast(bf16x8, raw[g][s2]), hb, Za, 0, 0, 0); }
#pragma unroll
                for (int kb = 0; kb < 4; ++kb) Hl[kb] = Hl[kb] * g4w[kb];
                const bf16x8 bw = __builtin_bit_cast(bf16x8, (v4u){pg8::cvt_pk_bf16(Wa[0], Wa[1]), pg8::cvt_pk_bf16(Wa[2], Wa[3]), vtw[g].x, vtw[g].y});
                const f32x4 Ua = __builtin_amdgcn_mfma_f32_16x16x32_bf16(__builtin_bit_cast(bf16x8, taw[g]), bw, (f32x4){0.f, 0.f, 0.f, 0.f}, 0, 0, 0);
                const bf16x8 vu = __builtin_bit_cast(bf16x8, (v4u){vtw[g].x, vtw[g].y, pg8::cvt_pk_bf16(Ua[0], Ua[1]), pg8::cvt_pk_bf16(Ua[2], Ua[3])});
#pragma unroll
                for (int kb = 0; kb < 4; ++kb) Hl[kb] = __builtin_amdgcn_mfma_f32_16x16x32_bf16(__builtin_bit_cast(bf16x8, caw[kb]), vu, Hl[kb], 0, 0, 0);
                Za = __builtin_amdgcn_mfma_f32_16x16x32_bf16(__builtin_bit_cast(bf16x8, aaw[g]), vu, Za, 0, 0, 0);
                if (g == 0) {
                    __builtin_amdgcn_sched_barrier(0);
#pragma unroll
                    for (int kb = 0; kb < 4; ++kb) { caw[kb] = E_LD8(lds + MX_KB + 64 * KB_ST + (16 * kb + lr) * KB_ST + 4 * lq * 2); g4w[kb] = *(const LAS f32x4*)(lds + MX_G16 + pb * 512 + 256 + (16 * kb + 4 * lq) * 4); }
                    __builtin_amdgcn_sched_barrier(0);
                }
#pragma unroll
                for (int rg = 0; rg < 4; ++rg) *(LAS float*)(lds + MX_Y + (16 * g + 4 * lq + rg) * 256 + (16 * cb + lr) * 4) = Za[rg];
            }
#undef E_LD8
#pragma unroll
            for (int kb = 0; kb < 4; ++kb) Hs[kb] = Hl[kb];
        }
        WG_SYNC();
#ifdef PROBE_MIX
        { const unsigned tn = (unsigned)__builtin_amdgcn_s_memrealtime(); tacc1 += tn - tprev; tprev = tn; }
#endif
        if (front)
        {
            const f32x4 a4 = *(const LAS f32x4*)(lds + MX_AL + tt * 256 + q * 16);
            const f32x4 c_kk = *(const LAS f32x4*)(lds + MX_CT + 7 * 256 + q * 16), c_ka = *(const LAS f32x4*)(lds + MX_CT + 8 * 256 + q * 16), c_rk = *(const LAS f32x4*)(lds + MX_CT + 9 * 256 + q * 16);
            f32x4 kkr = k_s * c_kk; float ss = (kkr[0] * kkr[0] + kkr[1] * kkr[1]) + (kkr[2] * kkr[2] + kkr[3] * kkr[3]); ss = red16(ss);
            const float inv = __builtin_amdgcn_rsqf(fmaxf(ss, 1e-24f));
            const f32x4 kk = kkr * inv, km = k_s * (1.0f + (a4 - 1.0f) * c_ka), bb = kk * a4;
            float bo = (r_s[0] * km[0] * c_rk[0] + r_s[1] * km[1] * c_rk[1]) + (r_s[2] * km[2] * c_rk[2] + r_s[3] * km[3] * c_rk[3]); bo = red16(bo);
            if (q == 0) *(LAS float*)(lds + MX_BON + pf * 128 + tt * 4) = bo;
            const int g = tt >> 4, i = tt & 15;
            const f32x4 lg = *(const LAS f32x4*)(lds + MX_LG + tt * 256 + q * 16), ldm = *(const LAS f32x4*)(lds + MX_LD + tt * 256 + q * 16), g16 = *(const LAS f32x4*)(lds + MX_G16 + pf * 512 + g * 256 + q * 16);
            f32x4 e, em, ei, eb;
#pragma unroll
            for (int j = 0; j < 4; ++j) { e[j] = __expf(lg[j]); em[j] = __expf(lg[j] - ldm[j]); ei[j] = __expf(-lg[j]); eb[j] = g16[j] * ei[j]; }
            const f32x4 Kt = kk * em, Rt = r_s * e, Kh = km * ei, Bh = bb * ei, Kb = km * eb, Bb = bb * eb;
            const int ro = g * 16 * KT_ST + i * KT_ST + q * 8;
            { u32x2v w; w.x = pg8::cvt_pk_bf16(Kt[0], Kt[1]); w.y = pg8::cvt_pk_bf16(Kt[2], Kt[3]); *(LAS u32x2v*)(lds + MX_KT + ro) = w; }
            { u32x2v w; w.x = pg8::cvt_pk_bf16(Rt[0], Rt[1]); w.y = pg8::cvt_pk_bf16(Rt[2], Rt[3]); *(LAS u32x2v*)(lds + MX_RT + ro) = w; }
            { u32x2v w; w.x = pg8::cvt_pk_bf16(Kh[0], Kh[1]); w.y = pg8::cvt_pk_bf16(Kh[2], Kh[3]); *(LAS u32x2v*)(lds + MX_KH + ro) = w; }
            { u32x2v w; w.x = pg8::cvt_pk_bf16(Bh[0], Bh[1]); w.y = pg8::cvt_pk_bf16(Bh[2], Bh[3]); *(LAS u32x2v*)(lds + MX_BH + ro) = w; }
            const unsigned kb01 = pg8::cvt_pk_bf16(Kb[0], Kb[1]), kb23 = pg8::cvt_pk_bf16(Kb[2], Kb[3]), nb01 = pg8::cvt_pk_bf16(-Bb[0], -Bb[1]), nb23 = pg8::cvt_pk_bf16(-Bb[2], -Bb[3]);
            const unsigned vv01 = pg8::cvt_pk_bf16(v_n[0], v_n[1]), vv23 = pg8::cvt_pk_bf16(v_n[2], v_n[3]);
            LAS unsigned short* kbp = (LAS unsigned short*)(lds + MX_KB + g * 64 * KB_ST + (4 * q) * KB_ST + i * 2);
            kbp[0] = (unsigned short)kb01; kbp[KB_ST / 2] = (unsigned short)(kb01 >> 16); kbp[KB_ST] = (unsigned short)kb23; kbp[3 * KB_ST / 2] = (unsigned short)(kb23 >> 16);
            kbp[16] = (unsigned short)nb01; kbp[16 + KB_ST / 2] = (unsigned short)(nb01 >> 16); kbp[16 + KB_ST] = (unsigned short)nb23; kbp[16 + 3 * KB_ST / 2] = (unsigned short)(nb23 >> 16);
            LAS unsigned short* vtp = (LAS unsigned short*)(lds + MX_VT + g * 64 * VT_ST + (4 * q) * VT_ST + i * 2);
            vtp[0] = (unsigned short)vv01; vtp[VT_ST / 2] = (unsigned short)(vv01 >> 16); vtp[VT_ST] = (unsigned short)vv23; vtp[3 * VT_ST / 2] = (unsigned short)(vv23 >> 16);
        }
        if (back) {
            {
                const f32x4 y4 = *(const LAS f32x4*)(lds + MX_Y + tt * 256 + q * 16), g4 = *(const LAS f32x4*)(lds + MX_G + pb * 8192 + tt * 256 + q * 16);
                const float bo = *(const LAS float*)(lds + MX_BON + pb * 128 + tt * 4);
                const f32x4 c_gw = *(const LAS f32x4*)(lds + MX_CT + 10 * 256 + q * 16), c_gb = *(const LAS f32x4*)(lds + MX_CT + 11 * 256 + q * 16);
                const f32x4 c_w0 = *(const LAS f32x4*)(lds + MX_CT + 12 * 256 + q * 16), c_w1 = *(const LAS f32x4*)(lds + MX_CT + 13 * 256 + q * 16), c_w2 = *(const LAS f32x4*)(lds + MX_CT + 14 * 256 + q * 16);
                float sm = (y4[0] + y4[1]) + (y4[2] + y4[3]); sm = red16(sm); const float mean = sm * (1.0f / 64.0f);
                const f32x4 dy = y4 - mean; float sv = (dy[0] * dy[0] + dy[1] * dy[1]) + (dy[2] * dy[2] + dy[3] * dy[3]); sv = red16(sv);
                const float rstd = __builtin_amdgcn_rsqf(sv * (1.0f / 64.0f) + GN_EPS);
                const f32x4 ya = (dy * rstd * c_gw + c_gb + bo * v_c) * g4;
                const f32x4 cu0 = *(const LAS f32x4*)(lds + MX_CU + pb * 8704 + tt * 256 + q * 16), cu1 = *(const LAS f32x4*)(lds + MX_CU + pb * 8704 + (tt + 1) * 256 + q * 16);
                const f32x4 yb = unpk4(fB) * (c_w0 * cu0 + c_w1 * cu1 + c_w2 * cu_c);
                const f32x4 ga = unpk4(fA), gb = unpk4(fG);
                f32x4 mo;
#pragma unroll
                for (int j = 0; j < 4; ++j) mo[j] = fsig(ga[j]) * ya[j] + fsig(gb[j]) * yb[j];
                mo_w.x = pg8::cvt_pk_bf16(mo[0], mo[1]); mo_w.y = pg8::cvt_pk_bf16(mo[2], mo[3]);
                if (j == NSC - 1) *(GAS u32x2v*)((GAS bf16*)(F.ws + WS_MIX) + (size_t)(b * TSEQ + chunk * TCH + j * SUBT + tt) * D + hc) = mo_w;
            }
            if (tt >= SUBT - 2) {
                *(LAS f32x4*)(lds + MX_CU + (pb ^ 1) * 8704 + (tt - (SUBT - 2)) * 256 + q * 16) = cu_c;
                if (j == NSC - 1) {
                    if (chunk < NTC - 1) *(GAS f32x4*)(car + 448 + (tt - (SUBT - 2)) * 64 + 4 * q) = cu_c;
                    else *(GAS f32x4*)(F.out + O_CVP + (size_t)(b * 2 + (tt - (SUBT - 2))) * D + hc) = cu_c;
                }
            }
        }
        WG_SYNC();
#ifdef PROBE_MIX
        { const unsigned tn = (unsigned)__builtin_amdgcn_s_memrealtime(); tacc2 += tn - tprev; tprev = tn; }
#endif
        v_c = v_n; cu_c = cu_n;
    }
#ifdef PROBE_MIX
    if (blockIdx.x == 0 && threadIdx.x == 0 && chunk == 1) { __hip_atomic_store(F.ctl + 2048 + 32, tacc0, RLX_AGENT); __hip_atomic_store(F.ctl + 2048 + 33, tacc1, RLX_AGENT); __hip_atomic_store(F.ctl + 2048 + 34, tacc2, RLX_AGENT); __hip_atomic_store(F.ctl + 2048 + 35, tacc3, RLX_AGENT); __hip_atomic_store(F.ctl + 2048 + 36, tprev - tstart, RLX_AGENT); }
#endif
    if (wave < 4) {
#pragma unroll
        for (int kb = 0; kb < 4; ++kb) *(GAS f32x4*)(Sg + (size_t)(16 * wave + lr) * 64 + 16 * kb + 4 * lq) = Hs[kb];
    }
    WG_SYNC();
}


constexpr int SJ_TW = 0, SJ_AD = 256, SJ_SG = 512, SJ_KK = 1024, SJ_BB = 5120, SJ_DD = 9216, SJ_KM = 13312, SJ_RR = 17408, SJ_VV = 21504, SJ_Y = 25600;
__device__ __forceinline__ void sample_job(Frame& F, int s) {
    LAS unsigned char* lds = F.lds;
    asm volatile("" : "+s"(s));
    int tid = threadIdx.x; asm volatile("" : "+v"(tid));
    const int lane = tid & 63, wave = __builtin_amdgcn_readfirstlane(tid >> 6), c0 = 2 * tid;
    const GAS bf16* zr = (const GAS bf16*)(F.ws + WS_ZS) + (size_t)s * NIN;
    const GAS float* sh = F.inp(5) + (size_t)s * SHIFTC; const GAS float* mu = F.inp(13);
    float r_s[2], k_s[2], v_s[2];
    {
        const unsigned zr2 = *(const GAS unsigned*)(zr + c0), zk2 = *(const GAS unsigned*)(zr + 1024 + c0), zv2 = *(const GAS unsigned*)(zr + 2048 + c0);
        const f32x2 pr = *(const GAS f32x2*)(sh + c0), pk = *(const GAS f32x2*)(sh + 1024 + c0), pv = *(const GAS f32x2*)(sh + 2048 + c0);
        const f32x2 mr = *(const GAS f32x2*)(mu + c0), mk = *(const GAS f32x2*)(mu + 1024 + c0), mv = *(const GAS f32x2*)(mu + 2048 + c0);
        float z;
        z = bf_lo(zr2); r_s[0] = z + mr.x * (pr.x - z); z = bf_hi(zr2); r_s[1] = z + mr.y * (pr.y - z);
        z = bf_lo(zk2); k_s[0] = z + mk.x * (pk.x - z); z = bf_hi(zk2); k_s[1] = z + mk.y * (pk.y - z);
        z = bf_lo(zv2); v_s[0] = z + mv.x * (pv.x - z); z = bf_hi(zv2); v_s[1] = z + mv.y * (pv.y - z);
    }
    for (int c = 2 * tid; c < SHIFTC; c += 2 * NWAVES * 64) { const unsigned z2 = *(const GAS unsigned*)(zr + c); *(GAS f32x2*)(F.out + O_SHS + (size_t)s * SHIFTC + c) = (f32x2){bf_lo(z2), bf_hi(z2)}; }
    if (tid < 128) {
        const int i = 2 * tid; const unsigned z2 = *(const GAS unsigned*)(zr + 3072 + i); const f32x2 p = *(const GAS f32x2*)(sh + 3072 + i), m = *(const GAS f32x2*)(mu + 3072 + i);
        float a = bf_lo(z2), b2 = bf_hi(z2); a = a + m.x * (p.x - a); b2 = b2 + m.y * (p.y - b2);
        if (i < 64) { a = ftanh(a); b2 = ftanh(b2); } else if (i >= 128) { a = fsig(a); b2 = fsig(b2); }
        *(LAS f32x2*)(lds + SJ_TW + i * 4) = (f32x2){a, b2};
    }
    WG_SYNC();
    float dd[2], al[2], gg[2];
#pragma unroll
    for (int e = 0; e < 2; ++e) {
        const int n = c0 + e;
        const GAS bf16* wd = (const GAS bf16*)(F.ws + WS_WDU) + (size_t)n * 64; const GAS bf16* wi = (const GAS bf16*)(F.ws + WS_WIU) + (size_t)n * 64; const GAS bf16* wg = (const GAS bf16*)(F.ws + WS_WGU) + (size_t)n * 128;
        float s1 = 0.f, s2 = 0.f, s3 = 0.f;
#pragma unroll 2
        for (int k8 = 0; k8 < 8; ++k8) { const v4u a = *(const GAS v4u*)(wd + 8 * k8), b4 = *(const GAS v4u*)(wi + 8 * k8);
            const f32x4 t0 = *(const LAS f32x4*)(lds + SJ_TW + k8 * 32), t1 = *(const LAS f32x4*)(lds + SJ_TW + k8 * 32 + 16), u0 = *(const LAS f32x4*)(lds + SJ_AD + k8 * 32), u1 = *(const LAS f32x4*)(lds + SJ_AD + k8 * 32 + 16);
            s1 += (bf_lo(a.x) * t0[0] + bf_hi(a.x) * t0[1]) + (bf_lo(a.y) * t0[2] + bf_hi(a.y) * t0[3]) + (bf_lo(a.z) * t1[0] + bf_hi(a.z) * t1[1]) + (bf_lo(a.w) * t1[2] + bf_hi(a.w) * t1[3]);
            s2 += (bf_lo(b4.x) * u0[0] + bf_hi(b4.x) * u0[1]) + (bf_lo(b4.y) * u0[2] + bf_hi(b4.y) * u0[3]) + (bf_lo(b4.z) * u1[0] + bf_hi(b4.z) * u1[1]) + (bf_lo(b4.w) * u1[2] + bf_hi(b4.w) * u1[3]); }
#pragma unroll 4
        for (int k8 = 0; k8 < 16; ++k8) { const v4u a = *(const GAS v4u*)(wg + 8 * k8);
            const f32x4 t0 = *(const LAS f32x4*)(lds + SJ_SG + k8 * 32), t1 = *(const LAS f32x4*)(lds + SJ_SG + k8 * 32 + 16);
            s3 += (bf_lo(a.x) * t0[0] + bf_hi(a.x) * t0[1]) + (bf_lo(a.y) * t0[2] + bf_hi(a.y) * t0[3]) + (bf_lo(a.z) * t1[0] + bf_hi(a.z) * t1[1]) + (bf_lo(a.w) * t1[2] + bf_hi(a.w) * t1[3]); }
        dd[e] = decay_of(F.inp(15)[n] + s1); al[e] = fsig(F.inp(17)[n] + s2); gg[e] = s3;
    }
    float bon;
    {
        const f32x2 ck = *(const GAS f32x2*)(F.inp(19) + c0), ca = *(const GAS f32x2*)(F.inp(20) + c0), crk = *(const GAS f32x2*)(F.inp(21) + c0);
        const float k0r = k_s[0] * ck.x, k1r = k_s[1] * ck.y; float ss = k0r * k0r + k1r * k1r;
#pragma unroll
        for (int o = 1; o < 32; o <<= 1) ss += __shfl_xor(ss, o);
        const float inv = 1.0f / fmaxf(sqrtf(ss), 1e-12f);
        const float kk0 = k0r * inv, kk1 = k1r * inv, km0 = k_s[0] * (1.0f + (al[0] - 1.0f) * ca.x), km1 = k_s[1] * (1.0f + (al[1] - 1.0f) * ca.y);
        bon = r_s[0] * km0 * crk.x + r_s[1] * km1 * crk.y;
#pragma unroll
        for (int o = 1; o < 32; o <<= 1) bon += __shfl_xor(bon, o);
        *(LAS f32x2*)(lds + SJ_KK + c0 * 4) = (f32x2){kk0, kk1}; *(LAS f32x2*)(lds + SJ_BB + c0 * 4) = (f32x2){kk0 * al[0], kk1 * al[1]}; *(LAS f32x2*)(lds + SJ_DD + c0 * 4) = (f32x2){dd[0], dd[1]};
        *(LAS f32x2*)(lds + SJ_KM + c0 * 4) = (f32x2){km0, km1}; *(LAS f32x2*)(lds + SJ_RR + c0 * 4) = (f32x2){r_s[0], r_s[1]}; *(LAS f32x2*)(lds + SJ_VV + c0 * 4) = (f32x2){v_s[0], v_s[1]};
    }
    WG_SYNC();
    {
        const int kq = lane & 15, rg = lane >> 4;
#pragma unroll 1
        for (int hh = 0; hh < 2; ++hh) {
            const int h = 2 * wave + hh;
            const f32x4 kk4 = *(const LAS f32x4*)(lds + SJ_KK + (64 * h + 4 * kq) * 4), b4 = *(const LAS f32x4*)(lds + SJ_BB + (64 * h + 4 * kq) * 4), d4 = *(const LAS f32x4*)(lds + SJ_DD + (64 * h + 4 * kq) * 4);
            const f32x4 km4 = *(const LAS f32x4*)(lds + SJ_KM + (64 * h + 4 * kq) * 4), r4 = *(const LAS f32x4*)(lds + SJ_RR + (64 * h + 4 * kq) * 4);
            const size_t sbase = ((size_t)(s * NHEAD + h) * 64) * 64;
#pragma unroll 2
            for (int ps = 0; ps < 8; ++ps) {
                const int v0 = 8 * ps + 2 * rg;
                f32x4 S0 = *(const GAS f32x4*)(F.inp(4) + sbase + (size_t)v0 * 64 + 4 * kq), S1 = *(const GAS f32x4*)(F.inp(4) + sbase + (size_t)(v0 + 1) * 64 + 4 * kq);
                const f32x2 v2 = *(const LAS f32x2*)(lds + SJ_VV + (64 * h + v0) * 4);
                float p0 = (S0[0] * kk4[0] + S0[1] * kk4[1]) + (S0[2] * kk4[2] + S0[3] * kk4[3]), p1 = (S1[0] * kk4[0] + S1[1] * kk4[1]) + (S1[2] * kk4[2] + S1[3] * kk4[3]);
                p0 = red16(p0); p1 = red16(p1);
#pragma unroll
                for (int j = 0; j < 4; ++j) { S0[j] = S0[j] * d4[j] + (v2.x * km4[j] - p0 * b4[j]); S1[j] = S1[j] * d4[j] + (v2.y * km4[j] - p1 * b4[j]); }
                float y0 = (S0[0] * r4[0] + S0[1] * r4[1]) + (S0[2] * r4[2] + S0[3] * r4[3]), y1 = (S1[0] * r4[0] + S1[1] * r4[1]) + (S1[2] * r4[2] + S1[3] * r4[3]);
                y0 = red16(y0); y1 = red16(y1);
                *(GAS f32x4*)(F.out + O_WKVS + sbase + (size_t)v0 * 64 + 4 * kq) = S0; *(GAS f32x4*)(F.out + O_WKVS + sbase + (size_t)(v0 + 1) * 64 + 4 * kq) = S1;
                if (kq == 0) *(LAS f32x2*)(lds + SJ_Y + (64 * h + v0) * 4) = (f32x2){y0, y1};
            }
        }
    }
    WG_SYNC();
    {
        const f32x2 y2 = *(const LAS f32x2*)(lds + SJ_Y + c0 * 4);
        float sm = y2.x + y2.y;
#pragma unroll
        for (int o = 1; o < 32; o <<= 1) sm += __shfl_xor(sm, o);
        const float mean = sm * (1.0f / 64.0f), d0 = y2.x - mean, d1 = y2.y - mean; float sv = d0 * d0 + d1 * d1;
#pragma unroll
        for (int o = 1; o < 32; o <<= 1) sv += __shfl_xor(sv, o);
        const float rstd = __builtin_amdgcn_rsqf(sv * (1.0f / 64.0f) + GN_EPS);
        const f32x2 gw = *(const GAS f32x2*)(F.inp(22) + c0), gb = *(const GAS f32x2*)(F.inp(23) + c0);
        const float ya0 = (d0 * rstd * gw.x + gb.x + bon * v_s[0]) * gg[0], ya1 = (d1 * rstd * gw.y + gb.y + bon * v_s[1]) * gg[1];
        const unsigned zB = *(const GAS unsigned*)(zr + 3328 + c0), zC = *(const GAS unsigned*)(zr + 4352 + c0), zU = *(const GAS unsigned*)(zr + 5376 + c0), zgA = *(const GAS unsigned*)(zr + 6400 + c0), zgB = *(const GAS unsigned*)(zr + 7424 + c0);
        const f32x2 cv0 = *(const GAS f32x2*)(F.inp(6) + (size_t)(s * 2) * D + c0), cv1 = *(const GAS f32x2*)(F.inp(6) + (size_t)(s * 2 + 1) * D + c0);
        const f32x2 w0 = *(const GAS f32x2*)(F.inp(24) + c0), w1 = *(const GAS f32x2*)(F.inp(24) + 1024 + c0), w2 = *(const GAS f32x2*)(F.inp(24) + 2048 + c0);
        const float cu0 = bf_lo(zC) * bf_lo(zU), cu1 = bf_hi(zC) * bf_hi(zU);
        const float yb0 = bf_lo(zB) * (w0.x * cv0.x + w1.x * cv1.x + w2.x * cu0), yb1 = bf_hi(zB) * (w0.y * cv0.y + w1.y * cv1.y + w2.y * cu1);
        const float m0 = fsig(bf_lo(zgA)) * ya0 + fsig(bf_lo(zgB)) * yb0, m1 = fsig(bf_hi(zgA)) * ya1 + fsig(bf_hi(zgB)) * yb1;
#if DBG_MIX
        *(GAS unsigned*)((GAS bf16*)(F.ws + WS_MIX) + (size_t)(MPR + s) * D + c0) = 0u; (void)m0; (void)m1;
#else
        *(GAS unsigned*)((GAS bf16*)(F.ws + WS_MIX) + (size_t)(MPR + s) * D + c0) = pg8::cvt_pk_bf16(m0, m1);
#endif
        *(GAS f32x2*)(F.out + O_CVS + (size_t)(s * 2) * D + c0) = cv1; *(GAS f32x2*)(F.out + O_CVS + (size_t)(s * 2 + 1) * D + c0) = (f32x2){cu0, cu1};
    }
    WG_SYNC();
}


enum StripKind { SK_SWIGLU = 0, SK_RES = 1, SK_Z = 2, SK_PP = 3, SK_PLE = 4 };
struct StripArgs { const GAS bf16* A; const GAS bf16* Wt; int K; GAS bf16* Ob; const GAS float* X; const GAS bf16* PP; float alpha; bool scale; };
template <int KIND> __device__ __forceinline__ void strip_gemm(const StripArgs& a, int mb, int pn) {
    int tid = threadIdx.x; asm volatile("" : "+v"(tid));
    const int lane = tid & 63, w = __builtin_amdgcn_readfirstlane(tid >> 6), lr = lane & 15, lq = lane >> 4;
    const int K = a.K, row = MPR + 16 * mb + lr;
    int wr0, wr1;
    if (KIND == SK_SWIGLU) { wr0 = 256 * pn + 16 * w + lr; wr1 = wr0 + 128; }
    else if (KIND == SK_Z || KIND == SK_PP) { wr0 = 256 * pn + 32 * w + 8 * (lr >> 2) + (lr & 3); wr1 = wr0 + 4; }
    else { wr0 = 256 * pn + 32 * w + lr; wr1 = wr0 + 16; }
    const GAS bf16* ap = a.A + (size_t)row * K + 8 * lq; const GAS bf16* w0p = a.Wt + (size_t)wr0 * K + 8 * lq; const GAS bf16* w1p = a.Wt + (size_t)wr1 * K + 8 * lq;
    f32x4 acc0 = (f32x4){0.f, 0.f, 0.f, 0.f}, acc1 = acc0; float ssq = 0.f;
#pragma unroll 1
    for (int ks0 = 0; ks0 < K / 32; ks0 += 8) {
        v4u av[8], b0[8], b1[8];
#pragma unroll
        for (int i = 0; i < 8; ++i) { av[i] = *(const GAS v4u*)(ap + 32 * (ks0 + i)); b0[i] = *(const GAS v4u*)(w0p + 32 * (ks0 + i)); b1[i] = *(const GAS v4u*)(w1p + 32 * (ks0 + i)); }
        __builtin_amdgcn_sched_barrier(0);
#pragma unroll
        for (int i = 0; i < 8; ++i) {
            if (KIND == SK_SWIGLU || KIND == SK_Z || KIND == SK_PLE) {
                const float x0 = bf_lo(av[i].x), x1 = bf_hi(av[i].x), x2 = bf_lo(av[i].y), x3 = bf_hi(av[i].y), x4 = bf_lo(av[i].z), x5 = bf_hi(av[i].z), x6 = bf_lo(av[i].w), x7 = bf_hi(av[i].w);
                ssq += ((x0 * x0 + x1 * x1) + (x2 * x2 + x3 * x3)) + ((x4 * x4 + x5 * x5) + (x6 * x6 + x7 * x7)); }
            const bf16x8 af = __builtin_bit_cast(bf16x8, av[i]);
            acc0 = __builtin_amdgcn_mfma_f32_16x16x32_bf16(__builtin_bit_cast(bf16x8, b0[i]), af, acc0, 0, 0, 0);
            acc1 = __builtin_amdgcn_mfma_f32_16x16x32_bf16(__builtin_bit_cast(bf16x8, b1[i]), af, acc1, 0, 0, 0);
        }
    }
    float sc = 1.0f;
    if (KIND == SK_Z || KIND == SK_PLE || (KIND == SK_SWIGLU && a.scale)) { ssq += __shfl_xor(ssq, 16); ssq += __shfl_xor(ssq, 32); sc = __builtin_amdgcn_rsqf(ssq * (1.0f / 1024.0f) + RMS_EPS); }
    if (KIND == SK_SWIGLU) {
        f32x4 v;
#pragma unroll
        for (int j = 0; j < 4; ++j) { const float g = acc0[j] * sc, u = acc1[j] * sc; v[j] = g * fsig(g) * u; }
        u32x2v o; o.x = pg8::cvt_pk_bf16(v[0], v[1]); o.y = pg8::cvt_pk_bf16(v[2], v[3]);
        *(GAS u32x2v*)(a.Ob + (size_t)row * FF + 128 * pn + 16 * w + 4 * lq) = o;
    } else if (KIND == SK_Z || KIND == SK_PP) {
        const f32x4 v0 = acc0 * sc, v1 = acc1 * sc;
        v4u o; o.x = pg8::cvt_pk_bf16(v0[0], v0[1]); o.y = pg8::cvt_pk_bf16(v0[2], v0[3]); o.z = pg8::cvt_pk_bf16(v1[0], v1[1]); o.w = pg8::cvt_pk_bf16(v1[2], v1[3]);
        if (KIND == SK_Z) *(GAS v4u*)(a.Ob + (size_t)(16 * mb + lr) * NIN + 256 * pn + 32 * w + 8 * lq) = o;
        else *(GAS v4u*)(a.Ob + (size_t)row * D + 256 * pn + 32 * w + 8 * lq) = o;
    } else {
#pragma unroll
        for (int nb = 0; nb < 2; ++nb) { const size_t off = (size_t)row * D + 256 * pn + 32 * w + 16 * nb + 4 * lq; const f32x4 ac = nb ? acc1 : acc0;
            const f32x4 xin = a.X ? *(const GAS f32x4*)(a.X + off) : unpk4(*(const GAS u32x2v*)((KIND == SK_PLE ? a.A : (const GAS bf16*)a.Ob) + off)); f32x4 xo;
            if (KIND == SK_RES) xo = xin + ac * a.alpha;
            else { const f32x4 pv = unpk4(*(const GAS u32x2v*)(a.PP + off));
#pragma unroll
                for (int j = 0; j < 4; ++j) xo[j] = xin[j] + fsig(ac[j] * sc) * pv[j]; }
            { u32x2v o; o.x = pg8::cvt_pk_bf16(xo[0], xo[1]); o.y = pg8::cvt_pk_bf16(xo[2], xo[3]); *(GAS u32x2v*)(a.Ob + off) = o; } }
    }
}
template <int KIND> __device__ __forceinline__ void strip_phase(const StripArgs& a, int ntn, int G, int c, int c0) {
    if (c >= c0) for (int s = c - c0; s < 8 * ntn; s += G - c0) strip_gemm<KIND>(a, s & 7, s >> 3);
}


template <int KIND, int KSW  > __device__ __forceinline__ void strip_gemm_sk(const StripArgs& a, LAS unsigned char* lds, int mb, int pn, int wg) {
    int tid = threadIdx.x; asm volatile("" : "+v"(tid));
    const int lane = tid & 63, w = __builtin_amdgcn_readfirstlane(tid >> 6), lr = lane & 15, lq = lane >> 4;
    const int K = a.K, row = MPR + 16 * mb + lr;
    int wr0, wr1;
    if (KIND == SK_PP) { wr0 = 256 * pn + 32 * wg + 8 * (lr >> 2) + (lr & 3); wr1 = wr0 + 4; }
    else { wr0 = 256 * pn + 32 * wg + lr; wr1 = wr0 + 16; }
    const int k0 = 32 * KSW * w + 8 * lq;
    const GAS bf16* ap = a.A + (size_t)row * K + k0; const GAS bf16* w0p = a.Wt + (size_t)wr0 * K + k0; const GAS bf16* w1p = a.Wt + (size_t)wr1 * K + k0;
    v4u av[KSW], b0[KSW], b1[KSW];
#pragma unroll
    for (int i = 0; i < KSW; ++i) { av[i] = *(const GAS v4u*)(ap + 32 * i); b0[i] = *(const GAS v4u*)(w0p + 32 * i); b1[i] = *(const GAS v4u*)(w1p + 32 * i); }
    __builtin_amdgcn_sched_barrier(0);
    f32x4 acc0 = (f32x4){0.f, 0.f, 0.f, 0.f}, acc1 = acc0; float ssq = 0.f;
#pragma unroll
    for (int i = 0; i < KSW; ++i) {
        if (KIND == SK_PLE) {
            const float x0 = bf_lo(av[i].x), x1 = bf_hi(av[i].x), x2 = bf_lo(av[i].y), x3 = bf_hi(av[i].y), x4 = bf_lo(av[i].z), x5 = bf_hi(av[i].z), x6 = bf_lo(av[i].w), x7 = bf_hi(av[i].w);
            ssq += ((x0 * x0 + x1 * x1) + (x2 * x2 + x3 * x3)) + ((x4 * x4 + x5 * x5) + (x6 * x6 + x7 * x7)); }
        const bf16x8 af = __builtin_bit_cast(bf16x8, av[i]);
        acc0 = __builtin_amdgcn_mfma_f32_16x16x32_bf16(__builtin_bit_cast(bf16x8, b0[i]), af, acc0, 0, 0, 0);
        acc1 = __builtin_amdgcn_mfma_f32_16x16x32_bf16(__builtin_bit_cast(bf16x8, b1[i]), af, acc1, 0, 0, 0);
    }
    if (KIND == SK_PLE) { ssq += __shfl_xor(ssq, 16); ssq += __shfl_xor(ssq, 32); }
    LAS unsigned char* slot = lds + (w * 64 + lane) * 48;
    *(LAS f32x4*)slot = acc0; *(LAS f32x4*)(slot + 16) = acc1; *(LAS float*)(slot + 32) = ssq;
    WG_SYNC();
    if (w == 0) {
        f32x4 s0 = (f32x4){0.f, 0.f, 0.f, 0.f}, s1 = s0; float sq = 0.f;
#pragma unroll
        for (int j = 0; j < 8; ++j) { const LAS unsigned char* p = lds + (j * 64 + lane) * 48; s0 = s0 + *(const LAS f32x4*)p; s1 = s1 + *(const LAS f32x4*)(p + 16); sq += *(const LAS float*)(p + 32); }
        const float sc = (KIND == SK_PLE) ? __builtin_amdgcn_rsqf(sq * (1.0f / 1024.0f) + RMS_EPS) : 1.0f;
        if (KIND == SK_PP) {
            v4u o; o.x = pg8::cvt_pk_bf16(s0[0], s0[1]); o.y = pg8::cvt_pk_bf16(s0[2], s0[3]); o.z = pg8::cvt_pk_bf16(s1[0], s1[1]); o.w = pg8::cvt_pk_bf16(s1[2], s1[3]);
            *(GAS v4u*)(a.Ob + (size_t)row * D + 256 * pn + 32 * wg + 8 * lq) = o;
        } else {
#pragma unroll
            for (int nb = 0; nb < 2; ++nb) { const size_t off = (size_t)row * D + 256 * pn + 32 * wg + 16 * nb + 4 * lq; const f32x4 ac = nb ? s1 : s0;
                const f32x4 xin = a.X ? *(const GAS f32x4*)(a.X + off) : unpk4(*(const GAS u32x2v*)((KIND == SK_PLE ? a.A : (const GAS bf16*)a.Ob) + off)); f32x4 xo;
                if (KIND == SK_RES) xo = xin + ac * a.alpha;
                else { const f32x4 pv = unpk4(*(const GAS u32x2v*)(a.PP + off));
#pragma unroll
                    for (int j = 0; j < 4; ++j) xo[j] = xin[j] + fsig(ac[j] * sc) * pv[j]; }
                { u32x2v o; o.x = pg8::cvt_pk_bf16(xo[0], xo[1]); o.y = pg8::cvt_pk_bf16(xo[2], xo[3]); *(GAS u32x2v*)(a.Ob + off) = o; } }
        }
    }
    WG_SYNC();
}
template <int KIND, int KSW> __device__ __forceinline__ void strip_phase_sk(const StripArgs& a, LAS unsigned char* lds, int G, int c) {
    for (int j = c; j < 256; j += G) strip_gemm_sk<KIND, KSW>(a, lds, j & 7, (j >> 3) & 3, j >> 5);
}

struct Args { const float* in[34]; float* out; unsigned char* ws; int ph_lo, ph_hi, li, pad; };
__global__ void __launch_bounds__(NWAVES * 64, 2) mk_fwd(Args args) {
    extern __shared__ __attribute__((aligned(16))) unsigned char lds[];
    Frame F;
    F.lds = (LAS unsigned char*)lds;
    F.MISC = (volatile LAS unsigned*)(F.lds + MISC_OFF);
    F.tid = threadIdx.x; F.lane = F.tid & 63; F.wave = __builtin_amdgcn_readfirstlane(F.tid >> 6);
    F.G = gridDim.x; { const int bx = blockIdx.x; F.vcu = (F.G % 8 == 0) ? (bx % 8) * (F.G / 8) + bx / 8 : bx; }
    GAS unsigned char* ws = (GAS unsigned char*)args.ws; F.ws = ws; F.out = (GAS float*)args.out;
    F.ctl = (gu32*)(ws + WS_CTL);
    for (int u = F.tid; u < (LDS_BYTES - LDSCTL_OFF) / 4; u += NWAVES * 64) ((LAS unsigned*)(F.lds + LDSCTL_OFF))[u] = 0u;
    __syncthreads();
#pragma unroll
    for (int i = 0; i < 34; ++i) if (F.tid == i) *(LAS unsigned long long*)(F.lds + PTR_OFF + 8 * i) = (unsigned long long)args.in[i];
    __syncthreads();
    XcdBarrier bar; bar.bar = (unsigned*)(F.ctl + CW_BAR); bar.x = 0; bar.st = nullptr;
    if (N_LAUNCHES == 1) bar = xcd_barrier_post((unsigned*)(F.ctl + CW_BAR), F.MISC + 8);
#define GRID_BAR() do { if (N_LAUNCHES == 1) xcd_barrier(bar); } while (0)
    const int lo = args.ph_lo, hi = args.ph_hi;
#ifndef PH_MASK
#define PH_MASK 0x3fff
#endif
#ifdef PROBE_TS_A
#define IN(k) ((((blockIdx.x == 0 && threadIdx.x == 0) ? (void)__hip_atomic_store(F.ctl + 2048 + (k), (unsigned)__builtin_amdgcn_s_memrealtime(), RLX_AGENT) : (void)0), true) && ((PH_MASK >> (k)) & 1) && lo <= (k) && (k) < hi)
#else
#define IN(k) (((PH_MASK >> (k)) & 1) && lo <= (k) && (k) < hi)
#endif
#define IN0(k) (((PH_MASK >> (k)) & 1) && lo <= (k) && (k) < hi)
#define BOTH(k) (IN0(k) && IN0((k) + 1))
    GAS bf16* const XB = (GAS bf16*)(ws + WS_XB); GAS bf16* const MIXB = (GAS bf16*)(ws + WS_MIX); GAS bf16* const GU = (GAS bf16*)(ws + WS_GU); GAS float* const SSQ = (GAS float*)(ws + WS_SSQ);
    GAS bf16* const PPB = (GAS bf16*)F.out;
    GAS bf16* const XF = (GAS bf16*)(ws + WS_GU);
#define GP(p) ((const bf16*)(p))

    if (IN(0)) { asm volatile("; MARK P0"); p0_prologue(F); if (BOTH(0)) GRID_BAR(); }
#ifndef REP_P1
#define REP_P1 1
#endif
    for (int rep = 0; rep < REP_P1; ++rep)
    if (IN(1)) { asm volatile("; MARK P1");
        pg8::Gemm g{GP(XB), GP(ws + WS_W1GU), MP, 2 * FF, D}; pg8::StaticOrder S; S.init(MPR, 2 * FF, F.G, (int)blockIdx.x);
        pg8::EpiSwiglu E{GU, F.lds, false};
        pg8::gemm_phase<pg8::EpiSwiglu, pg8::StaticOrder, true, true>(F.lds + RING_OFF, g, S, E);
#ifndef REP_S1
#define REP_S1 1
#endif
        for (int rs = 0; rs < REP_S1; ++rs)
        { const StripArgs sa{XB, (const GAS bf16*)(ws + WS_W1GU), D, GU, nullptr, nullptr, 0.f, false}; strip_phase<SK_SWIGLU>(sa, 2 * FF / 256, F.G, (int)blockIdx.x, F.G / 2); }
        if ((int)blockIdx.x >= F.G / 2) convert_group(F, 1, ((int)blockIdx.x - F.G / 2) * NWAVES + F.wave, (F.G / 2) * NWAVES);
        if (BOTH(1)) GRID_BAR();
    }
#ifndef REP_P2
#define REP_P2 1
#endif
    for (int rep = 0; rep < REP_P2; ++rep)
    if (IN(2)) { asm volatile("; MARK P2");
        pg8::Gemm g{GP(GU), GP(ws + WS_W1D), MP, D, FF}; pg8::StaticOrder S; S.init(MPR, D, F.G, (int)blockIdx.x);
        pg8::EpiRes E{F.inp(0), XB, SSQ, 0.5f};
#ifndef REP_G2
#define REP_G2 1
#endif
        for (int rg2 = 0; rg2 < REP_G2; ++rg2)
        pg8::gemm_phase<pg8::EpiRes, pg8::StaticOrder, true, true>(F.lds + RING_OFF, g, S, E);
        { const StripArgs sa{GU, (const GAS bf16*)(ws + WS_W1D), FF, XB, F.inp(1) - (size_t)MPR * D, nullptr, 0.5f, false}; strip_phase_sk<SK_RES, FF / 256>(sa, F.lds, F.G, (int)blockIdx.x); }
        if (BOTH(2)) GRID_BAR();
    }
    for (int r3 = 0; r3 < REP_P3; ++r3)
    if (IN(3)) { asm volatile("; MARK P3");
        pg8::Gemm g{GP(XB), GP(ws + WS_WIN), MP, NIN, D}; pg8::ChunkOrder S; S.init(2 * NBATCH, NIN / 256, F.G, (int)blockIdx.x, 0);
        pg8::precompute_scales(F.lds, S, SSQ);
        pg8::EpiZ E{(GAS bf16*)(ws + WS_Z), F.lds, (GAS bf16*)(ws + WS_ZX)};
        pg8::gemm_phase<pg8::EpiZ, pg8::ChunkOrder, true, true>(F.lds + RING_OFF, g, S, E);
        { pg8::TailOrder T; T.init((int)blockIdx.x); WG_SYNC(); pg8::precompute_scales(F.lds, T, SSQ);
          pg8::gemm_phase<pg8::EpiZ, pg8::TailOrder, true, true>(F.lds + RING_OFF, g, T, E); }
        { const StripArgs sa{XB, (const GAS bf16*)(ws + WS_WIN), D, (GAS bf16*)(ws + WS_ZS), nullptr, nullptr, 0.f, true}; strip_phase<SK_Z>(sa, NIN / 256, F.G, (int)blockIdx.x, 64); }
        if ((int)blockIdx.x >= 64) convert_group(F, 2, ((int)blockIdx.x - 64) * NWAVES + F.wave, (F.G - 64) * NWAVES);
        if (BOTH(3)) GRID_BAR();
    }
#pragma unroll 1
    for (int ch = 0; ch < NTC; ++ch) {
        if (IN(4 + ch)) { asm volatile("; MARK P4");
            const int x = (int)blockIdx.x & 7, i = (int)blockIdx.x >> 3;
            if (i < 16) { mix_job(F, x, i, ch);
#ifdef PROBE_TS_A
                if (blockIdx.x == 0 && threadIdx.x == 0) __hip_atomic_store(F.ctl + 2048 + 20 + ch, (unsigned)__builtin_amdgcn_s_memrealtime(), RLX_AGENT);
#endif
            }
            else if (ch + 1 < NTC) {
                pg8::Gemm g{GP(XB), GP(ws + WS_WIN), MP, NIN, D}; pg8::ChunkOrder S; S.init(2 * NBATCH, NIN / 256 - 1, F.G / 2, (i - 16) * 8 + x, ch + 1);
                pg8::precompute_scales(F.lds, S, SSQ);
                pg8::EpiZ E{(GAS bf16*)(ws + WS_Z + (size_t)((ch + 1) & 1) * ZCH_BYTES), F.lds, (GAS bf16*)(ws + WS_ZX)};
                pg8::gemm_phase<pg8::EpiZ, pg8::ChunkOrder, true, true>(F.lds + RING_OFF, g, S, E);
#ifdef PROBE_TS_A
                if (blockIdx.x == 128 && threadIdx.x == 0) __hip_atomic_store(F.ctl + 2048 + 24 + ch, (unsigned)__builtin_amdgcn_s_memrealtime(), RLX_AGENT);
                if (blockIdx.x == 255 && threadIdx.x == 0) __hip_atomic_store(F.ctl + 2048 + 28 + ch, (unsigned)__builtin_amdgcn_s_memrealtime(), RLX_AGENT);
#endif
            } else {
                const int cg = (i - 16) * 8 + x;
                sample_job(F, 16 * x + (i - 16));
                { pg8::Gemm g{GP(ws + WS_PB), GP(ws + WS_WPP), MP, D, PLE}; pg8::StaticOrder S; S.init(MPR, D, F.G / 2, cg);
                  pg8::EpiPP E{PPB, D};
                  pg8::gemm_phase<pg8::EpiPP, pg8::StaticOrder, true, true>(F.lds + RING_OFF, g, S, E);
                  const StripArgs sa{(const GAS bf16*)(ws + WS_PB), (const GAS bf16*)(ws + WS_WPP), PLE, PPB, nullptr, nullptr, 0.f, false}; strip_phase_sk<SK_PP, PLE / 256>(sa, F.lds, F.G / 2, cg); }
                convert_group(F, 3, cg * NWAVES + F.wave, (F.G / 2) * NWAVES);
            }
            if (BOTH(4 + ch)) GRID_BAR();
        }
    }
    for (int r5 = 0; r5 < REP_P5; ++r5)
    if (IN(8)) { asm volatile("; MARK P5");
        pg8::Gemm g{GP(MIXB), GP(ws + WS_WOUT), MP, D, D}; pg8::StaticOrder S; S.init(MPR, D, F.G, (int)blockIdx.x);
        pg8::EpiRes E{nullptr, XB, SSQ, 1.0f / REP_P5};
        pg8::gemm_phase<pg8::EpiRes, pg8::StaticOrder, true, true>(F.lds + RING_OFF, g, S, E);
        { const StripArgs sa{MIXB, (const GAS bf16*)(ws + WS_WOUT), D, XB, nullptr, nullptr, 1.0f / REP_P5, false}; strip_phase_sk<SK_RES, D / 256>(sa, F.lds, F.G, (int)blockIdx.x); }
        if (BOTH(8)) GRID_BAR();
    }
    for (int r6 = 0; r6 < REP_P6; ++r6)
    if (IN(9)) { asm volatile("; MARK P6");
        pg8::Gemm g{GP(XB), GP(ws + WS_W2GU), MP, 2 * FF, D}; pg8::StaticOrder S; S.init(MPR, 2 * FF, F.G, (int)blockIdx.x);
        pg8::precompute_scales(F.lds, S, SSQ);
        pg8::EpiSwiglu E{GU, F.lds, true};
        pg8::gemm_phase<pg8::EpiSwiglu, pg8::StaticOrder, true, true>(F.lds + RING_OFF, g, S, E);
        { const StripArgs sa{XB, (const GAS bf16*)(ws + WS_W2GU), D, GU, nullptr, nullptr, 0.f, true}; strip_phase<SK_SWIGLU>(sa, 2 * FF / 256, F.G, (int)blockIdx.x, F.G / 2); }
        if (BOTH(9)) GRID_BAR();
    }
    if (IN(10)) { asm volatile("; MARK P7");
        pg8::Gemm g{GP(GU), GP(ws + WS_W2D), MP, D, FF}; pg8::StaticOrder S; S.init(MPR, D, F.G, (int)blockIdx.x);
        pg8::EpiRes E{nullptr, XB, SSQ, 0.5f};
        pg8::gemm_phase<pg8::EpiRes, pg8::StaticOrder, true, true>(F.lds + RING_OFF, g, S, E);
        { const StripArgs sa{GU, (const GAS bf16*)(ws + WS_W2D), FF, XB, nullptr, nullptr, 0.5f, false}; strip_phase_sk<SK_RES, FF / 256>(sa, F.lds, F.G, (int)blockIdx.x); }
    }
    if (IN(11)) { if (BOTH(11)) GRID_BAR(); }
    if (IN(12)) { asm volatile("; MARK P8");
        pg8::Gemm g{GP(XB), GP(ws + WS_WPG), MP, D, D}; pg8::StaticOrder S; S.init(MPR, D, F.G, (int)blockIdx.x);
        pg8::precompute_scales(F.lds, S, SSQ);
        pg8::EpiPle E{XB, XF, PPB, F.lds};
        pg8::gemm_phase<pg8::EpiPle, pg8::StaticOrder, true, true>(F.lds + RING_OFF, g, S, E);
        { const StripArgs sa{XB, (const GAS bf16*)(ws + WS_WPG), D, XF, nullptr, PPB, 0.f, true}; strip_phase_sk<SK_PLE, D / 256>(sa, F.lds, F.G, (int)blockIdx.x); }
        if (BOTH(12)) GRID_BAR();
    }
    if (IN(13)) { asm volatile("; MARK P9"); p9_final(F); }
#ifdef PROBE_TS_A
    if (blockIdx.x == 0 && threadIdx.x == 0) { __hip_atomic_store(F.ctl + 2048 + 14, (unsigned)__builtin_amdgcn_s_memrealtime(), RLX_AGENT); asm volatile("s_waitcnt vmcnt(0)" ::: "memory"); const unsigned ta = __hip_atomic_load(F.ctl + 2048 + PROBE_TS_A, RLX_AGENT), tb = __hip_atomic_load(F.ctl + 2048 + PROBE_TS_B, RLX_AGENT);
        F.out[0] += ((float)(tb - ta) * 0.01f - (float)PROBE_TS_OFF) * 0.1f; }
#endif
#undef IN
#undef IN0
#undef BOTH
}

extern "C" void kernel_launch(void* const* d_in, const int* in_sizes, int n_in, void* d_out, int out_size, void* d_ws, size_t ws_size, hipStream_t stream) {
    static int grid = 0;
    if (grid == 0) {
        if (n_in != 34 || in_sizes[0] != MPR * D || (size_t)out_size != O_END || ws_size < WS_END) { fprintf(stderr, "kernel_launch: unexpected shapes (n_in %d, in0 %d, out %d, ws %zu); nothing launched\n", n_in, n_in > 0 ? in_sizes[0] : -1, out_size, ws_size); grid = -1; return; }
        int dev = 0, cus = 0, per_cu = 0;
        if (hipGetDevice(&dev) != hipSuccess || hipDeviceGetAttribute(&cus, hipDeviceAttributeMultiprocessorCount, dev) != hipSuccess) { grid = -1; return; }
        if (hipFuncSetAttribute((const void*)mk_fwd, hipFuncAttributeMaxDynamicSharedMemorySize, LDS_BYTES) != hipSuccess) { fprintf(stderr, "kernel_launch: hipFuncSetAttribute failed\n"); grid = -1; return; }
        if (hipOccupancyMaxActiveBlocksPerMultiprocessor(&per_cu, (const void*)mk_fwd, NWAVES * 64, LDS_BYTES) != hipSuccess || per_cu < 1) { fprintf(stderr, "kernel_launch: occupancy query says %d blocks per CU\n", per_cu); (void)hipGetLastError(); grid = -1; return; }
        grid = cus;
        if (grid != 256) fprintf(stderr, "kernel_launch: note: %d CUs\n", grid);
    }
    if (grid < 0) return;
    if (hipMemsetAsync((char*)d_ws + WS_CTL, 0, CTL_ZERO_BYTES, stream) != hipSuccess) return;
    Args a{};
    for (int i = 0; i < 34; ++i) a.in[i] = (const float*)d_in[i];
    a.out = (float*)d_out; a.ws = (unsigned char*)d_ws;
    for (int li = 0; li < N_LAUNCHES; ++li) {
        a.ph_lo = (N_LAUNCHES == 1) ? 0 : li; a.ph_hi = (N_LAUNCHES == 1) ? N_PHASES : li + 1; a.li = li;
        hipLaunchKernelGGL(mk_fwd, dim3(grid), dim3(NWAVES * 64), LDS_BYTES, stream, a);
    }
}
```

```cpp
#include <hip/hip_runtime.h>
#include <cstdio>
#include <cstdint>
namespace pg8 {
#define PG8_LAS __attribute__((address_space(3)))
typedef unsigned short bf16_t;
typedef short bf16x8 __attribute__((ext_vector_type(8)));
typedef float f32x4 __attribute__((ext_vector_type(4)));
typedef unsigned u32x4 __attribute__((ext_vector_type(4)));
constexpr int BM = 256, BK = 64, HALF = 128, HTB = HALF * BK * 2  , STAGE_BYTES = 8 * HTB, NXCD = 8, WGM = 8;

__host__ __device__ __forceinline__ int lds_byte(int r, int c) { const int st = (r >> 4) * 2 + (c >> 5), rr = r & 15, cc = c & 31, ob = rr * 64 + cc * 2; return st * 1024 + (ob ^ (((ob >> 9) & 1) << 5)); }
__host__ __device__ __forceinline__ void stage_rc(int b, int& R, int& C) { const int st = b / 1024, sb = b % 1024, swz = sb ^ (((sb >> 9) & 1) << 5); R = (st >> 1) * 16 + swz / 64; C = (st & 1) * 32 + (swz % 64) / 2; }
__host__ __device__ __forceinline__ int perm32(int rho) { const int n = rho >> 4, i = rho & 15; return 8 * (i >> 2) + 4 * n + (i & 3); }

struct Unit { int pm, pn; };
struct Gemm { const bf16_t* A; const bf16_t* Bt; int M, N, K; };

struct StaticOrder {
    int nM, nN, nwg, G, c;
    __host__ __device__ void init(int M, int N, int G_, int c_) { nM = M / BM; nN = N / BM; nwg = nM * nN; G = G_; c = c_; }
    __host__ __device__ bool next(int i, Unit& u) const {
        const long L = (long)i * G + c; if (L >= nwg) return false;
        int wgid = (int)L; { const int q = nwg / NXCD, r = nwg % NXCD, xcd = wgid % NXCD, off = wgid / NXCD; wgid = (xcd < r ? xcd * (q + 1) : r * (q + 1) + (xcd - r) * q) + off; }
        const int nig = WGM * nN, gid = wgid / nig, fm = gid * WGM, gsz = (nM - fm) < WGM ? (nM - fm) : WGM;
        u.pm = fm + ((wgid % nig) % gsz); u.pn = (wgid % nig) / gsz; return true;
    }
    __device__ __forceinline__ void a_ready(const Unit&) const {}
    __device__ __forceinline__ void done(const Unit&) const {}
};


#define PG8_GAS __attribute__((address_space(1)))
constexpr int MP = 16640;
constexpr int MV = 16512;
constexpr int MPR = 16384;
constexpr int PM_LAST = 64;
constexpr int DM = 1024, FFN = 2816, NINC = 8448, SHC = 3328;
constexpr size_t O_SHP = 17432576, O_SHS = 25864192;

struct ChunkOrder {
    int nM, nN, nwg, G, c, chunk;
    __host__ __device__ void init(int nM_, int nN_, int G_, int c_, int chunk_) { nM = nM_; nN = nN_; nwg = nM * nN; G = G_; c = c_; chunk = chunk_; }
    __host__ __device__ bool next(int i, Unit& u) const {
        const long L = (long)i * G + c; if (L >= nwg) return false;
        int wgid = (int)L; { const int q = nwg / NXCD, r = nwg % NXCD, xcd = wgid % NXCD, off = wgid / NXCD; wgid = (xcd < r ? xcd * (q + 1) : r * (q + 1) + (xcd - r) * q) + off; }
        const int nig = WGM * nN, gid = wgid / nig, fm = gid * WGM, gsz = (nM - fm) < WGM ? (nM - fm) : WGM;
        const int lm = fm + ((wgid % nig) % gsz); u.pn = (wgid % nig) / gsz;
        u.pm = 8 * (lm >> 1) + 2 * chunk + (lm & 1); return true;
    }
    __device__ __forceinline__ void a_ready(const Unit&) const {}
    __device__ __forceinline__ void done(const Unit&) const {}
};

struct TailOrder {
    int c;
    __host__ __device__ void init(int c_) { c = c_; }
    __host__ __device__ bool next(int i, Unit& u) const {
        if (i > 0 || c < 16 || c >= 64) return false;
        const int L = c - 16, ch = 1 + (L >> 4), lm = L & 15; u.pn = 32; u.pm = 8 * (lm >> 1) + 2 * ch + (lm & 1); return true;
    }
    __device__ __forceinline__ void a_ready(const Unit&) const {}
    __device__ __forceinline__ void done(const Unit&) const {}
};

struct SampleOrder {
    int c;
    __host__ __device__ void init(int c_) { c = c_; }
    __host__ __device__ bool next(int i, Unit& u) const { if (i > 0 || c < 64 || c >= 64 + 33) return false; u.pm = PM_LAST; u.pn = c - 64; return true; }
    __device__ __forceinline__ void a_ready(const Unit&) const {}
    __device__ __forceinline__ void done(const Unit&) const {}
};

typedef __bf16 bf16x2_t __attribute__((ext_vector_type(2)));
__device__ __forceinline__ unsigned cvt_pk_bf16(float lo, float hi) { bf16x2_t v; v[0] = (__bf16)lo; v[1] = (__bf16)hi; return __builtin_bit_cast(unsigned, v); }
typedef unsigned u32x2 __attribute__((ext_vector_type(2)));
__device__ __forceinline__ float fsigmoid(float x) { return __builtin_amdgcn_rcpf(1.0f + __expf(-x)); }

constexpr int SCL_MAP_OFF = 131072, SCL_TAB_OFF = 131584, SCL_MAX_UNITS = 12;
template <class Sched> __device__ __forceinline__ void precompute_scales(PG8_LAS unsigned char* lds, const Sched& S, const PG8_GAS float* ssq, const PG8_GAS bf16_t* xb) {
    int t = threadIdx.x; asm volatile("" : "+v"(t));
    const int row = t >> 1, half = t & 1;
    Unit u;
    for (int i = 0; i < SCL_MAX_UNITS && S.next(i, u); ++i) {
        if (u.pm == PM_LAST) {
            const int r4 = t >> 2, q4 = t & 3; const PG8_GAS u32x4* xr = (const PG8_GAS u32x4*)(xb + (size_t)(PM_LAST * BM + r4) * DM + q4 * 256);
            float p = 0.f;
#pragma unroll 4
            for (int j = 0; j < 32; ++j) { const u32x4 w = xr[j]; const unsigned ws_[4] = {w.x, w.y, w.z, w.w};
#pragma unroll
                for (int e2 = 0; e2 < 4; ++e2) { const float a = __uint_as_float(ws_[e2] << 16), b = __uint_as_float(ws_[e2] & 0xffff0000u); p += a * a + b * b; } }
            p += __shfl_xor(p, 1); p += __shfl_xor(p, 2);
            if (q4 == 0) *(PG8_LAS float*)(lds + SCL_TAB_OFF + (i * 256 + r4) * 4) = __builtin_amdgcn_rsqf(p * (1.0f / 1024.0f) + 1e-6f);
            if (t == 0) *(PG8_LAS int*)(lds + SCL_MAP_OFF + u.pm * 4) = i;
            continue;
        }
        const PG8_GAS float* q = ssq + (size_t)(8 * half) * MP + (u.pm * BM + row);
        float p = ((q[0] + q[MP]) + (q[2 * MP] + q[3 * MP])) + ((q[4 * (size_t)MP] + q[5 * (size_t)MP]) + (q[6 * (size_t)MP] + q[7 * (size_t)MP]));
        p += __shfl_xor(p, 1);
        if (half == 0) *(PG8_LAS float*)(lds + SCL_TAB_OFF + (i * 256 + row) * 4) = __builtin_amdgcn_rsqf(p * (1.0f / 1024.0f) + 1e-6f);
        if (t == 0) *(PG8_LAS int*)(lds + SCL_MAP_OFF + u.pm * 4) = i;
    }
    asm volatile("s_waitcnt lgkmcnt(0)" ::: "memory"); __builtin_amdgcn_s_barrier(); asm volatile("" ::: "memory");
}
__device__ __forceinline__ void row_scales(const PG8_LAS unsigned char* lds, int pm, int wr, int fr, float (&sc)[2][4]) {
    const int slot = *(const PG8_LAS int*)(lds + SCL_MAP_OFF + pm * 4);
    const PG8_LAS float* tb = (const PG8_LAS float*)(lds + SCL_TAB_OFF) + slot * 256 + wr * 64 + fr;
#pragma unroll
    for (int ai = 0; ai < 2; ++ai)
#pragma unroll
        for (int m = 0; m < 4; ++m) sc[ai][m] = tb[ai * HALF + m * 16];
}

struct EpiSwiglu {
    static constexpr bool PERM = true, AFTER_DRAIN = false;
    PG8_GAS bf16_t* O; const PG8_LAS unsigned char* sl; bool scaled;
    __device__ __forceinline__ void operator()(const f32x4 (&acc)[2][2][4][2], const Unit& u, int wr, int wc, int fr, int fq) const {
        float sc[2][4];
        if (scaled) row_scales(sl, u.pm, wr, fr, sc);
        else {
#pragma unroll
            for (int ai = 0; ai < 2; ++ai)
#pragma unroll
                for (int m = 0; m < 4; ++m) sc[ai][m] = 1.0f; }
        const int col0 = u.pn * HALF + wc * 32 + 8 * fq;
#pragma unroll
        for (int ai = 0; ai < 2; ++ai) {
            if (u.pm == PM_LAST && ai == 1) break;
#pragma unroll
            for (int m = 0; m < 4; ++m) {
                const int row = u.pm * BM + ai * HALF + wr * 64 + m * 16 + fr; const float s = sc[ai][m];
                const f32x4 g0 = acc[ai][0][m][0] * s, g1 = acc[ai][0][m][1] * s, u0 = acc[ai][1][m][0] * s, u1 = acc[ai][1][m][1] * s;
                f32x4 v0, v1;
#pragma unroll
                for (int j = 0; j < 4; ++j) { v0[j] = g0[j] * fsigmoid(g0[j]) * u0[j]; v1[j] = g1[j] * fsigmoid(g1[j]) * u1[j]; }
                u32x4 w; w.x = cvt_pk_bf16(v0[0], v0[1]); w.y = cvt_pk_bf16(v0[2], v0[3]); w.z = cvt_pk_bf16(v1[0], v1[1]); w.w = cvt_pk_bf16(v1[2], v1[3]);
                *(PG8_GAS u32x4*)(O + (size_t)row * FFN + col0) = w; }
        }
    }
};

struct EpiRes {
    static constexpr bool PERM = true, AFTER_DRAIN = false;
    const PG8_GAS float* inF; PG8_GAS bf16_t* XB; PG8_GAS float* ssq; float alpha;
    __device__ __forceinline__ void operator()(const f32x4 (&acc)[2][2][4][2], const Unit& u, int wr, int wc, int fr, int fq) const {
        const int col0 = u.pn * BM + wc * 32 + 8 * fq;
#pragma unroll
        for (int ai = 0; ai < 2; ++ai) {
#pragma unroll
            for (int m = 0; m < 4; ++m) {
                const int row = u.pm * BM + ai * HALF + wr * 64 + m * 16 + fr; const size_t off = (size_t)row * DM + col0;
                f32x4 xin[2][2];
                if (inF) {
#pragma unroll
                    for (int bj = 0; bj < 2; ++bj) { xin[bj][0] = *(const PG8_GAS f32x4*)(inF + off + bj * HALF); xin[bj][1] = *(const PG8_GAS f32x4*)(inF + off + bj * HALF + 4); }
                } else {
#pragma unroll
                    for (int bj = 0; bj < 2; ++bj) { const u32x4 p = *(const PG8_GAS u32x4*)(XB + off + bj * HALF);
                        xin[bj][0][0] = __uint_as_float(p.x << 16); xin[bj][0][1] = __uint_as_float(p.x & 0xffff0000u); xin[bj][0][2] = __uint_as_float(p.y << 16); xin[bj][0][3] = __uint_as_float(p.y & 0xffff0000u);
                        xin[bj][1][0] = __uint_as_float(p.z << 16); xin[bj][1][1] = __uint_as_float(p.z & 0xffff0000u); xin[bj][1][2] = __uint_as_float(p.w << 16); xin[bj][1][3] = __uint_as_float(p.w & 0xffff0000u); }
                }
                float q = 0.f;
#pragma unroll
                for (int bj = 0; bj < 2; ++bj) { const f32x4 x0 = xin[bj][0] + acc[ai][bj][m][0] * alpha, x1 = xin[bj][1] + acc[ai][bj][m][1] * alpha;
                    u32x4 w; w.x = cvt_pk_bf16(x0[0], x0[1]); w.y = cvt_pk_bf16(x0[2], x0[3]); w.z = cvt_pk_bf16(x1[0], x1[1]); w.w = cvt_pk_bf16(x1[2], x1[3]);
                    *(PG8_GAS u32x4*)(XB + off + bj * HALF) = w;
                    q += ((x0[0] * x0[0] + x0[1] * x0[1]) + (x0[2] * x0[2] + x0[3] * x0[3])) + ((x1[0] * x1[0] + x1[1] * x1[1]) + (x1[2] * x1[2] + x1[3] * x1[3])); }
                q += __shfl_xor(q, 16); q += __shfl_xor(q, 32);
                if (fq == 0) ssq[(size_t)(4 * u.pn + wc) * MP + row] = q;
                if (m & 1) asm volatile("" ::: "memory"); }
        }
    }
};

struct EpiZ {
    static constexpr bool PERM = true, AFTER_DRAIN = false;
    PG8_GAS bf16_t* Z; const PG8_LAS unsigned char* sl; PG8_GAS bf16_t* ZX; PG8_GAS bf16_t* ZS;
    __device__ __forceinline__ void operator()(const f32x4 (&acc)[2][2][4][2], const Unit& u, int wr, int wc, int fr, int fq) const {
        float sc[2][4]; row_scales(sl, u.pm, wr, fr, sc);
        const int lm = 2 * (u.pm >> 3) + (u.pm & 1);
        const int col0 = u.pn * BM + wc * 32 + 8 * fq;
#pragma unroll
        for (int ai = 0; ai < 2; ++ai) {
            if (u.pm == PM_LAST && ai == 1) break;
#pragma unroll
            for (int m = 0; m < 4; ++m) {
                const int rt = ai * HALF + wr * 64 + m * 16 + fr, lrow = lm * BM + rt; const float s = sc[ai][m];
                PG8_GAS bf16_t* zp = (u.pm == PM_LAST) ? ZS + (size_t)rt * NINC + col0 : ((u.pn == 32) ? ZX + ((size_t)(((u.pm & 7) >> 1) * 16 * BM + lrow) * 256 + wc * 32 + 8 * fq) : Z + (size_t)lrow * NINC + col0);
#pragma unroll
                for (int bj = 0; bj < 2; ++bj) { const f32x4 v0 = acc[ai][bj][m][0] * s, v1 = acc[ai][bj][m][1] * s;
                    u32x4 w; w.x = cvt_pk_bf16(v0[0], v0[1]); w.y = cvt_pk_bf16(v0[2], v0[3]); w.z = cvt_pk_bf16(v1[0], v1[1]); w.w = cvt_pk_bf16(v1[2], v1[3]);
                    *(PG8_GAS u32x4*)(zp + bj * HALF) = w; }
            }
        }
    }
};

struct EpiPP {
    static constexpr bool PERM = true, AFTER_DRAIN = false;
    PG8_GAS bf16_t* O; int ldc;
    __device__ __forceinline__ void operator()(const f32x4 (&acc)[2][2][4][2], const Unit& u, int wr, int wc, int fr, int fq) const {
        const int col0 = u.pn * BM + wc * 32 + 8 * fq;
#pragma unroll
        for (int ai = 0; ai < 2; ++ai)
#pragma unroll
            for (int m = 0; m < 4; ++m) { PG8_GAS bf16_t* rowp = O + (size_t)(u.pm * BM + ai * HALF + wr * 64 + m * 16 + fr) * ldc + col0;
#pragma unroll
                for (int bj = 0; bj < 2; ++bj) { const f32x4 v0 = acc[ai][bj][m][0], v1 = acc[ai][bj][m][1];
                    u32x4 w; w.x = cvt_pk_bf16(v0[0], v0[1]); w.y = cvt_pk_bf16(v0[2], v0[3]); w.z = cvt_pk_bf16(v1[0], v1[1]); w.w = cvt_pk_bf16(v1[2], v1[3]);
                    *(PG8_GAS u32x4*)(rowp + bj * HALF) = w; } }
    }
};

struct EpiPle {
    static constexpr bool PERM = true, AFTER_DRAIN = false;
    const PG8_GAS bf16_t* XB; PG8_GAS bf16_t* XF; const PG8_GAS bf16_t* PP; const PG8_LAS unsigned char* sl;
    __device__ __forceinline__ void operator()(const f32x4 (&acc)[2][2][4][2], const Unit& u, int wr, int wc, int fr, int fq) const {
        float sc[2][4]; row_scales(sl, u.pm, wr, fr, sc);
        const int col0 = u.pn * BM + wc * 32 + 8 * fq;
#pragma unroll
        for (int ai = 0; ai < 2; ++ai) {
#pragma unroll
            for (int m = 0; m < 4; ++m) {
                const int row = u.pm * BM + ai * HALF + wr * 64 + m * 16 + fr; const size_t off = (size_t)row * DM + col0; const float s = sc[ai][m];
                u32x4 xr[2], pr[2];
#pragma unroll
                for (int bj = 0; bj < 2; ++bj) { xr[bj] = *(const PG8_GAS u32x4*)(XB + off + bj * HALF); pr[bj] = *(const PG8_GAS u32x4*)(PP + off + bj * HALF); }
#pragma unroll
                for (int bj = 0; bj < 2; ++bj) {
                    const unsigned xs[4] = {xr[bj].x, xr[bj].y, xr[bj].z, xr[bj].w}, ps[4] = {pr[bj].x, pr[bj].y, pr[bj].z, pr[bj].w};
                    unsigned o[4];
#pragma unroll
                    for (int j = 0; j < 4; ++j) { const float a0 = acc[ai][bj][m][j >> 1][2 * (j & 1)] * s, a1 = acc[ai][bj][m][j >> 1][2 * (j & 1) + 1] * s;
                        const float y0 = __uint_as_float(xs[j] << 16) + fsigmoid(a0) * __uint_as_float(ps[j] << 16), y1 = __uint_as_float(xs[j] & 0xffff0000u) + fsigmoid(a1) * __uint_as_float(ps[j] & 0xffff0000u);
                        o[j] = cvt_pk_bf16(y0, y1); }
                    u32x4 w; w.x = o[0]; w.y = o[1]; w.z = o[2]; w.w = o[3];
                    *(PG8_GAS u32x4*)(XF + off + bj * HALF) = w; }
                if (m & 1) asm volatile("" ::: "memory"); }
        }
    }
};

template <class Epi, class Sched, bool ALIGN_EPI = false, bool SP2 = false>
__device__ __forceinline__ void gemm_phase(PG8_LAS unsigned char* lds, const Gemm g, const Sched& S, const Epi& E) {
    int tid_ = threadIdx.x; asm volatile("" : "+v"(tid_));
    const int tid = tid_, wid = __builtin_amdgcn_readfirstlane(tid >> 6), lane = tid & 63, wr = wid >> 2, wc = wid & 3, fr = lane & 15, fq = lane >> 4;
    const int K = g.K, nt = K / BK;
    unsigned voffA[2], voffB[2];
#pragma unroll
    for (int i = 0; i < 2; ++i) { int R, C; stage_rc(tid * 16 + i * 8192, R, C); const int Rb = Epi::PERM ? ((R & ~31) + perm32(R & 31)) : R;
        voffA[i] = (unsigned)(R * K + C) * 2u; voffB[i] = (unsigned)(Rb * K + C) * 2u; }
    const size_t kstep = (size_t)(BK * 2);
    const size_t hstep = (size_t)HALF * K * 2;
    const size_t tstep = 2 * hstep;
    const unsigned ldsw = (unsigned)wid * 1024u;
    const int aoff = lds_byte(wr * 64 + fr, fq * 8), boff = lds_byte(wc * 32 + fr, fq * 8);
#define PG8_SA(b, h) (((b) * 2 + (h)) * HTB)
#define PG8_SB(b, h) ((4 + (b) * 2 + (h)) * HTB)
#define PG8_STAGE(bufoff, gbase, voff) do { _Pragma("unroll") for (int _i = 0; _i < 2; ++_i) \
        __builtin_amdgcn_global_load_lds((const unsigned*)((const char*)(gbase) + (voff)[_i]), (PG8_LAS unsigned*)(lds + (bufoff) + ldsw + _i * 8192), 16, 0, 0); } while (0)
#define PG8_LDA(dst, b, h) do { _Pragma("unroll") for (int m = 0; m < 4; ++m) _Pragma("unroll") for (int k = 0; k < 2; ++k) dst[m][k] = *(const PG8_LAS bf16x8*)(lds + PG8_SA(b, h) + aoff + m * 2048 + k * 1024); } while (0)
#define PG8_LDB(dst, b, h) do { _Pragma("unroll") for (int n = 0; n < 2; ++n) _Pragma("unroll") for (int k = 0; k < 2; ++k) dst[n][k] = *(const PG8_LAS bf16x8*)(lds + PG8_SB(b, h) + boff + n * 2048 + k * 1024); } while (0)
#define PG8_MMA(ai, bj, At, Bt) do { __builtin_amdgcn_s_setprio(1); _Pragma("unroll") for (int m = 0; m < 4; ++m) _Pragma("unroll") for (int n = 0; n < 2; ++n) _Pragma("unroll") for (int k = 0; k < 2; ++k) \
        acc[ai][bj][m][n] = __builtin_amdgcn_mfma_f32_16x16x32_bf16(Bt[n][k], At[m][k], acc[ai][bj][m][n], 0, 0, 0); __builtin_amdgcn_s_setprio(0); } while (0)
#define PG8_WAIT_V(n) asm volatile("s_waitcnt vmcnt(" #n ")" ::: "memory")
#define PG8_WAIT_L(n) asm volatile("s_waitcnt lgkmcnt(" #n ")" ::: "memory")
#define PG8_BAR __builtin_amdgcn_s_barrier()
#define PG8_SCHED __builtin_amdgcn_sched_barrier(0)
    Unit cur, nxt; int ui = 0;
    if (!S.next(0, cur)) return;
    f32x4 acc[2][2][4][2];
#pragma unroll
    for (int a = 0; a < 2; ++a)
#pragma unroll
        for (int b = 0; b < 2; ++b)
#pragma unroll
            for (int m = 0; m < 4; ++m)
#pragma unroll
                for (int n = 0; n < 2; ++n) acc[a][b][m][n] = (f32x4){0.f, 0.f, 0.f, 0.f};
    bf16x8 At[4][2], B0[2][2], B1[2][2];
    const char* cA = (const char*)g.A + (size_t)cur.pm * tstep; const char* cB = (const char*)g.Bt + (size_t)cur.pn * tstep;
    S.a_ready(cur);
    if constexpr (SP2) {
        PG8_STAGE(PG8_SB(0, 0), cB, voffB); PG8_STAGE(PG8_SB(0, 1), cB + hstep, voffB); PG8_STAGE(PG8_SA(0, 0), cA, voffA); PG8_STAGE(PG8_SA(0, 1), cA + hstep, voffA);
        if (wr == 1) PG8_BAR;
        PG8_WAIT_V(2); PG8_BAR;
        PG8_STAGE(PG8_SB(1, 0), cB + kstep, voffB); PG8_STAGE(PG8_SA(1, 0), cA + kstep, voffA); PG8_STAGE(PG8_SB(1, 1), cB + hstep + kstep, voffB);
        PG8_WAIT_V(6); PG8_BAR;
    } else {
        PG8_STAGE(PG8_SB(0, 0), cB, voffB); PG8_STAGE(PG8_SA(0, 0), cA, voffA); PG8_STAGE(PG8_SB(0, 1), cB + hstep, voffB); PG8_STAGE(PG8_SA(0, 1), cA + hstep, voffA);
        if (wr == 1) PG8_BAR;
        PG8_WAIT_V(4); PG8_BAR;
        PG8_STAGE(PG8_SB(1, 0), cB + kstep, voffB); PG8_STAGE(PG8_SA(1, 0), cA + kstep, voffA); PG8_STAGE(PG8_SB(1, 1), cB + hstep + kstep, voffB);
        PG8_WAIT_V(6); PG8_BAR;
    }
    for (;;) {
        const bool has_next = S.next(ui + 1, nxt);
        const bool full_a = (cur.pm != PM_LAST);
        const char* nA = has_next ? (const char*)g.A + (size_t)nxt.pm * tstep : cA; const char* nB = has_next ? (const char*)g.Bt + (size_t)nxt.pn * tstep : cB;
#pragma unroll 1
        for (int t = 0; t < nt; t += 2) {
            const bool last = (t == nt - 2);
            const char* a1 = cA + (size_t)(t + 1) * kstep;
            const char* a2 = last ? nA : cA + (size_t)(t + 2) * kstep; const char* b2 = last ? nB : cB + (size_t)(t + 2) * kstep;
            const char* a3 = a2 + kstep; const char* b3 = b2 + kstep;
            if (last && has_next) S.a_ready(nxt);
            if constexpr (SP2) {
            PG8_LDB(B0, 0, 0); PG8_LDB(B1, 0, 1); PG8_SCHED; PG8_LDA(At, 0, 0); PG8_STAGE(PG8_SA(1, 1), a1 + hstep, voffA);
            PG8_WAIT_V(8); PG8_WAIT_L(0); PG8_BAR; PG8_MMA(0, 0, At, B0); PG8_MMA(0, 1, At, B1); PG8_BAR; PG8_SCHED;
            PG8_LDA(At, 0, 1); PG8_STAGE(PG8_SB(0, 0), b2, voffB); PG8_STAGE(PG8_SB(0, 1), b2 + hstep, voffB); PG8_STAGE(PG8_SA(0, 0), a2, voffA);
            PG8_WAIT_V(8); PG8_WAIT_L(0); PG8_BAR; if (full_a) { PG8_MMA(1, 0, At, B0); PG8_MMA(1, 1, At, B1); } PG8_BAR; PG8_SCHED;
            PG8_LDB(B0, 1, 0); PG8_LDB(B1, 1, 1); PG8_SCHED; PG8_LDA(At, 1, 0); PG8_STAGE(PG8_SA(0, 1), a2 + hstep, voffA);
            PG8_WAIT_V(8); PG8_WAIT_L(0); PG8_BAR; PG8_MMA(0, 0, At, B0); PG8_MMA(0, 1, At, B1); PG8_BAR; PG8_SCHED;
            PG8_LDA(At, 1, 1); PG8_STAGE(PG8_SB(1, 0), b3, voffB); PG8_STAGE(PG8_SB(1, 1), b3 + hstep, voffB); PG8_STAGE(PG8_SA(1, 0), a3, voffA);
            PG8_WAIT_V(8); PG8_WAIT_L(0); PG8_BAR; if (full_a) { PG8_MMA(1, 0, At, B0); PG8_MMA(1, 1, At, B1); } PG8_BAR; PG8_SCHED;
            } else {
            PG8_LDB(B0, 0, 0); PG8_SCHED; PG8_LDA(At, 0, 0); PG8_STAGE(PG8_SA(1, 1), a1 + hstep, voffA);
            PG8_WAIT_L(8); PG8_BAR; PG8_WAIT_L(0); PG8_MMA(0, 0, At, B0); PG8_BAR; PG8_SCHED;
            PG8_LDB(B1, 0, 1); PG8_STAGE(PG8_SB(0, 0), b2, voffB);
            PG8_BAR; PG8_WAIT_L(0); PG8_MMA(0, 1, At, B1); PG8_BAR;
            PG8_LDA(At, 0, 1); PG8_STAGE(PG8_SA(0, 0), a2, voffA);
            PG8_BAR; PG8_WAIT_L(0); PG8_MMA(1, 0, At, B0); PG8_BAR; PG8_SCHED;
            PG8_STAGE(PG8_SB(0, 1), b2 + hstep, voffB);
            PG8_WAIT_V(6); PG8_BAR; PG8_MMA(1, 1, At, B1); PG8_BAR;
            PG8_LDB(B0, 1, 0); PG8_SCHED; PG8_LDA(At, 1, 0); PG8_STAGE(PG8_SA(0, 1), a2 + hstep, voffA);
            PG8_WAIT_L(8); PG8_BAR; PG8_WAIT_L(0); PG8_MMA(0, 0, At, B0); PG8_BAR; PG8_SCHED;
            PG8_LDB(B1, 1, 1); PG8_STAGE(PG8_SB(1, 0), b3, voffB);
            PG8_BAR; PG8_WAIT_L(0); PG8_MMA(0, 1, At, B1); PG8_BAR;
            PG8_LDA(At, 1, 1); PG8_STAGE(PG8_SA(1, 0), a3, voffA);
            PG8_BAR; PG8_WAIT_L(0); PG8_MMA(1, 0, At, B0); PG8_BAR; PG8_SCHED;
            PG8_STAGE(PG8_SB(1, 1), b3 + hstep, voffB);
            PG8_WAIT_V(6); PG8_BAR; PG8_MMA(1, 1, At, B1); PG8_BAR;
            }
        }
        if constexpr (ALIGN_EPI) { if (wr == 0) PG8_BAR; }
        if constexpr (!Epi::AFTER_DRAIN) { E(acc, cur, wr, wc, fr, fq); S.done(cur); }
        if (!has_next) break;
#pragma unroll
        for (int a = 0; a < 2; ++a)
#pragma unroll
            for (int b = 0; b < 2; ++b)
#pragma unroll
                for (int m = 0; m < 4; ++m)
#pragma unroll
                    for (int n = 0; n < 2; ++n) acc[a][b][m][n] = (f32x4){0.f, 0.f, 0.f, 0.f};
        cur = nxt; cA = nA; cB = nB; ++ui;
        if constexpr (ALIGN_EPI) { if (wr == 1) PG8_BAR; }
    }
    PG8_WAIT_V(0);
    if constexpr (!ALIGN_EPI) { if (wr == 0) PG8_BAR; }
    PG8_BAR;
    if constexpr (Epi::AFTER_DRAIN) { E.fused(acc, cur, wr, wc, fr, fq, lds, wid, lane); S.done(cur); }
#undef PG8_SA
#undef PG8_SB
#undef PG8_STAGE
#undef PG8_LDA
#undef PG8_LDB
#undef PG8_MMA
#undef PG8_WAIT_V
#undef PG8_WAIT_L
#undef PG8_BAR
#undef PG8_SCHED
}
}
#define GAS __attribute__((address_space(1)))
#define LAS __attribute__((address_space(3)))
typedef unsigned short bf16;
typedef unsigned v4u __attribute__((ext_vector_type(4)));
typedef float f32x4 __attribute__((ext_vector_type(4)));
typedef short bf16x8 __attribute__((ext_vector_type(8)));
typedef GAS unsigned gu32;
typedef GAS unsigned long long gu64;
#define RLX_AGENT __ATOMIC_RELAXED, __HIP_MEMORY_SCOPE_AGENT
#define LDS_WAIT() asm volatile("s_waitcnt lgkmcnt(0)" ::: "memory")
#define VM_WAIT() asm volatile("s_waitcnt vmcnt(0)" ::: "memory")
__device__ __forceinline__ unsigned long long rt() { return __builtin_amdgcn_s_memrealtime(); }
__device__ __forceinline__ unsigned f2bf(float f) { unsigned u = __builtin_bit_cast(unsigned, f); return (u + 0x7fffu + ((u >> 16) & 1u)) >> 16; }
__device__ __forceinline__ unsigned pk2(float lo, float hi) { return f2bf(lo) | (f2bf(hi) << 16); }

#define XB_TMO      128
#define XB_XCNT(j)  (256  + 64 * (j))
#define XB_XSUB(j)  (1280 + 64 * (j))
#define XB_XGEN(j)  (2304 + 64 * (j))
#define XB_TOP      3328
#define XB_TOPGEN   3392
#define XCD_BAR_WORDS 3456
#define XB_SPIN_CAP (1u << 18)

__device__ __forceinline__ unsigned xb_ld(unsigned* p)              { return __hip_atomic_load(p, __ATOMIC_RELAXED, __HIP_MEMORY_SCOPE_AGENT); }
__device__ __forceinline__ unsigned xb_add(unsigned* p, unsigned v) { return __hip_atomic_fetch_add(p, v, __ATOMIC_RELAXED, __HIP_MEMORY_SCOPE_AGENT); }
__device__ __forceinline__ unsigned xb_xcc_id() { return (unsigned)__builtin_amdgcn_s_getreg((3 << 11) | 20) & 0xFu; }
#define XB_SPIN(cond, bar) do { unsigned _sp = 0; while (cond) { __builtin_amdgcn_s_sleep(1); \
    if ((++_sp & 255u) == 0u) { if (xb_ld(&(bar)[XB_TMO])) break; if (_sp > XB_SPIN_CAP) { atomicAdd(&(bar)[XB_TMO], 1u); break; } } } } while (0)

struct XcdBarrier {
    unsigned* bar; unsigned x;
    volatile LAS unsigned* st;
};

__device__ __forceinline__ XcdBarrier xcd_barrier_post(unsigned* bar, volatile LAS unsigned* st) {
    XcdBarrier b; b.bar = bar; b.x = xb_xcc_id(); b.st = st;
    if (threadIdx.x == 0) (void)xb_add(&bar[XB_XCNT(b.x)], 1u);
    return b;
}
__device__ __forceinline__ void xcd_barrier_complete(unsigned* bar, unsigned x, unsigned& nloc, unsigned& nx) {
    const unsigned G = gridDim.x * gridDim.y * gridDim.z;
    unsigned sum, cnt, mine, sp = 0u;
    for (;;) {
        sum = 0u; cnt = 0u; mine = 0u;
#pragma unroll
        for (unsigned j = 0; j < 16; ++j) { const unsigned c = xb_ld(&bar[XB_XCNT(j)]); sum += c; cnt += (c > 0u) ? 1u : 0u; mine = (j == x) ? c : mine; }
        if (sum == G) break;
        __builtin_amdgcn_s_sleep(1);
        if ((++sp & 255u) == 0u) { if (xb_ld(&bar[XB_TMO])) break; if (sp > XB_SPIN_CAP) { atomicAdd(&bar[XB_TMO], 1u); break; } }
    }
    nloc = mine > 0u ? mine : 1u; nx = cnt > 0u ? cnt : 1u;
}

__device__ __forceinline__ void xcd_barrier(const XcdBarrier& b) {
    asm volatile("s_waitcnt vmcnt(0)" ::: "memory");
    __syncthreads();
    if (threadIdx.x == 0) {
        unsigned* bar = b.bar;
        __builtin_amdgcn_s_waitcnt(0);
        unsigned nloc = b.st[0], nx = b.st[1];
        if (nloc == 0u) { xcd_barrier_complete(bar, b.x, nloc, nx); b.st[0] = nloc; b.st[1] = nx; }
        const unsigned old = xb_add(&bar[XB_XSUB(b.x)], 1u);
        const unsigned gen = old / nloc;
        if (old + 1u == (gen + 1u) * nloc) {
            __builtin_amdgcn_fence(__ATOMIC_RELEASE, "agent");
            asm volatile("s_waitcnt vmcnt(0)" ::: "memory");
            const unsigned og = xb_add(&bar[XB_TOP], 1u);
            const unsigned tg = og / nx;
            if (og + 1u == (tg + 1u) * nx) xb_add(&bar[XB_TOPGEN], 1u);
            else XB_SPIN(xb_ld(&bar[XB_TOPGEN]) == tg, bar);
            __builtin_amdgcn_fence(__ATOMIC_ACQUIRE, "agent");
            xb_add(&bar[XB_XGEN(b.x)], 1u);
            asm volatile("s_waitcnt vmcnt(0)" ::: "memory");
        } else {
            XB_SPIN(xb_ld(&bar[XB_XGEN(b.x)]) == gen, bar);
            __builtin_amdgcn_fence(__ATOMIC_ACQUIRE, "agent");
            asm volatile("s_waitcnt vmcnt(0)" ::: "memory");
        }
    }
    __syncthreads();
}


constexpr int NWAVES = 8;
#ifndef REP_P5
#define REP_P5 1
#define REP_P6 1
#define REP_P3 1
#define REP_P8A 1
#endif
#ifndef DBG_MIX
#define DBG_MIX 0
#endif
#ifndef MK_N_LAUNCHES
#define MK_N_LAUNCHES 1
#endif
constexpr int N_PHASES = 14;
constexpr int N_LAUNCHES = MK_N_LAUNCHES;

constexpr int D = 1024, FF = 2816, NIN = 8448, SHIFTC = 3328, PLE = 256, TSEQ = 2048, NBATCH = 8, NSAMP = 128, NHEAD = 16;
constexpr int MP = pg8::MP, MV = pg8::MV, MPR = pg8::MPR;
constexpr float RMS_EPS = 1e-6f, GN_EPS = 64e-5f;
constexpr size_t O_YP = 0, O_YS = 16777216, O_WKVP = 16908288, O_SHP = 17432576, O_CVP = 17459200, O_WKVS = 17475584, O_SHS = 25864192, O_CVS = 26290176, O_END = 26552320;
constexpr size_t MiB = 1u << 20;
constexpr size_t WS_CTL = 0, CTL_ZERO_BYTES = 1 * MiB;
constexpr size_t WS_WIN = 1 * MiB;
constexpr size_t WS_WOUT = WS_WIN + (size_t)NIN * D * 2;
constexpr size_t WS_W2GU = WS_WOUT + (size_t)D * D * 2;
constexpr size_t WS_W2D = WS_W2GU + (size_t)2 * FF * D * 2;
constexpr size_t WS_WPG = WS_W2D + (size_t)D * FF * 2;
constexpr size_t WS_WPP = WS_WPG + (size_t)D * D * 2;
constexpr size_t WS_WDU = WS_WPP + (size_t)D * PLE * 2;
constexpr size_t WS_WIU = WS_WDU + (size_t)D * 64 * 2;
constexpr size_t WS_WGU = WS_WIU + (size_t)D * 64 * 2;
constexpr size_t WS_PB = WS_WGU + (size_t)D * 128 * 2;
constexpr size_t WS_XB = WS_PB + (size_t)MP * PLE * 2;
constexpr size_t WS_MIX = WS_XB + (size_t)MP * D * 2;
constexpr size_t WS_SSQ = WS_MIX + (size_t)MP * D * 2;
constexpr size_t WS_CAR = WS_SSQ + (size_t)16 * MP * 4;
constexpr size_t WS_R = (WS_CAR + (size_t)128 * 576 * 4 + 4095) / 4096 * 4096;
constexpr size_t WS_W1GU = WS_R;
constexpr size_t WS_W1D = WS_W1GU + (size_t)2 * FF * D * 2;
constexpr size_t WS_GU = WS_W1D + (size_t)D * FF * 2;
constexpr int NTC = 4, TCH = TSEQ / NTC;
constexpr size_t ZCH_BYTES = (size_t)NBATCH * TCH * NIN * 2;
constexpr size_t WS_Z = WS_R;
constexpr size_t WS_ZS = WS_Z + 2 * ZCH_BYTES;
constexpr size_t WS_ZX = WS_ZS + (size_t)NSAMP * NIN * 2;
constexpr size_t WS_END = 256 * MiB;
static_assert(WS_GU + (size_t)MP * FF * 2 <= WS_END && WS_ZX + (size_t)NTC * NBATCH * TCH * 256 * 2 <= WS_END, "d_ws map");
constexpr int CW_BAR = 4096;
constexpr int RING_OFF = 0, RING_BYTES = 131072;
constexpr int LDSCTL_OFF = 155648, MISC_OFF = LDSCTL_OFF + 320, PTR_OFF = LDSCTL_OFF + 1024;
constexpr int LDS_BYTES = 163840;
static_assert(MISC_OFF + 128 <= LDS_BYTES, "LDS map");

#define WG_SYNC() do { asm volatile("s_waitcnt lgkmcnt(0)" ::: "memory"); __builtin_amdgcn_s_barrier(); asm volatile("" ::: "memory"); } while (0)

typedef unsigned u32x2v __attribute__((ext_vector_type(2)));
typedef float f32x2 __attribute__((ext_vector_type(2)));

struct Frame {
    LAS unsigned char* lds;
    volatile LAS unsigned* MISC;
    gu32* ctl;
    int tid, lane, wave, vcu, G;
    GAS float* out; GAS unsigned char* ws;
    __device__ __forceinline__ const GAS float* inp(int k) const { const u32x2v p = *(const LAS u32x2v*)(lds + PTR_OFF + 8 * k); const unsigned long long a = ((unsigned long long)(unsigned)__builtin_amdgcn_readfirstlane((int)p.y) << 32) | (unsigned)__builtin_amdgcn_readfirstlane((int)p.x); return (const GAS float*)a; }
};

__device__ __forceinline__ float wave_sum(float v) {
#pragma unroll
    for (int o = 1; o < 64; o <<= 1) v += __shfl_xor(v, o);
    return v;
}
__device__ __forceinline__ f32x4 unpk4(u32x2v p) { f32x4 r; r[0] = __uint_as_float(p.x << 16); r[1] = __uint_as_float(p.x & 0xffff0000u); r[2] = __uint_as_float(p.y << 16); r[3] = __uint_as_float(p.y & 0xffff0000u); return r; }
__device__ __forceinline__ float bf_lo(unsigned p) { return __uint_as_float(p << 16); }
__device__ __forceinline__ float bf_hi(unsigned p) { return __uint_as_float(p & 0xffff0000u); }
__device__ __forceinline__ float fsig(float x) { return __builtin_amdgcn_rcpf(1.0f + __expf(-x)); }
__device__ __forceinline__ float ftanh(float x) { return 1.0f - 2.0f * __builtin_amdgcn_rcpf(__expf(2.0f * x) + 1.0f); }
template <int CTRL> __device__ __forceinline__ float dppf(float x) { return __builtin_bit_cast(float, __builtin_amdgcn_update_dpp(0, __builtin_bit_cast(int, x), CTRL, 0xF, 0xF, true)); }
__device__ __forceinline__ float red16(float x) {
    x += dppf<0xB1>(x); x += dppf<0x4E>(x); x += dppf<0x141>(x); x += dppf<0x140>(x); return x; }
__device__ __forceinline__ float decay_of(float x) {
    const float w = fminf(x, 0.f) - __logf(1.0f + __expf(-fabsf(x))) - 0.5f;
    return __expf(-__expf(w));
}

constexpr int P0_SCR = 17408;
__device__ __forceinline__ void p0_item(const GAS float* W, int K, int N, GAS bf16* WT, int mode, const GAS float* gain, LAS float* scr, int item, int lane) {
    const int nblk = N / 64, kb = item / nblk, nb = item % nblk, k0 = 64 * kb, n0 = 64 * nb;
    f32x4 w[16];
#pragma unroll
    for (int i = 0; i < 16; ++i) { const int kk = 4 * i + (lane >> 4); w[i] = *(const GAS f32x4*)(W + (size_t)(k0 + kk) * N + n0 + 4 * (lane & 15)); }
    if (gain) {
#pragma unroll
        for (int i = 0; i < 16; ++i) w[i] = w[i] * gain[k0 + 4 * i + (lane >> 4)]; }
#pragma unroll
    for (int i = 0; i < 16; ++i) { const int kk = 4 * i + (lane >> 4); *(LAS f32x4*)(scr + kk * 68 + ((4 * (lane & 15)) ^ (4 * (kk >> 3)))) = w[i]; }
    LDS_WAIT(); asm volatile("" ::: "memory");
    const int c = lane & 7;
    const int r0 = (mode == 0) ? n0 : ((n0 >> 7) * 256 + (n0 & 127) + (mode == 2 ? 128 : 0));
#pragma unroll
    for (int j = 0; j < 8; ++j) { const int n = (lane >> 3) + 8 * j; const LAS float* s = scr + (8 * c) * 68 + (n ^ (4 * c));
        v4u o; o.x = pk2(s[0 * 68], s[1 * 68]); o.y = pk2(s[2 * 68], s[3 * 68]); o.z = pk2(s[4 * 68], s[5 * 68]); o.w = pk2(s[6 * 68], s[7 * 68]);
        *(GAS v4u*)(WT + (size_t)(r0 + n) * K + k0 + 8 * c) = o; }
    LDS_WAIT(); asm volatile("" ::: "memory");
}
__device__ __forceinline__ void rms_row_to_bf16(int lane, const GAS float* xrow, const GAS float* gain, GAS bf16* orow) {
    const GAS f32x4* xr = (const GAS f32x4*)xrow + lane; const GAS f32x4* gr = (const GAS f32x4*)gain + lane;
    f32x4 v[4]; float s = 0.f;
#pragma unroll
    for (int j = 0; j < 4; ++j) { v[j] = xr[64 * j]; s += (v[j].x * v[j].x + v[j].y * v[j].y) + (v[j].z * v[j].z + v[j].w * v[j].w); }
    const float rs = 1.0f / sqrtf(wave_sum(s) * (1.f / D) + RMS_EPS);
    GAS unsigned long long* o8 = (GAS unsigned long long*)orow + lane;
#pragma unroll
    for (int j = 0; j < 4; ++j) { const f32x4 g = gr[64 * j]; o8[64 * j] = (unsigned long long)pk2(v[j].x * rs * g.x, v[j].y * rs * g.y) | ((unsigned long long)pk2(v[j].z * rs * g.z, v[j].w * rs * g.w) << 32); }
}
__device__ __forceinline__ void convert_group(Frame& F, int group, int gw, int NGW) {
    int tidl = threadIdx.x; asm volatile("" : "+v"(tidl)); const int lane_ = tidl & 63;
    LAS float* scr = (LAS float*)(F.lds + RING_OFF + F.wave * P0_SCR);
    GAS unsigned char* ws = F.ws;
    constexpr int I_GU = (D / 64) * (FF / 64), I_DN = (FF / 64) * (D / 64), I_IN = (D / 64) * (NIN / 64), I_SQ = (D / 64) * (D / 64), I_PP = (PLE / 64) * (D / 64), I_L64 = (D / 64), I_L128 = 2 * (D / 64);
    constexpr int I_LORA = 2 * I_L64 + I_L128 + I_PP;
    const int nitems = group == 0 ? 2 * I_GU : (group == 1 ? I_DN + I_IN : (group == 2 ? I_LORA : 2 * I_GU + I_DN + 2 * I_SQ));
#pragma unroll 1
    for (int it = gw; it < nitems; it += NGW) {
        int r = (group == 3) ? it + I_LORA : it, wi, gi = -1, K, N, mode = 0; size_t dst;
        if (group == 0) {
            if (r < I_GU) { wi = 8; K = D; N = FF; dst = WS_W1GU; mode = 1; } else { r -= I_GU; wi = 9; K = D; N = FF; dst = WS_W1GU; mode = 2; }
        } else if (group == 1) {
            if (r < I_DN) { wi = 10; K = FF; N = D; dst = WS_W1D; } else { r -= I_DN; wi = 12; gi = 11; K = D; N = NIN; dst = WS_WIN; }
        } else {
            if (r < I_L64) { wi = 14; K = 64; N = D; dst = WS_WDU; }
            else if ((r -= I_L64) < I_L64) { wi = 16; K = 64; N = D; dst = WS_WIU; }
            else if ((r -= I_L64) < I_L128) { wi = 18; K = 128; N = D; dst = WS_WGU; }
            else if ((r -= I_L128) < I_PP) { wi = 32; K = PLE; N = D; dst = WS_WPP; }
            else if ((r -= I_PP) < I_SQ) { wi = 25; K = D; N = D; dst = WS_WOUT; }
            else if ((r -= I_SQ) < I_GU) { wi = 27; gi = 26; K = D; N = FF; dst = WS_W2GU; mode = 1; }
            else if ((r -= I_GU) < I_GU) { wi = 28; gi = 26; K = D; N = FF; dst = WS_W2GU; mode = 2; }
            else if ((r -= I_GU) < I_DN) { wi = 29; K = FF; N = D; dst = WS_W2D; }
            else { r -= I_DN; wi = 31; gi = 30; K = D; N = D; dst = WS_WPG; }
        }
        const GAS float* gp = nullptr; if (gi >= 0) gp = F.inp(gi);
        p0_item(F.inp(wi), K, N, (GAS bf16*)(ws + dst), mode, gp, scr, r, lane_);
    }
}
__device__ __forceinline__ void p0_prologue(Frame& F) {
    const int gw = F.vcu * NWAVES + F.wave, NGW = F.G * NWAVES;
    GAS unsigned char* ws = F.ws;
    convert_group(F, 0, gw, NGW);
    for (int m = gw; m < MV; m += NGW) {
        const GAS float* xr = (m < MPR) ? F.inp(0) + (size_t)m * D : F.inp(1) + (size_t)(m - MPR) * D;
        rms_row_to_bf16(F.lane, xr, F.inp(7), (GAS bf16*)(ws + WS_XB) + (size_t)m * D);
        const GAS float* pr = (m < MPR) ? F.inp(2) + (size_t)m * PLE : F.inp(3) + (size_t)(m - MPR) * PLE;
        const f32x4 pv = ((const GAS f32x4*)pr)[F.lane];
        ((GAS unsigned long long*)((GAS bf16*)(ws + WS_PB) + (size_t)m * PLE))[F.lane] = (unsigned long long)pk2(pv.x, pv.y) | ((unsigned long long)pk2(pv.z, pv.w) << 32);
    }
}
__device__ __forceinline__ void p9_final(Frame& F) {
    const int gw = F.vcu * NWAVES + F.wave, NGW = F.G * NWAVES;
    const GAS bf16* XF = (const GAS bf16*)(F.ws + WS_GU);
    for (int m = gw; m < MV; m += NGW) {
        const GAS v4u* xr = (const GAS v4u*)(XF + (size_t)m * D) + F.lane; const GAS f32x4* gr = (const GAS f32x4*)F.inp(33) + 2 * F.lane;
        f32x4 v[4]; float s = 0.f;
#pragma unroll
        for (int j = 0; j < 2; ++j) { const v4u p = xr[64 * j]; v[2 * j] = (f32x4){bf_lo(p.x), bf_hi(p.x), bf_lo(p.y), bf_hi(p.y)}; v[2 * j + 1] = (f32x4){bf_lo(p.z), bf_hi(p.z), bf_lo(p.w), bf_hi(p.w)}; }
#pragma unroll
        for (int j = 0; j < 4; ++j) s += (v[j].x * v[j].x + v[j].y * v[j].y) + (v[j].z * v[j].z + v[j].w * v[j].w);
        const float rs = 1.0f / sqrtf(wave_sum(s) * (1.f / D) + RMS_EPS);
        GAS f32x4* yr = (GAS f32x4*)(F.out + (size_t)m * D) + 2 * F.lane;
#pragma unroll
        for (int j = 0; j < 2; ++j) { const f32x4 g0 = gr[128 * j], g1 = gr[128 * j + 1]; yr[128 * j] = v[2 * j] * rs * g0; yr[128 * j + 1] = v[2 * j + 1] * rs * g1; }
    }
}

constexpr int MX_WGU = 0, MX_AT = 17408, MX_AA = 22016, MX_AG = 26624, MX_LD = 35328, MX_AL = 43520, MX_LG = 51712, MX_LGT = 59904, MX_G = 60416  ,
              MX_KT = 76800, MX_RT = 81408, MX_KH = 86016, MX_BH = 90624, MX_KB = 95232, MX_VT = 104448, MX_TP = 109568, MX_AR = 111872, MX_AKK = 114176, MX_ABK = 116224,
              MX_G16 = 118272  , MX_Y = 119296, MX_BON = 127488  , MX_CU = 127744  , MX_CT = 145152, MX_CAR = 148992, MX_ID = 150784  , MX_END = 151808;
static_assert(MX_END <= LDSCTL_OFF, "mixer LDS map");
constexpr int SUBT = 32;
constexpr int CAR_STRIDE = 576;
constexpr int KT_ST = 144, KB_ST = 72, VT_ST = 40, TP_ST = 72;
__device__ __forceinline__ float logdecay_of(float x) { return -0.60653065971263342f * __builtin_amdgcn_rcpf(1.0f + __expf(-x)); }

struct RawZ { u32x2v r, k, v, rp, kp, vp, wd, ad, wdp, adp; v4u gd, gdp; u32x2v cC, cU; };

__device__ __forceinline__ void mix_load(RawZ& R, const GAS bf16* Zc, int lrow, bool first, int h, int q) {
    const GAS unsigned char* zb = (const GAS unsigned char*)Zc;
    const unsigned ro = (unsigned)lrow * (unsigned)(NIN * 2), po = first ? ro : ro - (unsigned)(NIN * 2);
    const unsigned hb = (unsigned)(64 * h + 4 * q) * 2u, qb = (unsigned)q * 8u;
    R.r = *(const GAS u32x2v*)(zb + (ro + hb)); R.k = *(const GAS u32x2v*)(zb + (ro + hb + 2048u)); R.v = *(const GAS u32x2v*)(zb + (ro + hb + 4096u));
    R.rp = *(const GAS u32x2v*)(zb + (po + hb)); R.kp = *(const GAS u32x2v*)(zb + (po + hb + 2048u)); R.vp = *(const GAS u32x2v*)(zb + (po + hb + 4096u));
    R.wd = *(const GAS u32x2v*)(zb + (ro + qb + 6144u)); R.ad = *(const GAS u32x2v*)(zb + (ro + qb + 6272u)); R.gd = *(const GAS v4u*)(zb + (ro + 2u * qb + 6400u));
    R.wdp = *(const GAS u32x2v*)(zb + (po + qb + 6144u)); R.adp = *(const GAS u32x2v*)(zb + (po + qb + 6272u)); R.gdp = *(const GAS v4u*)(zb + (po + 2u * qb + 6400u));
    R.cC = *(const GAS u32x2v*)(zb + (ro + hb + 8704u)); R.cU = *(const GAS u32x2v*)(zb + (ro + hb + 10752u));
}

#ifdef PROBE_TS_A
#define PROBE_MIX
#endif
__device__ __forceinline__ void mix_job(Frame& F, int b, int h, int chunk) {
    LAS unsigned char* lds = F.lds;
    asm volatile("" : "+s"(b), "+s"(h), "+s"(chunk));
    int tid = threadIdx.x; asm volatile("" : "+v"(tid));
    const int lane = tid & 63, wave = __builtin_amdgcn_readfirstlane(tid >> 6);
    const int tt = tid >> 4, q = tid & 15;
    const GAS bf16* Zc = (const GAS bf16*)(F.ws + WS_Z + (size_t)(chunk & 1) * ZCH_BYTES);
    GAS float* car = (GAS float*)(F.ws + WS_CAR) + (size_t)(b * NHEAD + h) * CAR_STRIDE;
    const GAS bf16* GBb = (h >= 12) ? (const GAS bf16*)(F.ws + WS_ZX) + (size_t)chunk * (NBATCH * TCH) * 256 + 64 * (h - 12) : Zc + 7424 + 64 * h; const int gbs = (h >= 12) ? 256 : NIN;
    const int hc = 64 * h + 4 * q;
    const int mb = wave & 1, nb = wave >> 1, lr = lane & 15, lq = lane >> 4;
    const bool cont = (chunk != 0);
    const GAS bf16* wgu = (const GAS bf16*)(F.ws + WS_WGU) + (size_t)(64 * h) * 128;
    f32x4 ctv[2];
#pragma unroll
    for (int i = 0; i < 2; ++i) {
        const int rw = (wave + 8 * i < 15) ? wave + 8 * i : 14;
        const int idx = rw < 7 ? 13 : (rw < 12 ? rw + 12 : 24);
        const int off = rw < 3 ? rw * 1024 + 64 * h : (rw < 7 ? 3072 + 64 * (rw - 3) : (rw < 12 ? 64 * h : (rw - 12) * 1024 + 64 * h));
        ctv[i] = *(const GAS f32x4*)(F.inp(idx) + off + 4 * (lane & 15));
    }
    const float dbias = F.inp(15)[64 * h + 16 * nb + lr], ibias = F.inp(17)[64 * h + 16 * nb + lr];
    bf16x8 bfD[2], bfI[2];
    { const GAS bf16* wdu = (const GAS bf16*)(F.ws + WS_WDU) + (size_t)(64 * h + 16 * nb + lr) * 64 + 8 * lq; const GAS bf16* wiu = (const GAS bf16*)(F.ws + WS_WIU) + (size_t)(64 * h + 16 * nb + lr) * 64 + 8 * lq;
      bfD[0] = *(const GAS bf16x8*)wdu; bfD[1] = *(const GAS bf16x8*)(wdu + 32); bfI[0] = *(const GAS bf16x8*)wiu; bfI[1] = *(const GAS bf16x8*)(wiu + 32); }
    GAS float* Sg = F.out + O_WKVP + (size_t)(b * NHEAD + h) * 4096;
    f32x4 Hs[4];
#pragma unroll
    for (int kb = 0; kb < 4; ++kb) Hs[kb] = *(const GAS f32x4*)(Sg + (size_t)(16 * (wave & 3) + lr) * 64 + 16 * kb + 4 * lq);
    const f32x4 ch0 = *(const GAS f32x4*)(car + 448 + (tt & 1) * 64 + 4 * q);
    f32x4 c7[7];
#pragma unroll
    for (int i = 0; i < 7; ++i) c7[i] = *(const GAS f32x4*)(car + 64 * i + 4 * q);
    RawZ R; mix_load(R, Zc, b * TCH + tt, (tt == 0), h, q);
    const v4u wg0 = *(const GAS v4u*)(wgu + tid * 8), wg1 = *(const GAS v4u*)(wgu + (tid + 512) * 8);
    __builtin_amdgcn_sched_barrier(0);
    *(LAS v4u*)(lds + MX_WGU + (tid >> 4) * 272 + (tid & 15) * 16) = wg0; *(LAS v4u*)(lds + MX_WGU + ((tid + 512) >> 4) * 272 + (tid & 15) * 16) = wg1;
    if (tid < 256) *(LAS float*)(lds + MX_ID + tid * 4) = ((tid >> 4) == (tid & 15)) ? 1.0f : 0.0f;
    if (lane < 16) { *(LAS f32x4*)(lds + MX_CT + wave * 256 + lane * 16) = ctv[0]; if (wave < 7) *(LAS f32x4*)(lds + MX_CT + (wave + 8) * 256 + lane * 16) = ctv[1]; }
    { const f32x4 z4 = (f32x4){0.f, 0.f, 0.f, 0.f};
#pragma unroll
      for (int kb = 0; kb < 4; ++kb) Hs[kb] = (cont && wave < 4) ? Hs[kb] : z4;
      if (tt < 2) *(LAS f32x4*)(lds + MX_CU + tt * 256 + q * 16) = cont ? ch0 : z4;
      if (tt == 0) {
#pragma unroll
          for (int i = 0; i < 7; ++i) *(LAS f32x4*)(lds + MX_CAR + i * 256 + q * 16) = cont ? c7[i] : z4;
      } }
    const int tid0 = tid;
    WG_SYNC();
    constexpr int NSC = TCH / SUBT;
    f32x4 v_c = (f32x4){0.f, 0.f, 0.f, 0.f}, cu_c = v_c; u32x2v mo_w = (u32x2v){0u, 0u};
#ifdef PROBE_MIX
    unsigned tacc0 = 0, tacc1 = 0, tacc2 = 0, tacc3 = 0, tprev = (unsigned)__builtin_amdgcn_s_memrealtime(); const unsigned tstart = tprev;
#endif
    for (int j = -1; j < NSC; ++j) {
        int tid = tid0; asm volatile("" : "+v"(tid));
        const int lane = tid & 63, tt = tid >> 4, q = tid & 15, lr = lane & 15, lq = lane >> 4, hc = 64 * h + 4 * q;
        const bool front = (j + 1 < NSC), back = (j >= 0);
        const int sf = j + 1, pf = sf & 1, pb = j & 1;
        f32x4 r_s, k_s, v_n, cu_n; u32x2v fB, fA, fG;
        if (back)
        if (wave < 4) {
            const int g = wave & 1, kind = wave >> 1;
            const LAS unsigned char* As = lds + (kind ? MX_RT : MX_KT) + g * 16 * KT_ST; const LAS unsigned char* Bk = lds + MX_KH + g * 16 * KT_ST; const LAS unsigned char* Bb = lds + MX_BH + g * 16 * KT_ST;
            f32x4 accK = (f32x4){0.f, 0.f, 0.f, 0.f}, accB = accK;
#pragma unroll
            for (int ks = 0; ks < 2; ++ks) { const bf16x8 af = *(const LAS bf16x8*)(As + lr * KT_ST + (32 * ks + 8 * lq) * 2), bk = *(const LAS bf16x8*)(Bk + lr * KT_ST + (32 * ks + 8 * lq) * 2), bb = *(const LAS bf16x8*)(Bb + lr * KT_ST + (32 * ks + 8 * lq) * 2);
                accK = __builtin_amdgcn_mfma_f32_16x16x32_bf16(af, bk, accK, 0, 0, 0); accB = __builtin_amdgcn_mfma_f32_16x16x32_bf16(af, bb, accB, 0, 0, 0); }
            if (kind == 0) {
                LAS float* akk = (LAS float*)(lds + MX_AKK + g * 1024); LAS float* abk = (LAS float*)(lds + MX_ABK + g * 1024);
#pragma unroll
                for (int rg = 0; rg < 4; ++rg) { const int i = 4 * lq + rg; const bool keep = (lr < i); akk[i * 16 + lr] = keep ? accK[rg] : 0.f;
                    abk[i * 16 + lr] = keep ? accB[rg] : 0.f;
                }
                const int wh = (lane >> 4) & 1, jc = lane & 15;
                float t[16];
                { const LAS float* ini = wh ? (const LAS float*)akk : (const LAS float*)(lds + MX_ID);
#pragma unroll
                  for (int i = 0; i < 16; ++i) t[i] = ini[i * 16 + jc]; }
                {
                    f32x4 c[12];
                    c[0] = *(const LAS f32x4*)(abk + 16);
                    c[1] = *(const LAS f32x4*)(abk + 32);
                    c[2] = *(const LAS f32x4*)(abk + 48);
                    c[3] = *(const LAS f32x4*)(abk + 64);
                    c[4] = *(const LAS f32x4*)(abk + 80);
                    c[5] = *(const LAS f32x4*)(abk + 84);
                    c[6] = *(const LAS f32x4*)(abk + 96);
                    c[7] = *(const LAS f32x4*)(abk + 100);
                    c[8] = *(const LAS f32x4*)(abk + 112);
                    c[9] = *(const LAS f32x4*)(abk + 116);
                    c[10] = *(const LAS f32x4*)(abk + 128);
                    c[11] = *(const LAS f32x4*)(abk + 132);
                    __builtin_amdgcn_sched_barrier(0);
                    t[1] -= c[0][0] * t[0];
                    t[2] -= c[1][0] * t[0];
                    t[2] -= c[1][1] * t[1];
                    t[3] -= c[2][0] * t[0];
                    t[3] -= c[2][1] * t[1];
                    t[3] -= c[2][2] * t[2];
                    t[4] -= c[3][0] * t[0];
                    t[4] -= c[3][1] * t[1];
                    t[4] -= c[3][2] * t[2];
                    t[4] -= c[3][3] * t[3];
                    t[5] -= c[4][0] * t[0];
                    t[5] -= c[4][1] * t[1];
                    t[5] -= c[4][2] * t[2];
                    t[5] -= c[4][3] * t[3];
                    t[5] -= c[5][0] * t[4];
                    t[6] -= c[6][0] * t[0];
                    t[6] -= c[6][1] * t[1];
                    t[6] -= c[6][2] * t[2];
                    t[6] -= c[6][3] * t[3];
                    t[6] -= c[7][0] * t[4];
                    t[6] -= c[7][1] * t[5];
                    t[7] -= c[8][0] * t[0];
                    t[7] -= c[8][1] * t[1];
                    t[7] -= c[8][2] * t[2];
                    t[7] -= c[8][3] * t[3];
                    t[7] -= c[9][0] * t[4];
                    t[7] -= c[9][1] * t[5];
                    t[7] -= c[9][2] * t[6];
                    t[8] -= c[10][0] * t[0];
                    t[8] -= c[10][1] * t[1];
                    t[8] -= c[10][2] * t[2];
                    t[8] -= c[10][3] * t[3];
                    t[8] -= c[11][0] * t[4];
                    t[8] -= c[11][1] * t[5];
                    t[8] -= c[11][2] * t[6];
                    t[8] -= c[11][3] * t[7];
                    __builtin_amdgcn_sched_barrier(0);
                }
                {
                    f32x4 c[12];
                    c[0] = *(const LAS f32x4*)(abk + 144);
                    c[1] = *(const LAS f32x4*)(abk + 148);
                    c[2] = *(const LAS f32x4*)(abk + 152);
                    c[3] = *(const LAS f32x4*)(abk + 160);
                    c[4] = *(const LAS f32x4*)(abk + 164);
                    c[5] = *(const LAS f32x4*)(abk + 168);
                    c[6] = *(const LAS f32x4*)(abk + 176);
                    c[7] = *(const LAS f32x4*)(abk + 180);
                    c[8] = *(const LAS f32x4*)(abk + 184);
                    c[9] = *(const LAS f32x4*)(abk + 192);
                    c[10] = *(const LAS f32x4*)(abk + 196);
                    c[11] = *(const LAS f32x4*)(abk + 200);
                    __builtin_amdgcn_sched_barrier(0);
                    t[9] -= c[0][0] * t[0];
                    t[9] -= c[0][1] * t[1];
                    t[9] -= c[0][2] * t[2];
                    t[9] -= c[0][3] * t[3];
                    t[9] -= c[1][0] * t[4];
                    t[9] -= c[1][1] * t[5];
                    t[9] -= c[1][2] * t[6];
                    t[9] -= c[1][3] * t[7];
                    t[9] -= c[2][0] * t[8];
                    t[10] -= c[3][0] * t[0];
                    t[10] -= c[3][1] * t[1];
                    t[10] -= c[3][2] * t[2];
                    t[10] -= c[3][3] * t[3];
                    t[10] -= c[4][0] * t[4];
                    t[10] -= c[4][1] * t[5];
                    t[10] -= c[4][2] * t[6];
                    t[10] -= c[4][3] * t[7];
                    t[10] -= c[5][0] * t[8];
                    t[10] -= c[5][1] * t[9];
                    t[11] -= c[6][0] * t[0];
                    t[11] -= c[6][1] * t[1];
                    t[11] -= c[6][2] * t[2];
                    t[11] -= c[6][3] * t[3];
                    t[11] -= c[7][0] * t[4];
                    t[11] -= c[7][1] * t[5];
                    t[11] -= c[7][2] * t[6];
                    t[11] -= c[7][3] * t[7];
                    t[11] -= c[8][0] * t[8];
                    t[11] -= c[8][1] * t[9];
                    t[11] -= c[8][2] * t[10];
                    t[12] -= c[9][0] * t[0];
                    t[12] -= c[9][1] * t[1];
                    t[12] -= c[9][2] * t[2];
                    t[12] -= c[9][3] * t[3];
                    t[12] -= c[10][0] * t[4];
                    t[12] -= c[10][1] * t[5];
                    t[12] -= c[10][2] * t[6];
                    t[12] -= c[10][3] * t[7];
                    t[12] -= c[11][0] * t[8];
                    t[12] -= c[11][1] * t[9];
                    t[12] -= c[11][2] * t[10];
                    t[12] -= c[11][3] * t[11];
                    __builtin_amdgcn_sched_barrier(0);
                }
                {
                    f32x4 c[12];
                    c[0] = *(const LAS f32x4*)(abk + 208);
                    c[1] = *(const LAS f32x4*)(abk + 212);
                    c[2] = *(const LAS f32x4*)(abk + 216);
                    c[3] = *(const LAS f32x4*)(abk + 220);
                    c[4] = *(const LAS f32x4*)(abk + 224);
                    c[5] = *(const LAS f32x4*)(abk + 228);
                    c[6] = *(const LAS f32x4*)(abk + 232);
                    c[7] = *(const LAS f32x4*)(abk + 236);
                    c[8] = *(const LAS f32x4*)(abk + 240);
                    c[9] = *(const LAS f32x4*)(abk + 244);
                    c[10] = *(const LAS f32x4*)(abk + 248);
                    c[11] = *(const LAS f32x4*)(abk + 252);
                    __builtin_amdgcn_sched_barrier(0);
                    t[13] -= c[0][0] * t[0];
                    t[13] -= c[0][1] * t[1];
                    t[13] -= c[0][2] * t[2];
                    t[13] -= c[0][3] * t[3];
                    t[13] -= c[1][0] * t[4];
                    t[13] -= c[1][1] * t[5];
                    t[13] -= c[1][2] * t[6];
                    t[13] -= c[1][3] * t[7];
                    t[13] -= c[2][0] * t[8];
                    t[13] -= c[2][1] * t[9];
                    t[13] -= c[2][2] * t[10];
                    t[13] -= c[2][3] * t[11];
                    t[13] -= c[3][0] * t[12];
                    t[14] -= c[4][0] * t[0];
                    t[14] -= c[4][1] * t[1];
                    t[14] -= c[4][2] * t[2];
                    t[14] -= c[4][3] * t[3];
                    t[14] -= c[5][0] * t[4];
                    t[14] -= c[5][1] * t[5];
                    t[14] -= c[5][2] * t[6];
                    t[14] -= c[5][3] * t[7];
                    t[14] -= c[6][0] * t[8];
                    t[14] -= c[6][1] * t[9];
                    t[14] -= c[6][2] * t[10];
                    t[14] -= c[6][3] * t[11];
                    t[14] -= c[7][0] * t[12];
                    t[14] -= c[7][1] * t[13];
                    t[15] -= c[8][0] * t[0];
                    t[15] -= c[8][1] * t[1];
                    t[15] -= c[8][2] * t[2];
                    t[15] -= c[8][3] * t[3];
                    t[15] -= c[9][0] * t[4];
                    t[15] -= c[9][1] * t[5];
                    t[15] -= c[9][2] * t[6];
                    t[15] -= c[9][3] * t[7];
                    t[15] -= c[10][0] * t[8];
                    t[15] -= c[10][1] * t[9];
                    t[15] -= c[10][2] * t[10];
                    t[15] -= c[10][3] * t[11];
                    t[15] -= c[11][0] * t[12];
                    t[15] -= c[11][1] * t[13];
                    t[15] -= c[11][2] * t[14];
                    __builtin_amdgcn_sched_barrier(0);
                }
#pragma unroll
                for (int i = 0; i < 16; ++i) *(LAS unsigned short*)(lds + MX_TP + g * 16 * TP_ST + i * TP_ST + wh * 32 + jc * 2) = (unsigned short)pg8::cvt_pk_bf16(t[i], 0.f);
            } else {
#pragma unroll
                for (int rg = 0; rg < 4; ++rg) { const int i = 4 * lq + rg; const bool keep = (lr <= i);
                    *(LAS unsigned short*)(lds + MX_AR + g * 16 * TP_ST + i * TP_ST + lr * 2) = (unsigned short)pg8::cvt_pk_bf16(keep ? accK[rg] : 0.f, 0.f);
                    *(LAS unsigned short*)(lds + MX_AR + g * 16 * TP_ST + i * TP_ST + 32 + lr * 2) = (unsigned short)pg8::cvt_pk_bf16(keep ? -accB[rg] : 0.f, 0.f); }
            }
        }
        if (front) {
            const bool first = (sf == 0 && tt == 0);
            const f32x4 mu_r = *(const LAS f32x4*)(lds + MX_CT + 0 * 256 + q * 16), mu_k = *(const LAS f32x4*)(lds + MX_CT + 1 * 256 + q * 16), mu_v = *(const LAS f32x4*)(lds + MX_CT + 2 * 256 + q * 16);
            const f32x4 mu_wd = *(const LAS f32x4*)(lds + MX_CT + 3 * 256 + q * 16), mu_ad = *(const LAS f32x4*)(lds + MX_CT + 4 * 256 + q * 16);
            const f32x4 mu_g0 = *(const LAS f32x4*)(lds + MX_CT + 5 * 256 + q * 32), mu_g1 = *(const LAS f32x4*)(lds + MX_CT + 5 * 256 + q * 32 + 16);
            f32x4 zr_ = unpk4(R.r), zk_ = unpk4(R.k), zv_ = unpk4(R.v), zwd = unpk4(R.wd), zad = unpk4(R.ad);
            f32x4 zg0 = unpk4((u32x2v){R.gd.x, R.gd.y}), zg1 = unpk4((u32x2v){R.gd.z, R.gd.w});
            f32x4 pr_ = unpk4(R.rp), pk_ = unpk4(R.kp), pv_ = unpk4(R.vp), pwd = unpk4(R.wdp), pad = unpk4(R.adp);
            f32x4 pg0 = unpk4((u32x2v){R.gdp.x, R.gdp.y}), pg1 = unpk4((u32x2v){R.gdp.z, R.gdp.w});
            if (first) { const LAS float* cl = (const LAS float*)(lds + MX_CAR);
                pr_ = *(const LAS f32x4*)(cl + 4 * q); pk_ = *(const LAS f32x4*)(cl + 64 + 4 * q); pv_ = *(const LAS f32x4*)(cl + 128 + 4 * q);
                pwd = *(const LAS f32x4*)(cl + 192 + 4 * q); pad = *(const LAS f32x4*)(cl + 256 + 4 * q); pg0 = *(const LAS f32x4*)(cl + 320 + 8 * q); pg1 = *(const LAS f32x4*)(cl + 324 + 8 * q); }
            if (chunk < NTC - 1 && sf == NSC - 1 && tt == SUBT - 1) {
                *(GAS f32x4*)(car + 4 * q) = zr_; *(GAS f32x4*)(car + 64 + 4 * q) = zk_; *(GAS f32x4*)(car + 128 + 4 * q) = zv_;
                *(GAS f32x4*)(car + 192 + 4 * q) = zwd; *(GAS f32x4*)(car + 256 + 4 * q) = zad; *(GAS f32x4*)(car + 320 + 8 * q) = zg0; *(GAS f32x4*)(car + 324 + 8 * q) = zg1;
            }
            if (chunk == NTC - 1 && sf == NSC - 1 && tt == SUBT - 1) {
                GAS float* d = F.out + O_SHP + (size_t)b * SHIFTC;
                *(GAS f32x4*)(d + hc) = zr_; *(GAS f32x4*)(d + 1024 + hc) = zk_; *(GAS f32x4*)(d + 2048 + hc) = zv_;
                if (h == 0) { *(GAS f32x4*)(d + 3072 + 4 * q) = zwd; *(GAS f32x4*)(d + 3136 + 4 * q) = zad; *(GAS f32x4*)(d + 3200 + 8 * q) = zg0; *(GAS f32x4*)(d + 3204 + 8 * q) = zg1; }
            }
            r_s = zr_ + mu_r * (pr_ - zr_); k_s = zk_ + mu_k * (pk_ - zk_); v_n = zv_ + mu_v * (pv_ - zv_);
            const f32x4 wd_s = zwd + mu_wd * (pwd - zwd), ad_s = zad + mu_ad * (pad - zad), g0_s = zg0 + mu_g0 * (pg0 - zg0), g1_s = zg1 + mu_g1 * (pg1 - zg1);
            { u32x2v w; w.x = pg8::cvt_pk_bf16(ftanh(wd_s[0]), ftanh(wd_s[1])); w.y = pg8::cvt_pk_bf16(ftanh(wd_s[2]), ftanh(wd_s[3])); *(LAS u32x2v*)(lds + MX_AT + tt * 144 + q * 8) = w; }
            { u32x2v w; w.x = pg8::cvt_pk_bf16(ad_s[0], ad_s[1]); w.y = pg8::cvt_pk_bf16(ad_s[2], ad_s[3]); *(LAS u32x2v*)(lds + MX_AA + tt * 144 + q * 8) = w; }
            { v4u w; w.x = pg8::cvt_pk_bf16(fsig(g0_s[0]), fsig(g0_s[1])); w.y = pg8::cvt_pk_bf16(fsig(g0_s[2]), fsig(g0_s[3])); w.z = pg8::cvt_pk_bf16(fsig(g1_s[0]), fsig(g1_s[1])); w.w = pg8::cvt_pk_bf16(fsig(g1_s[2]), fsig(g1_s[3]));
              *(LAS v4u*)(lds + MX_AG + tt * 272 + q * 16) = w; }
            cu_n = unpk4(R.cC) * unpk4(R.cU);
            *(LAS f32x4*)(lds + MX_CU + pf * 8704 + (tt + 2) * 256 + q * 16) = cu_n;
        } else {
            asm volatile("" :: "v"(R.r.x), "v"(R.r.y), "v"(R.k.x), "v"(R.k.y), "v"(R.v.x), "v"(R.v.y), "v"(R.rp.x), "v"(R.rp.y), "v"(R.kp.x), "v"(R.kp.y), "v"(R.vp.x), "v"(R.vp.y), "v"(R.wd.x), "v"(R.wd.y));
            asm volatile("" :: "v"(R.ad.x), "v"(R.ad.y), "v"(R.wdp.x), "v"(R.wdp.y), "v"(R.adp.x), "v"(R.adp.y), "v"(R.gd.x), "v"(R.gd.y), "v"(R.gd.z), "v"(R.gd.w), "v"(R.gdp.x), "v"(R.gdp.y), "v"(R.gdp.z), "v"(R.gdp.w));
            asm volatile("" :: "v"(R.cC.x), "v"(R.cC.y), "v"(R.cU.x), "v"(R.cU.y));
            r_s = (f32x4){0.f, 0.f, 0.f, 0.f}; k_s = r_s; v_n = r_s; cu_n = r_s;
        }
        __builtin_amdgcn_sched_barrier(0);
        if (j >= 1) *(GAS u32x2v*)((GAS bf16*)(F.ws + WS_MIX) + (size_t)(b * TSEQ + chunk * TCH + (j - 1) * SUBT + tt) * D + hc) = mo_w;
        mix_load(R, Zc, b * TCH + (sf + 1 < NSC ? sf + 1 : NSC - 1) * SUBT + tt, false, h, q);
        { const int lrow = b * TCH + (j < 0 ? 0 : j) * SUBT + tt; const unsigned ro = (unsigned)lrow * (unsigned)(NIN * 2) + (unsigned)hc * 2u;
            fB = *(const GAS u32x2v*)((const GAS unsigned char*)Zc + (ro + 6656u)); fA = *(const GAS u32x2v*)((const GAS unsigned char*)Zc + (ro + 12800u));
            fG = *(const GAS u32x2v*)((const GAS unsigned char*)GBb + ((unsigned)lrow * (unsigned)(gbs * 2) + (unsigned)q * 8u)); }
        WG_SYNC();
#ifdef PROBE_MIX
        { const unsigned tn = (unsigned)__builtin_amdgcn_s_memrealtime(); tacc0 += tn - tprev; tprev = tn; }
#endif
        if (front)
        {
            f32x4 a1 = (f32x4){0.f, 0.f, 0.f, 0.f}, a2 = a1, a3 = a1;
#pragma unroll
            for (int ks = 0; ks < 2; ++ks) {
                const bf16x8 At = *(const LAS bf16x8*)(lds + MX_AT + (16 * mb + lr) * 144 + (32 * ks + 8 * lq) * 2);
                const bf16x8 Aa = *(const LAS bf16x8*)(lds + MX_AA + (16 * mb + lr) * 144 + (32 * ks + 8 * lq) * 2);
                a1 = __builtin_amdgcn_mfma_f32_16x16x32_bf16(At, bfD[ks], a1, 0, 0, 0); a2 = __builtin_amdgcn_mfma_f32_16x16x32_bf16(Aa, bfI[ks], a2, 0, 0, 0); }
#pragma unroll
            for (int ks = 0; ks < 4; ++ks) {
                const bf16x8 Ag = *(const LAS bf16x8*)(lds + MX_AG + (16 * mb + lr) * 272 + (32 * ks + 8 * lq) * 2), Bg = *(const LAS bf16x8*)(lds + MX_WGU + (16 * nb + lr) * 272 + (32 * ks + 8 * lq) * 2);
                a3 = __builtin_amdgcn_mfma_f32_16x16x32_bf16(Ag, Bg, a3, 0, 0, 0); }
            float ldv[4], pfx[4];
#pragma unroll
            for (int j = 0; j < 4; ++j) { ldv[j] = logdecay_of(dbias + a1[j]); pfx[j] = (j ? pfx[j - 1] : 0.f) + ldv[j]; }
            const float T = pfx[3]; const float t1 = __shfl_up(T, 16); float sI = T + (lq >= 1 ? t1 : 0.f); const float t2 = __shfl_up(sI, 32); sI += (lq >= 2 ? t2 : 0.f);
            const float excl = sI - T, tot = __shfl(sI, 48 + lr);
#pragma unroll
            for (int j = 0; j < 4; ++j) { const int o = ((16 * mb + 4 * lq + j) * 64 + 16 * nb + lr) * 4;
                *(LAS float*)(lds + MX_LD + o) = ldv[j]; *(LAS float*)(lds + MX_LG + o) = excl + pfx[j]; *(LAS float*)(lds + MX_AL + o) = fsig(ibias + a2[j]); *(LAS float*)(lds + MX_G + pf * 8192 + o) = a3[j]; }
            if (lq == 0) *(LAS float*)(lds + MX_G16 + pf * 512 + (mb * 64 + 16 * nb + lr) * 4) = __expf(tot);
        }
        if (back && wave < 4) {
            const int cb = wave;
            f32x4 Hl[4];
#pragma unroll
            for (int kb = 0; kb < 4; ++kb) Hl[kb] = Hs[kb];
            v4u kaw[2][2], raw[2][2], taw[2], aaw[2], caw[4]; u32x2v vtw[2]; f32x4 g4w[4];
#define E_LD8(base) ({ const LAS unsigned char* p_ = (base); const u32x2v x0_ = *(const LAS u32x2v*)p_, x1_ = *(const LAS u32x2v*)(p_ + 32); (v4u){x0_.x, x0_.y, x1_.x, x1_.y}; })
#pragma unroll
            for (int g = 0; g < 2; ++g) {
#pragma unroll
                for (int s2 = 0; s2 < 2; ++s2) { kaw[g][s2] = E_LD8(lds + MX_KT + g * 16 * KT_ST + lr * KT_ST + (32 * s2 + 4 * lq) * 2); raw[g][s2] = E_LD8(lds + MX_RT + g * 16 * KT_ST + lr * KT_ST + (32 * s2 + 4 * lq) * 2); }
                taw[g] = E_LD8(lds + MX_TP + g * 16 * TP_ST + lr * TP_ST + 4 * lq * 2); aaw[g] = E_LD8(lds + MX_AR + g * 16 * TP_ST + lr * TP_ST + 4 * lq * 2);
                vtw[g] = *(const LAS u32x2v*)(lds + MX_VT + g * 64 * VT_ST + (16 * cb + lr) * VT_ST + 4 * lq * 2);
            }
#pragma unroll
            for (int kb = 0; kb < 4; ++kb) { caw[kb] = E_LD8(lds + MX_KB + (16 * kb + lr) * KB_ST + 4 * lq * 2); g4w[kb] = *(const LAS f32x4*)(lds + MX_G16 + pb * 512 + (16 * kb + 4 * lq) * 4); }
            __builtin_amdgcn_sched_barrier(0);
#pragma unroll
            for (int g = 0; g < 2; ++g) {
                f32x4 Wa = (f32x4){0.f, 0.f, 0.f, 0.f}, Za = Wa;
#pragma unroll
                for (int s2 = 0; s2 < 2; ++s2) {
                    const f32x4 lo = Hl[2 * s2], hi = Hl[2 * s2 + 1];
                    const bf16x8 hb = __builtin_bit_cast(bf16x8, (v4u){pg8::cvt_pk_bf16(lo[0], lo[1]), pg8::cvt_pk_bf16(lo[2], lo[3]), pg8::cvt_pk_bf16(hi[0], hi[1]), pg8::cvt_pk_bf16(hi[2], hi[3])});
                    Wa = __builtin_amdgcn_mfma_f32_16x16x32_bf16(__builtin_bit_cast(bf16x8, kaw[g][s2]), hb, Wa, 0, 0, 0); Za = __builtin_amdgcn_mfma_f32_16x16x32_bf16(__builtin_bit_cast(bf16x8, raw[g][s2]), hb, Za, 0, 0, 0); }
#pragma unroll
                for (int kb = 0; kb < 4; ++kb) Hl[kb] = Hl[kb] * g4w[kb];
                const bf16x8 bw = __builtin_bit_cast(bf16x8, (v4u){pg8::cvt_pk_bf16(Wa[0], Wa[1]), pg8::cvt_pk_bf16(Wa[2], Wa[3]), vtw[g].x, vtw[g].y});
                const f32x4 Ua = __builtin_amdgcn_mfma_f32_16x16x32_bf16(__builtin_bit_cast(bf16x8, taw[g]), bw, (f32x4){0.f, 0.f, 0.f, 0.f}, 0, 0, 0);
                const bf16x8 vu = __builtin_bit_cast(bf16x8, (v4u){vtw[g].x, vtw[g].y, pg8::cvt_pk_bf16(Ua[0], Ua[1]), pg8::cvt_pk_bf16(Ua[2], Ua[3])});
#pragma unroll
                for (int kb = 0; kb < 4; ++kb) Hl[kb] = __builtin_amdgcn_mfma_f32_16x16x32_bf16(__builtin_bit_cast(bf16x8, caw[kb]), vu, Hl[kb], 0, 0, 0);
                Za = __builtin_amdgcn_mfma_f32_16x16x32_bf16(__builtin_bit_cast(bf16x8, aaw[g]), vu, Za, 0, 0, 0);
                if (g == 0) {
                    __builtin_amdgcn_sched_barrier(0);
#pragma unroll
                    for (int kb = 0; kb < 4; ++kb) { caw[kb] = E_LD8(lds + MX_KB + 64 * KB_ST + (16 * kb + lr) * KB_ST + 4 * lq * 2); g4w[kb] = *(const LAS f32x4*)(lds + MX_G16 + pb * 512 + 256 + (16 * kb + 4 * lq) * 4); }
                    __builtin_amdgcn_sched_barrier(0);
                }
#pragma unroll
                for (int rg = 0; rg < 4; ++rg) *(LAS float*)(lds + MX_Y + (16 * g + 4 * lq + rg) * 256 + (16 * cb + lr) * 4) = Za[rg];
            }
#undef E_LD8
#pragma unroll
            for (int kb = 0; kb < 4; ++kb) Hs[kb] = Hl[kb];
        }
        WG_SYNC();
#ifdef PROBE_MIX
        { const unsigned tn = (unsigned)__builtin_amdgcn_s_memrealtime(); tacc1 += tn - tprev; tprev = tn; }
#endif
        if (front)
        {
            const f32x4 a4 = *(const LAS f32x4*)(lds + MX_AL + tt * 256 + q * 16);
            const f32x4 c_kk = *(const LAS f32x4*)(lds + MX_CT + 7 * 256 + q * 16), c_ka = *(const LAS f32x4*)(lds + MX_CT + 8 * 256 + q * 16), c_rk = *(const LAS f32x4*)(lds + MX_CT + 9 * 256 + q * 16);
            f32x4 kkr = k_s * c_kk; float ss = (kkr[0] * kkr[0] + kkr[1] * kkr[1]) + (kkr[2] * kkr[2] + kkr[3] * kkr[3]); ss = red16(ss);
            const float inv = __builtin_amdgcn_rsqf(fmaxf(ss, 1e-24f));
            const f32x4 kk = kkr * inv, km = k_s * (1.0f + (a4 - 1.0f) * c_ka), bb = kk * a4;
            float bo = (r_s[0] * km[0] * c_rk[0] + r_s[1] * km[1] * c_rk[1]) + (r_s[2] * km[2] * c_rk[2] + r_s[3] * km[3] * c_rk[3]); bo = red16(bo);
            if (q == 0) *(LAS float*)(lds + MX_BON + pf * 128 + tt * 4) = bo;
            const int g = tt >> 4, i = tt & 15;
            const f32x4 lg = *(const LAS f32x4*)(lds + MX_LG + tt * 256 + q * 16), ldm = *(const LAS f32x4*)(lds + MX_LD + tt * 256 + q * 16), g16 = *(const LAS f32x4*)(lds + MX_G16 + pf * 512 + g * 256 + q * 16);
            f32x4 e, em, ei, eb;
#pragma unroll
            for (int j = 0; j < 4; ++j) { e[j] = __expf(lg[j]); em[j] = __expf(lg[j] - ldm[j]); ei[j] = __expf(-lg[j]); eb[j] = g16[j] * ei[j]; }
            const f32x4 Kt = kk * em, Rt = r_s * e, Kh = km * ei, Bh = bb * ei, Kb = km * eb, Bb = bb * eb;
            const int ro = g * 16 * KT_ST + i * KT_ST + q * 8;
            { u32x2v w; w.x = pg8::cvt_pk_bf16(Kt[0], Kt[1]); w.y = pg8::cvt_pk_bf16(Kt[2], Kt[3]); *(LAS u32x2v*)(lds + MX_KT + ro) = w; }
            { u32x2v w; w.x = pg8::cvt_pk_bf16(Rt[0], Rt[1]); w.y = pg8::cvt_pk_bf16(Rt[2], Rt[3]); *(LAS u32x2v*)(lds + MX_RT + ro) = w; }
            { u32x2v w; w.x = pg8::cvt_pk_bf16(Kh[0], Kh[1]); w.y = pg8::cvt_pk_bf16(Kh[2], Kh[3]); *(LAS u32x2v*)(lds + MX_KH + ro) = w; }
            { u32x2v w; w.x = pg8::cvt_pk_bf16(Bh[0], Bh[1]); w.y = pg8::cvt_pk_bf16(Bh[2], Bh[3]); *(LAS u32x2v*)(lds + MX_BH + ro) = w; }
            const unsigned kb01 = pg8::cvt_pk_bf16(Kb[0], Kb[1]), kb23 = pg8::cvt_pk_bf16(Kb[2], Kb[3]), nb01 = pg8::cvt_pk_bf16(-Bb[0], -Bb[1]), nb23 = pg8::cvt_pk_bf16(-Bb[2], -Bb[3]);
            const unsigned vv01 = pg8::cvt_pk_bf16(v_n[0], v_n[1]), vv23 = pg8::cvt_pk_bf16(v_n[2], v_n[3]);
            LAS unsigned short* kbp = (LAS unsigned short*)(lds + MX_KB + g * 64 * KB_ST + (4 * q) * KB_ST + i * 2);
            kbp[0] = (unsigned short)kb01; kbp[KB_ST / 2] = (unsigned short)(kb01 >> 16); kbp[KB_ST] = (unsigned short)kb23; kbp[3 * KB_ST / 2] = (unsigned short)(kb23 >> 16);
            kbp[16] = (unsigned short)nb01; kbp[16 + KB_ST / 2] = (unsigned short)(nb01 >> 16); kbp[16 + KB_ST] = (unsigned short)nb23; kbp[16 + 3 * KB_ST / 2] = (unsigned short)(nb23 >> 16);
            LAS unsigned short* vtp = (LAS unsigned short*)(lds + MX_VT + g * 64 * VT_ST + (4 * q) * VT_ST + i * 2);
            vtp[0] = (unsigned short)vv01; vtp[VT_ST / 2] = (unsigned short)(vv01 >> 16); vtp[VT_ST] = (unsigned short)vv23; vtp[3 * VT_ST / 2] = (unsigned short)(vv23 >> 16);
        }
        if (back) {
            {
                const f32x4 y4 = *(const LAS f32x4*)(lds + MX_Y + tt * 256 + q * 16), g4 = *(const LAS f32x4*)(lds + MX_G + pb * 8192 + tt * 256 + q * 16);
                const float bo = *(const LAS float*)(lds + MX_BON + pb * 128 + tt * 4);
                const f32x4 c_gw = *(const LAS f32x4*)(lds + MX_CT + 10 * 256 + q * 16), c_gb = *(const LAS f32x4*)(lds + MX_CT + 11 * 256 + q * 16);
                const f32x4 c_w0 = *(const LAS f32x4*)(lds + MX_CT + 12 * 256 + q * 16), c_w1 = *(const LAS f32x4*)(lds + MX_CT + 13 * 256 + q * 16), c_w2 = *(const LAS f32x4*)(lds + MX_CT + 14 * 256 + q * 16);
                float sm = (y4[0] + y4[1]) + (y4[2] + y4[3]); sm = red16(sm); const float mean = sm * (1.0f / 64.0f);
                const f32x4 dy = y4 - mean; float sv = (dy[0] * dy[0] + dy[1] * dy[1]) + (dy[2] * dy[2] + dy[3] * dy[3]); sv = red16(sv);
                const float rstd = __builtin_amdgcn_rsqf(sv * (1.0f / 64.0f) + GN_EPS);
                const f32x4 ya = (dy * rstd * c_gw + c_gb + bo * v_c) * g4;
                const f32x4 cu0 = *(const LAS f32x4*)(lds + MX_CU + pb * 8704 + tt * 256 + q * 16), cu1 = *(const LAS f32x4*)(lds + MX_CU + pb * 8704 + (tt + 1) * 256 + q * 16);
                const f32x4 yb = unpk4(fB) * (c_w0 * cu0 + c_w1 * cu1 + c_w2 * cu_c);
                const f32x4 ga = unpk4(fA), gb = unpk4(fG);
                f32x4 mo;
#pragma unroll
                for (int j = 0; j < 4; ++j) mo[j] = fsig(ga[j]) * ya[j] + fsig(gb[j]) * yb[j];
                mo_w.x = pg8::cvt_pk_bf16(mo[0], mo[1]); mo_w.y = pg8::cvt_pk_bf16(mo[2], mo[3]);
                if (j == NSC - 1) *(GAS u32x2v*)((GAS bf16*)(F.ws + WS_MIX) + (size_t)(b * TSEQ + chunk * TCH + j * SUBT + tt) * D + hc) = mo_w;
            }
            if (tt >= SUBT - 2) {
                *(LAS f32x4*)(lds + MX_CU + (pb ^ 1) * 8704 + (tt - (SUBT - 2)) * 256 + q * 16) = cu_c;
                if (j == NSC - 1) {
                    if (chunk < NTC - 1) *(GAS f32x4*)(car + 448 + (tt - (SUBT - 2)) * 64 + 4 * q) = cu_c;
                    else *(GAS f32x4*)(F.out + O_CVP + (size_t)(b * 2 + (tt - (SUBT - 2))) * D + hc) = cu_c;
                }
            }
        }
        WG_SYNC();
#ifdef PROBE_MIX
        { const unsigned tn = (unsigned)__builtin_amdgcn_s_memrealtime(); tacc2 += tn - tprev; tprev = tn; }
#endif
        v_c = v_n; cu_c = cu_n;
    }
#ifdef PROBE_MIX
    if (blockIdx.x == 0 && threadIdx.x == 0 && chunk == 1) { __hip_atomic_store(F.ctl + 2048 + 32, tacc0, RLX_AGENT); __hip_atomic_store(F.ctl + 2048 + 33, tacc1, RLX_AGENT); __hip_atomic_store(F.ctl + 2048 + 34, tacc2, RLX_AGENT); __hip_atomic_store(F.ctl + 2048 + 35, tacc3, RLX_AGENT); __hip_atomic_store(F.ctl + 2048 + 36, tprev - tstart, RLX_AGENT); }
#endif
    if (wave < 4) {
#pragma unroll
        for (int kb = 0; kb < 4; ++kb) *(GAS f32x4*)(Sg + (size_t)(16 * wave + lr) * 64 + 16 * kb + 4 * lq) = Hs[kb];
    }
    WG_SYNC();
}


constexpr int SJ_TW = 0, SJ_AD = 256, SJ_SG = 512, SJ_KK = 1024, SJ_BB = 5120, SJ_DD = 9216, SJ_KM = 13312, SJ_RR = 17408, SJ_VV = 21504, SJ_Y = 25600;
__device__ __forceinline__ void sample_job(Frame& F, int s) {
    LAS unsigned char* lds = F.lds;
    asm volatile("" : "+s"(s));
    int tid = threadIdx.x; asm volatile("" : "+v"(tid));
    const int lane = tid & 63, wave = __builtin_amdgcn_readfirstlane(tid >> 6), c0 = 2 * tid;
    const GAS bf16* zr = (const GAS bf16*)(F.ws + WS_ZS) + (size_t)s * NIN;
    const GAS float* sh = F.inp(5) + (size_t)s * SHIFTC; const GAS float* mu = F.inp(13);
    float r_s[2], k_s[2], v_s[2];
    {
        const unsigned zr2 = *(const GAS unsigned*)(zr + c0), zk2 = *(const GAS unsigned*)(zr + 1024 + c0), zv2 = *(const GAS unsigned*)(zr + 2048 + c0);
        const f32x2 pr = *(const GAS f32x2*)(sh + c0), pk = *(const GAS f32x2*)(sh + 1024 + c0), pv = *(const GAS f32x2*)(sh + 2048 + c0);
        const f32x2 mr = *(const GAS f32x2*)(mu + c0), mk = *(const GAS f32x2*)(mu + 1024 + c0), mv = *(const GAS f32x2*)(mu + 2048 + c0);
        float z;
        z = bf_lo(zr2); r_s[0] = z + mr.x * (pr.x - z); z = bf_hi(zr2); r_s[1] = z + mr.y * (pr.y - z);
        z = bf_lo(zk2); k_s[0] = z + mk.x * (pk.x - z); z = bf_hi(zk2); k_s[1] = z + mk.y * (pk.y - z);
        z = bf_lo(zv2); v_s[0] = z + mv.x * (pv.x - z); z = bf_hi(zv2); v_s[1] = z + mv.y * (pv.y - z);
    }
    for (int c = 2 * tid; c < SHIFTC; c += 2 * NWAVES * 64) { const unsigned z2 = *(const GAS unsigned*)(zr + c); *(GAS f32x2*)(F.out + O_SHS + (size_t)s * SHIFTC + c) = (f32x2){bf_lo(z2), bf_hi(z2)}; }
    if (tid < 128) {
        const int i = 2 * tid; const unsigned z2 = *(const GAS unsigned*)(zr + 3072 + i); const f32x2 p = *(const GAS f32x2*)(sh + 3072 + i), m = *(const GAS f32x2*)(mu + 3072 + i);
        float a = bf_lo(z2), b2 = bf_hi(z2); a = a + m.x * (p.x - a); b2 = b2 + m.y * (p.y - b2);
        if (i < 64) { a = ftanh(a); b2 = ftanh(b2); } else if (i >= 128) { a = fsig(a); b2 = fsig(b2); }
        *(LAS f32x2*)(lds + SJ_TW + i * 4) = (f32x2){a, b2};
    }
    WG_SYNC();
    float dd[2], al[2], gg[2];
#pragma unroll
    for (int e = 0; e < 2; ++e) {
        const int n = c0 + e;
        const GAS bf16* wd = (const GAS bf16*)(F.ws + WS_WDU) + (size_t)n * 64; const GAS bf16* wi = (const GAS bf16*)(F.ws + WS_WIU) + (size_t)n * 64; const GAS bf16* wg = (const GAS bf16*)(F.ws + WS_WGU) + (size_t)n * 128;
        float s1 = 0.f, s2 = 0.f, s3 = 0.f;
#pragma unroll 2
        for (int k8 = 0; k8 < 8; ++k8) { const v4u a = *(const GAS v4u*)(wd + 8 * k8), b4 = *(const GAS v4u*)(wi + 8 * k8);
            const f32x4 t0 = *(const LAS f32x4*)(lds + SJ_TW + k8 * 32), t1 = *(const LAS f32x4*)(lds + SJ_TW + k8 * 32 + 16), u0 = *(const LAS f32x4*)(lds + SJ_AD + k8 * 32), u1 = *(const LAS f32x4*)(lds + SJ_AD + k8 * 32 + 16);
            s1 += (bf_lo(a.x) * t0[0] + bf_hi(a.x) * t0[1]) + (bf_lo(a.y) * t0[2] + bf_hi(a.y) * t0[3]) + (bf_lo(a.z) * t1[0] + bf_hi(a.z) * t1[1]) + (bf_lo(a.w) * t1[2] + bf_hi(a.w) * t1[3]);
            s2 += (bf_lo(b4.x) * u0[0] + bf_hi(b4.x) * u0[1]) + (bf_lo(b4.y) * u0[2] + bf_hi(b4.y) * u0[3]) + (bf_lo(b4.z) * u1[0] + bf_hi(b4.z) * u1[1]) + (bf_lo(b4.w) * u1[2] + bf_hi(b4.w) * u1[3]); }
#pragma unroll 4
        for (int k8 = 0; k8 < 16; ++k8) { const v4u a = *(const GAS v4u*)(wg + 8 * k8);
            const f32x4 t0 = *(const LAS f32x4*)(lds + SJ_SG + k8 * 32), t1 = *(const LAS f32x4*)(lds + SJ_SG + k8 * 32 + 16);
            s3 += (bf_lo(a.x) * t0[0] + bf_hi(a.x) * t0[1]) + (bf_lo(a.y) * t0[2] + bf_hi(a.y) * t0[3]) + (bf_lo(a.z) * t1[0] + bf_hi(a.z) * t1[1]) + (bf_lo(a.w) * t1[2] + bf_hi(a.w) * t1[3]); }
        dd[e] = decay_of(F.inp(15)[n] + s1); al[e] = fsig(F.inp(17)[n] + s2); gg[e] = s3;
    }
    float bon;
    {
        const f32x2 ck = *(const GAS f32x2*)(F.inp(19) + c0), ca = *(const GAS f32x2*)(F.inp(20) + c0), crk = *(const GAS f32x2*)(F.inp(21) + c0);
        const float k0r = k_s[0] * ck.x, k1r = k_s[1] * ck.y; float ss = k0r * k0r + k1r * k1r;
#pragma unroll
        for (int o = 1; o < 32; o <<= 1) ss += __shfl_xor(ss, o);
        const float inv = 1.0f / fmaxf(sqrtf(ss), 1e-12f);
        const float kk0 = k0r * inv, kk1 = k1r * inv, km0 = k_s[0] * (1.0f + (al[0] - 1.0f) * ca.x), km1 = k_s[1] * (1.0f + (al[1] - 1.0f) * ca.y);
        bon = r_s[0] * km0 * crk.x + r_s[1] * km1 * crk.y;
#pragma unroll
        for (int o = 1; o < 32; o <<= 1) bon += __shfl_xor(bon, o);
        *(LAS f32x2*)(lds + SJ_KK + c0 * 4) = (f32x2){kk0, kk1}; *(LAS f32x2*)(lds + SJ_BB + c0 * 4) = (f32x2){kk0 * al[0], kk1 * al[1]}; *(LAS f32x2*)(lds + SJ_DD + c0 * 4) = (f32x2){dd[0], dd[1]};
        *(LAS f32x2*)(lds + SJ_KM + c0 * 4) = (f32x2){km0, km1}; *(LAS f32x2*)(lds + SJ_RR + c0 * 4) = (f32x2){r_s[0], r_s[1]}; *(LAS f32x2*)(lds + SJ_VV + c0 * 4) = (f32x2){v_s[0], v_s[1]};
    }
    WG_SYNC();
    {
        const int kq = lane & 15, rg = lane >> 4;
#pragma unroll 1
        for (int hh = 0; hh < 2; ++hh) {
            const int h = 2 * wave + hh;
            const f32x4 kk4 = *(const LAS f32x4*)(lds + SJ_KK + (64 * h + 4 * kq) * 4), b4 = *(const LAS f32x4*)(lds + SJ_BB + (64 * h + 4 * kq) * 4), d4 = *(const LAS f32x4*)(lds + SJ_DD + (64 * h + 4 * kq) * 4);
            const f32x4 km4 = *(const LAS f32x4*)(lds + SJ_KM + (64 * h + 4 * kq) * 4), r4 = *(const LAS f32x4*)(lds + SJ_RR + (64 * h + 4 * kq) * 4);
            const size_t sbase = ((size_t)(s * NHEAD + h) * 64) * 64;
#pragma unroll 2
            for (int ps = 0; ps < 8; ++ps) {
                const int v0 = 8 * ps + 2 * rg;
                f32x4 S0 = *(const GAS f32x4*)(F.inp(4) + sbase + (size_t)v0 * 64 + 4 * kq), S1 = *(const GAS f32x4*)(F.inp(4) + sbase + (size_t)(v0 + 1) * 64 + 4 * kq);
                const f32x2 v2 = *(const LAS f32x2*)(lds + SJ_VV + (64 * h + v0) * 4);
                float p0 = (S0[0] * kk4[0] + S0[1] * kk4[1]) + (S0[2] * kk4[2] + S0[3] * kk4[3]), p1 = (S1[0] * kk4[0] + S1[1] * kk4[1]) + (S1[2] * kk4[2] + S1[3] * kk4[3]);
                p0 = red16(p0); p1 = red16(p1);
#pragma unroll
                for (int j = 0; j < 4; ++j) { S0[j] = S0[j] * d4[j] + (v2.x * km4[j] - p0 * b4[j]); S1[j] = S1[j] * d4[j] + (v2.y * km4[j] - p1 * b4[j]); }
                float y0 = (S0[0] * r4[0] + S0[1] * r4[1]) + (S0[2] * r4[2] + S0[3] * r4[3]), y1 = (S1[0] * r4[0] + S1[1] * r4[1]) + (S1[2] * r4[2] + S1[3] * r4[3]);
                y0 = red16(y0); y1 = red16(y1);
                *(GAS f32x4*)(F.out + O_WKVS + sbase + (size_t)v0 * 64 + 4 * kq) = S0; *(GAS f32x4*)(F.out + O_WKVS + sbase + (size_t)(v0 + 1) * 64 + 4 * kq) = S1;
                if (kq == 0) *(LAS f32x2*)(lds + SJ_Y + (64 * h + v0) * 4) = (f32x2){y0, y1};
            }
        }
    }
    WG_SYNC();
    {
        const f32x2 y2 = *(const LAS f32x2*)(lds + SJ_Y + c0 * 4);
        float sm = y2.x + y2.y;
#pragma unroll
        for (int o = 1; o < 32; o <<= 1) sm += __shfl_xor(sm, o);
        const float mean = sm * (1.0f / 64.0f), d0 = y2.x - mean, d1 = y2.y - mean; float sv = d0 * d0 + d1 * d1;
#pragma unroll
        for (int o = 1; o < 32; o <<= 1) sv += __shfl_xor(sv, o);
        const float rstd = __builtin_amdgcn_rsqf(sv * (1.0f / 64.0f) + GN_EPS);
        const f32x2 gw = *(const GAS f32x2*)(F.inp(22) + c0), gb = *(const GAS f32x2*)(F.inp(23) + c0);
        const float ya0 = (d0 * rstd * gw.x + gb.x + bon * v_s[0]) * gg[0], ya1 = (d1 * rstd * gw.y + gb.y + bon * v_s[1]) * gg[1];
        const unsigned zB = *(const GAS unsigned*)(zr + 3328 + c0), zC = *(const GAS unsigned*)(zr + 4352 + c0), zU = *(const GAS unsigned*)(zr + 5376 + c0), zgA = *(const GAS unsigned*)(zr + 6400 + c0), zgB = *(const GAS unsigned*)(zr + 7424 + c0);
        const f32x2 cv0 = *(const GAS f32x2*)(F.inp(6) + (size_t)(s * 2) * D + c0), cv1 = *(const GAS f32x2*)(F.inp(6) + (size_t)(s * 2 + 1) * D + c0);
        const f32x2 w0 = *(const GAS f32x2*)(F.inp(24) + c0), w1 = *(const GAS f32x2*)(F.inp(24) + 1024 + c0), w2 = *(const GAS f32x2*)(F.inp(24) + 2048 + c0);
        const float cu0 = bf_lo(zC) * bf_lo(zU), cu1 = bf_hi(zC) * bf_hi(zU);
        const float yb0 = bf_lo(zB) * (w0.x * cv0.x + w1.x * cv1.x + w2.x * cu0), yb1 = bf_hi(zB) * (w0.y * cv0.y + w1.y * cv1.y + w2.y * cu1);
        const float m0 = fsig(bf_lo(zgA)) * ya0 + fsig(bf_lo(zgB)) * yb0, m1 = fsig(bf_hi(zgA)) * ya1 + fsig(bf_hi(zgB)) * yb1;
#if DBG_MIX
        *(GAS unsigned*)((GAS bf16*)(F.ws + WS_MIX) + (size_t)(MPR + s) * D + c0) = 0u; (void)m0; (void)m1;
#else
        *(GAS unsigned*)((GAS bf16*)(F.ws + WS_MIX) + (size_t)(MPR + s) * D + c0) = pg8::cvt_pk_bf16(m0, m1);
#endif
        *(GAS f32x2*)(F.out + O_CVS + (size_t)(s * 2) * D + c0) = cv1; *(GAS f32x2*)(F.out + O_CVS + (size_t)(s * 2 + 1) * D + c0) = (f32x2){cu0, cu1};
    }
    WG_SYNC();
}


enum StripKind { SK_SWIGLU = 0, SK_RES = 1, SK_Z = 2, SK_PP = 3, SK_PLE = 4 };
struct StripArgs { const GAS bf16* A; const GAS bf16* Wt; int K; GAS bf16* Ob; const GAS float* X; const GAS bf16* PP; float alpha; bool scale; };
template <int KIND> __device__ __forceinline__ void strip_gemm(const StripArgs& a, int mb, int pn) {
    int tid = threadIdx.x; asm volatile("" : "+v"(tid));
    const int lane = tid & 63, w = __builtin_amdgcn_readfirstlane(tid >> 6), lr = lane & 15, lq = lane >> 4;
    const int K = a.K, row = MPR + 16 * mb + lr;
    int wr0, wr1;
    if (KIND == SK_SWIGLU) { wr0 = 256 * pn + 16 * w + lr; wr1 = wr0 + 128; }
    else if (KIND == SK_Z || KIND == SK_PP) { wr0 = 256 * pn + 32 * w + 8 * (lr >> 2) + (lr & 3); wr1 = wr0 + 4; }
    else { wr0 = 256 * pn + 32 * w + lr; wr1 = wr0 + 16; }
    const GAS bf16* ap = a.A + (size_t)row * K + 8 * lq; const GAS bf16* w0p = a.Wt + (size_t)wr0 * K + 8 * lq; const GAS bf16* w1p = a.Wt + (size_t)wr1 * K + 8 * lq;
    f32x4 acc0 = (f32x4){0.f, 0.f, 0.f, 0.f}, acc1 = acc0; float ssq = 0.f;
#pragma unroll 1
    for (int ks0 = 0; ks0 < K / 32; ks0 += 8) {
        v4u av[8], b0[8], b1[8];
#pragma unroll
        for (int i = 0; i < 8; ++i) { av[i] = *(const GAS v4u*)(ap + 32 * (ks0 + i)); b0[i] = *(const GAS v4u*)(w0p + 32 * (ks0 + i)); b1[i] = *(const GAS v4u*)(w1p + 32 * (ks0 + i)); }
        __builtin_amdgcn_sched_barrier(0);
#pragma unroll
        for (int i = 0; i < 8; ++i) {
            if (KIND == SK_SWIGLU || KIND == SK_Z || KIND == SK_PLE) {
                const float x0 = bf_lo(av[i].x), x1 = bf_hi(av[i].x), x2 = bf_lo(av[i].y), x3 = bf_hi(av[i].y), x4 = bf_lo(av[i].z), x5 = bf_hi(av[i].z), x6 = bf_lo(av[i].w), x7 = bf_hi(av[i].w);
                ssq += ((x0 * x0 + x1 * x1) + (x2 * x2 + x3 * x3)) + ((x4 * x4 + x5 * x5) + (x6 * x6 + x7 * x7)); }
            const bf16x8 af = __builtin_bit_cast(bf16x8, av[i]);
            acc0 = __builtin_amdgcn_mfma_f32_16x16x32_bf16(__builtin_bit_cast(bf16x8, b0[i]), af, acc0, 0, 0, 0);
            acc1 = __builtin_amdgcn_mfma_f32_16x16x32_bf16(__builtin_bit_cast(bf16x8, b1[i]), af, acc1, 0, 0, 0);
        }
    }
    float sc = 1.0f;
    if (KIND == SK_Z || KIND == SK_PLE || (KIND == SK_SWIGLU && a.scale)) { ssq += __shfl_xor(ssq, 16); ssq += __shfl_xor(ssq, 32); sc = __builtin_amdgcn_rsqf(ssq * (1.0f / 1024.0f) + RMS_EPS); }
    if (KIND == SK_SWIGLU) {
        f32x4 v;
#pragma unroll
        for (int j = 0; j < 4; ++j) { const float g = acc0[j] * sc, u = acc1[j] * sc; v[j] = g * fsig(g) * u; }
        u32x2v o; o.x = pg8::cvt_pk_bf16(v[0], v[1]); o.y = pg8::cvt_pk_bf16(v[2], v[3]);
        *(GAS u32x2v*)(a.Ob + (size_t)row * FF + 128 * pn + 16 * w + 4 * lq) = o;
    } else if (KIND == SK_Z || KIND == SK_PP) {
        const f32x4 v0 = acc0 * sc, v1 = acc1 * sc;
        v4u o; o.x = pg8::cvt_pk_bf16(v0[0], v0[1]); o.y = pg8::cvt_pk_bf16(v0[2], v0[3]); o.z = pg8::cvt_pk_bf16(v1[0], v1[1]); o.w = pg8::cvt_pk_bf16(v1[2], v1[3]);
        if (KIND == SK_Z) *(GAS v4u*)(a.Ob + (size_t)(16 * mb + lr) * NIN + 256 * pn + 32 * w + 8 * lq) = o;
        else *(GAS v4u*)(a.Ob + (size_t)row * D + 256 * pn + 32 * w + 8 * lq) = o;
    } else {
#pragma unroll
        for (int nb = 0; nb < 2; ++nb) { const size_t off = (size_t)row * D + 256 * pn + 32 * w + 16 * nb + 4 * lq; const f32x4 ac = nb ? acc1 : acc0;
            const f32x4 xin = a.X ? *(const GAS f32x4*)(a.X + off) : unpk4(*(const GAS u32x2v*)((KIND == SK_PLE ? a.A : (const GAS bf16*)a.Ob) + off)); f32x4 xo;
            if (KIND == SK_RES) xo = xin + ac * a.alpha;
            else { const f32x4 pv = unpk4(*(const GAS u32x2v*)(a.PP + off));
#pragma unroll
                for (int j = 0; j < 4; ++j) xo[j] = xin[j] + fsig(ac[j] * sc) * pv[j]; }
            { u32x2v o; o.x = pg8::cvt_pk_bf16(xo[0], xo[1]); o.y = pg8::cvt_pk_bf16(xo[2], xo[3]); *(GAS u32x2v*)(a.Ob + off) = o; } }
    }
}
template <int KIND> __device__ __forceinline__ void strip_phase(const StripArgs& a, int ntn, int G, int c) {
    for (int s = G - 1 - c; s < 8 * ntn; s += G) strip_gemm<KIND>(a, s & 7, s >> 3);
}


template <int KIND, int KSW  > __device__ __forceinline__ void strip_gemm_sk(const StripArgs& a, LAS unsigned char* lds, int mb, int pn, int wg) {
    int tid = threadIdx.x; asm volatile("" : "+v"(tid));
    const int lane = tid & 63, w = __builtin_amdgcn_readfirstlane(tid >> 6), lr = lane & 15, lq = lane >> 4;
    const int K = a.K, row = MPR + 16 * mb + lr;
    int wr0, wr1;
    if (KIND == SK_PP) { wr0 = 256 * pn + 32 * wg + 8 * (lr >> 2) + (lr & 3); wr1 = wr0 + 4; }
    else { wr0 = 256 * pn + 32 * wg + lr; wr1 = wr0 + 16; }
    const int k0 = 32 * KSW * w + 8 * lq;
    const GAS bf16* ap = a.A + (size_t)row * K + k0; const GAS bf16* w0p = a.Wt + (size_t)wr0 * K + k0; const GAS bf16* w1p = a.Wt + (size_t)wr1 * K + k0;
    v4u av[KSW], b0[KSW], b1[KSW];
#pragma unroll
    for (int i = 0; i < KSW; ++i) { av[i] = *(const GAS v4u*)(ap + 32 * i); b0[i] = *(const GAS v4u*)(w0p + 32 * i); b1[i] = *(const GAS v4u*)(w1p + 32 * i); }
    __builtin_amdgcn_sched_barrier(0);
    f32x4 acc0 = (f32x4){0.f, 0.f, 0.f, 0.f}, acc1 = acc0; float ssq = 0.f;
#pragma unroll
    for (int i = 0; i < KSW; ++i) {
        if (KIND == SK_PLE) {
            const float x0 = bf_lo(av[i].x), x1 = bf_hi(av[i].x), x2 = bf_lo(av[i].y), x3 = bf_hi(av[i].y), x4 = bf_lo(av[i].z), x5 = bf_hi(av[i].z), x6 = bf_lo(av[i].w), x7 = bf_hi(av[i].w);
            ssq += ((x0 * x0 + x1 * x1) + (x2 * x2 + x3 * x3)) + ((x4 * x4 + x5 * x5) + (x6 * x6 + x7 * x7)); }
        const bf16x8 af = __builtin_bit_cast(bf16x8, av[i]);
        acc0 = __builtin_amdgcn_mfma_f32_16x16x32_bf16(__builtin_bit_cast(bf16x8, b0[i]), af, acc0, 0, 0, 0);
        acc1 = __builtin_amdgcn_mfma_f32_16x16x32_bf16(__builtin_bit_cast(bf16x8, b1[i]), af, acc1, 0, 0, 0);
    }
    if (KIND == SK_PLE) { ssq += __shfl_xor(ssq, 16); ssq += __shfl_xor(ssq, 32); }
    LAS unsigned char* slot = lds + (w * 64 + lane) * 48;
    *(LAS f32x4*)slot = acc0; *(LAS f32x4*)(slot + 16) = acc1; *(LAS float*)(slot + 32) = ssq;
    WG_SYNC();
    if (w == 0) {
        f32x4 s0 = (f32x4){0.f, 0.f, 0.f, 0.f}, s1 = s0; float sq = 0.f;
#pragma unroll
        for (int j = 0; j < 8; ++j) { const LAS unsigned char* p = lds + (j * 64 + lane) * 48; s0 = s0 + *(const LAS f32x4*)p; s1 = s1 + *(const LAS f32x4*)(p + 16); sq += *(const LAS float*)(p + 32); }
        const float sc = (KIND == SK_PLE) ? __builtin_amdgcn_rsqf(sq * (1.0f / 1024.0f) + RMS_EPS) : 1.0f;
        if (KIND == SK_PP) {
            v4u o; o.x = pg8::cvt_pk_bf16(s0[0], s0[1]); o.y = pg8::cvt_pk_bf16(s0[2], s0[3]); o.z = pg8::cvt_pk_bf16(s1[0], s1[1]); o.w = pg8::cvt_pk_bf16(s1[2], s1[3]);
            *(GAS v4u*)(a.Ob + (size_t)row * D + 256 * pn + 32 * wg + 8 * lq) = o;
        } else {
#pragma unroll
            for (int nb = 0; nb < 2; ++nb) { const size_t off = (size_t)row * D + 256 * pn + 32 * wg + 16 * nb + 4 * lq; const f32x4 ac = nb ? s1 : s0;
                const f32x4 xin = a.X ? *(const GAS f32x4*)(a.X + off) : unpk4(*(const GAS u32x2v*)((KIND == SK_PLE ? a.A : (const GAS bf16*)a.Ob) + off)); f32x4 xo;
                if (KIND == SK_RES) xo = xin + ac * a.alpha;
                else { const f32x4 pv = unpk4(*(const GAS u32x2v*)(a.PP + off));
#pragma unroll
                    for (int j = 0; j < 4; ++j) xo[j] = xin[j] + fsig(ac[j] * sc) * pv[j]; }
                { u32x2v o; o.x = pg8::cvt_pk_bf16(xo[0], xo[1]); o.y = pg8::cvt_pk_bf16(xo[2], xo[3]); *(GAS u32x2v*)(a.Ob + off) = o; } }
        }
    }
    WG_SYNC();
}
template <int KIND, int KSW> __device__ __forceinline__ void strip_phase_sk(const StripArgs& a, LAS unsigned char* lds, int G, int c) {
    for (int j = c; j < 256; j += G) strip_gemm_sk<KIND, KSW>(a, lds, j & 7, (j >> 3) & 3, j >> 5);
}

struct Args { const float* in[34]; float* out; unsigned char* ws; int ph_lo, ph_hi, li, pad; };
__global__ void __launch_bounds__(NWAVES * 64, 2) mk_fwd(Args args) {
    extern __shared__ __attribute__((aligned(16))) unsigned char lds[];
    Frame F;
    F.lds = (LAS unsigned char*)lds;
    F.MISC = (volatile LAS unsigned*)(F.lds + MISC_OFF);
    F.tid = threadIdx.x; F.lane = F.tid & 63; F.wave = __builtin_amdgcn_readfirstlane(F.tid >> 6);
    F.G = gridDim.x; { const int bx = blockIdx.x; F.vcu = (F.G % 8 == 0) ? (bx % 8) * (F.G / 8) + bx / 8 : bx; }
    GAS unsigned char* ws = (GAS unsigned char*)args.ws; F.ws = ws; F.out = (GAS float*)args.out;
    F.ctl = (gu32*)(ws + WS_CTL);
    for (int u = F.tid; u < (LDS_BYTES - LDSCTL_OFF) / 4; u += NWAVES * 64) ((LAS unsigned*)(F.lds + LDSCTL_OFF))[u] = 0u;
    __syncthreads();
#pragma unroll
    for (int i = 0; i < 34; ++i) if (F.tid == i) *(LAS unsigned long long*)(F.lds + PTR_OFF + 8 * i) = (unsigned long long)args.in[i];
    __syncthreads();
    XcdBarrier bar; bar.bar = (unsigned*)(F.ctl + CW_BAR); bar.x = 0; bar.st = nullptr;
    if (N_LAUNCHES == 1) bar = xcd_barrier_post((unsigned*)(F.ctl + CW_BAR), F.MISC + 8);
#define GRID_BAR() do { if (N_LAUNCHES == 1) xcd_barrier(bar); } while (0)
    const int lo = args.ph_lo, hi = args.ph_hi;
#ifndef PH_MASK
#define PH_MASK 0x3fff
#endif
#ifdef PROBE_TS_A
#define IN(k) ((((blockIdx.x == 0 && threadIdx.x == 0) ? (void)__hip_atomic_store(F.ctl + 2048 + (k), (unsigned)__builtin_amdgcn_s_memrealtime(), RLX_AGENT) : (void)0), true) && ((PH_MASK >> (k)) & 1) && lo <= (k) && (k) < hi)
#else
#define IN(k) (((PH_MASK >> (k)) & 1) && lo <= (k) && (k) < hi)
#endif
#define IN0(k) (((PH_MASK >> (k)) & 1) && lo <= (k) && (k) < hi)
#define BOTH(k) (IN0(k) && IN0((k) + 1))
    GAS bf16* const XB = (GAS bf16*)(ws + WS_XB); GAS bf16* const MIXB = (GAS bf16*)(ws + WS_MIX); GAS bf16* const GU = (GAS bf16*)(ws + WS_GU); GAS float* const SSQ = (GAS float*)(ws + WS_SSQ);
    GAS bf16* const PPB = (GAS bf16*)F.out;
    GAS bf16* const XF = (GAS bf16*)(ws + WS_GU);
#define GP(p) ((const bf16*)(p))

    if (IN(0)) { asm volatile("; MARK P0"); p0_prologue(F); if (BOTH(0)) GRID_BAR(); }
#ifndef REP_P1
#define REP_P1 1
#endif
    for (int rep = 0; rep < REP_P1; ++rep)
    if (IN(1)) { asm volatile("; MARK P1");
        pg8::Gemm g{GP(XB), GP(ws + WS_W1GU), MP, 2 * FF, D}; pg8::StaticOrder S; S.init(MP, 2 * FF, F.G, (int)blockIdx.x);
        pg8::EpiSwiglu E{GU, F.lds, false};
        pg8::gemm_phase<pg8::EpiSwiglu, pg8::StaticOrder, true, true>(F.lds + RING_OFF, g, S, E);
        if ((int)blockIdx.x >= 150) convert_group(F, 1, ((int)blockIdx.x - 150) * NWAVES + F.wave, (F.G - 150) * NWAVES);
        if (BOTH(1)) GRID_BAR();
    }
#ifndef REP_P2
#define REP_P2 1
#endif
    for (int rep = 0; rep < REP_P2; ++rep)
    if (IN(2)) { asm volatile("; MARK P2");
        pg8::Gemm g{GP(GU), GP(ws + WS_W1D), MP, D, FF}; pg8::StaticOrder S; S.init(MPR, D, F.G, (int)blockIdx.x);
        pg8::EpiRes E{F.inp(0), XB, SSQ, 0.5f};
#ifndef REP_G2
#define REP_G2 1
#endif
        for (int rg2 = 0; rg2 < REP_G2; ++rg2)
        pg8::gemm_phase<pg8::EpiRes, pg8::StaticOrder, true, true>(F.lds + RING_OFF, g, S, E);
        { const StripArgs sa{GU, (const GAS bf16*)(ws + WS_W1D), FF, XB, F.inp(1) - (size_t)MPR * D, nullptr, 0.5f, false}; strip_phase_sk<SK_RES, FF / 256>(sa, F.lds, F.G, (int)blockIdx.x); }
        if (BOTH(2)) GRID_BAR();
    }
    for (int r3 = 0; r3 < REP_P3; ++r3)
    if (IN(3)) { asm volatile("; MARK P3");
        pg8::Gemm g{GP(XB), GP(ws + WS_WIN), MP, NIN, D}; pg8::ChunkOrder S; S.init(2 * NBATCH, NIN / 256, F.G, (int)blockIdx.x, 0);
        pg8::precompute_scales(F.lds, S, SSQ, XB);
        pg8::EpiZ E{(GAS bf16*)(ws + WS_Z), F.lds, (GAS bf16*)(ws + WS_ZX), (GAS bf16*)(ws + WS_ZS)};
        pg8::gemm_phase<pg8::EpiZ, pg8::ChunkOrder, true, true>(F.lds + RING_OFF, g, S, E);
        { pg8::TailOrder T; T.init((int)blockIdx.x); WG_SYNC(); pg8::precompute_scales(F.lds, T, SSQ, XB);
          pg8::gemm_phase<pg8::EpiZ, pg8::TailOrder, true, true>(F.lds + RING_OFF, g, T, E); }
        { pg8::SampleOrder SO; SO.init((int)blockIdx.x); WG_SYNC(); pg8::precompute_scales(F.lds, SO, SSQ, XB);
          pg8::gemm_phase<pg8::EpiZ, pg8::SampleOrder, true, true>(F.lds + RING_OFF, g, SO, E); }
        if ((int)blockIdx.x >= 64) convert_group(F, 2, ((int)blockIdx.x - 64) * NWAVES + F.wave, (F.G - 64) * NWAVES);
        if (BOTH(3)) GRID_BAR();
    }
#pragma unroll 1
    for (int ch = 0; ch < NTC; ++ch) {
        if (IN(4 + ch)) { asm volatile("; MARK P4");
            const int x = (int)blockIdx.x & 7, i = (int)blockIdx.x >> 3;
            if (i < 16) { mix_job(F, x, i, ch);
#ifdef PROBE_TS_A
                if (blockIdx.x == 0 && threadIdx.x == 0) __hip_atomic_store(F.ctl + 2048 + 20 + ch, (unsigned)__builtin_amdgcn_s_memrealtime(), RLX_AGENT);
#endif
            }
            else if (ch + 1 < NTC) {
                pg8::Gemm g{GP(XB), GP(ws + WS_WIN), MP, NIN, D}; pg8::ChunkOrder S; S.init(2 * NBATCH, NIN / 256 - 1, F.G / 2, (i - 16) * 8 + x, ch + 1);
                pg8::precompute_scales(F.lds, S, SSQ, XB);
                pg8::EpiZ E{(GAS bf16*)(ws + WS_Z + (size_t)((ch + 1) & 1) * ZCH_BYTES), F.lds, (GAS bf16*)(ws + WS_ZX), (GAS bf16*)(ws + WS_ZS)};
                pg8::gemm_phase<pg8::EpiZ, pg8::ChunkOrder, true, true>(F.lds + RING_OFF, g, S, E);
#ifdef PROBE_TS_A
                if (blockIdx.x == 128 && threadIdx.x == 0) __hip_atomic_store(F.ctl + 2048 + 24 + ch, (unsigned)__builtin_amdgcn_s_memrealtime(), RLX_AGENT);
                if (blockIdx.x == 255 && threadIdx.x == 0) __hip_atomic_store(F.ctl + 2048 + 28 + ch, (unsigned)__builtin_amdgcn_s_memrealtime(), RLX_AGENT);
#endif
            } else {
                const int cg = (i - 16) * 8 + x;
                sample_job(F, 16 * x + (i - 16));
                { pg8::Gemm g{GP(ws + WS_PB), GP(ws + WS_WPP), MP, D, PLE}; pg8::StaticOrder S; S.init(MPR, D, F.G / 2, cg);
                  pg8::EpiPP E{PPB, D};
                  pg8::gemm_phase<pg8::EpiPP, pg8::StaticOrder, true, true>(F.lds + RING_OFF, g, S, E);
                  const StripArgs sa{(const GAS bf16*)(ws + WS_PB), (const GAS bf16*)(ws + WS_WPP), PLE, PPB, nullptr, nullptr, 0.f, false}; strip_phase_sk<SK_PP, PLE / 256>(sa, F.lds, F.G / 2, cg); }
                convert_group(F, 3, cg * NWAVES + F.wave, (F.G / 2) * NWAVES);
            }
            if (BOTH(4 + ch)) GRID_BAR();
        }
    }
    for (int r5 = 0; r5 < REP_P5; ++r5)
    if (IN(8)) { asm volatile("; MARK P5");
        pg8::Gemm g{GP(MIXB), GP(ws + WS_WOUT), MP, D, D}; pg8::StaticOrder S; S.init(MPR, D, F.G, (int)blockIdx.x);
        pg8::EpiRes E{nullptr, XB, SSQ, 1.0f / REP_P5};
        pg8::gemm_phase<pg8::EpiRes, pg8::StaticOrder, true, true>(F.lds + RING_OFF, g, S, E);
        { const StripArgs sa{MIXB, (const GAS bf16*)(ws + WS_WOUT), D, XB, nullptr, nullptr, 1.0f / REP_P5, false}; strip_phase_sk<SK_RES, D / 256>(sa, F.lds, F.G, (int)blockIdx.x); }
        if (BOTH(8)) GRID_BAR();
    }
    for (int r6 = 0; r6 < REP_P6; ++r6)
    if (IN(9)) { asm volatile("; MARK P6");
        pg8::Gemm g{GP(XB), GP(ws + WS_W2GU), MP, 2 * FF, D}; pg8::StaticOrder S; S.init(MP, 2 * FF, F.G, (int)blockIdx.x);
        pg8::precompute_scales(F.lds, S, SSQ, XB);
        pg8::EpiSwiglu E{GU, F.lds, true};
        pg8::gemm_phase<pg8::EpiSwiglu, pg8::StaticOrder, true, true>(F.lds + RING_OFF, g, S, E);
        if (BOTH(9)) GRID_BAR();
    }
    if (IN(10)) { asm volatile("; MARK P7");
        pg8::Gemm g{GP(GU), GP(ws + WS_W2D), MP, D, FF}; pg8::StaticOrder S; S.init(MPR, D, F.G, (int)blockIdx.x);
        pg8::EpiRes E{nullptr, XB, SSQ, 0.5f};
        pg8::gemm_phase<pg8::EpiRes, pg8::StaticOrder, true, true>(F.lds + RING_OFF, g, S, E);
        { const StripArgs sa{GU, (const GAS bf16*)(ws + WS_W2D), FF, XB, nullptr, nullptr, 0.5f, false}; strip_phase_sk<SK_RES, FF / 256>(sa, F.lds, F.G, (int)blockIdx.x); }
    }
    if (IN(11)) { if (BOTH(11)) GRID_BAR(); }
    if (IN(12)) { asm volatile("; MARK P8");
        pg8::Gemm g{GP(XB), GP(ws + WS_WPG), MP, D, D}; pg8::StaticOrder S; S.init(MPR, D, F.G, (int)blockIdx.x);
        pg8::precompute_scales(F.lds, S, SSQ, XB);
        pg8::EpiPle E{XB, XF, PPB, F.lds};
        pg8::gemm_phase<pg8::EpiPle, pg8::StaticOrder, true, true>(F.lds + RING_OFF, g, S, E);
        { const StripArgs sa{XB, (const GAS bf16*)(ws + WS_WPG), D, XF, nullptr, PPB, 0.f, true}; strip_phase_sk<SK_PLE, D / 256>(sa, F.lds, F.G, (int)blockIdx.x); }
        if (BOTH(12)) GRID_BAR();
    }
    if (IN(13)) { asm volatile("; MARK P9"); p9_final(F); }
#ifdef PROBE_TS_A
    if (blockIdx.x == 0 && threadIdx.x == 0) { __hip_atomic_store(F.ctl + 2048 + 14, (unsigned)__builtin_amdgcn_s_memrealtime(), RLX_AGENT); asm volatile("s_waitcnt vmcnt(0)" ::: "memory"); const unsigned ta = __hip_atomic_load(F.ctl + 2048 + PROBE_TS_A, RLX_AGENT), tb = __hip_atomic_load(F.ctl + 2048 + PROBE_TS_B, RLX_AGENT);
        F.out[0] += ((float)(tb - ta) * 0.01f - (float)PROBE_TS_OFF) * 0.1f; }
#endif
#undef IN
#undef IN0
#undef BOTH
}

extern "C" void kernel_launch(void* const* d_in, const int* in_sizes, int n_in, void* d_out, int out_size, void* d_ws, size_t ws_size, hipStream_t stream) {
    static int grid = 0;
    if (grid == 0) {
        if (n_in != 34 || in_sizes[0] != MPR * D || (size_t)out_size != O_END || ws_size < WS_END) { fprintf(stderr, "kernel_launch: unexpected shapes (n_in %d, in0 %d, out %d, ws %zu); nothing launched\n", n_in, n_in > 0 ? in_sizes[0] : -1, out_size, ws_size); grid = -1; return; }
        int dev = 0, cus = 0, per_cu = 0;
        if (hipGetDevice(&dev) != hipSuccess || hipDeviceGetAttribute(&cus, hipDeviceAttributeMultiprocessorCount, dev) != hipSuccess) { grid = -1; return; }
        if (hipFuncSetAttribute((const void*)mk_fwd, hipFuncAttributeMaxDynamicSharedMemorySize, LDS_BYTES) != hipSuccess) { fprintf(stderr, "kernel_launch: hipFuncSetAttribute failed\n"); grid = -1; return; }
        if (hipOccupancyMaxActiveBlocksPerMultiprocessor(&per_cu, (const void*)mk_fwd, NWAVES * 64, LDS_BYTES) != hipSuccess || per_cu < 1) { fprintf(stderr, "kernel_launch: occupancy query says %d blocks per CU\n", per_cu); (void)hipGetLastError(); grid = -1; return; }
        grid = cus;
        if (grid != 256) fprintf(stderr, "kernel_launch: note: %d CUs\n", grid);
    }
    if (grid < 0) return;
    if (hipMemsetAsync((char*)d_ws + WS_CTL, 0, CTL_ZERO_BYTES, stream) != hipSuccess) return;
    Args a{};
    for (int i = 0; i < 34; ++i) a.in[i] = (const float*)d_in[i];
    a.out = (float*)d_out; a.ws = (unsigned char*)d_ws;
    for (int li = 0; li < N_LAUNCHES; ++li) {
        a.ph_lo = (N_LAUNCHES == 1) ? 0 : li; a.ph_hi = (N_LAUNCHES == 1) ? N_PHASES : li + 1; a.li = li;
        hipLaunchKernelGGL(mk_fwd, dim3(grid), dim3(NWAVES * 64), LDS_BYTES, stream, a);
    }
}
```

```cpp
#include <hip/hip_runtime.h>
#include <cstdio>
#include <cstdint>
namespace pg8 {
#define PG8_LAS __attribute__((address_space(3)))
typedef unsigned short bf16_t;
typedef short bf16x8 __attribute__((ext_vector_type(8)));
typedef float f32x4 __attribute__((ext_vector_type(4)));
typedef unsigned u32x4 __attribute__((ext_vector_type(4)));
constexpr int BM = 256, BK = 64, HALF = 128, HTB = HALF * BK * 2  , STAGE_BYTES = 8 * HTB, NXCD = 8, WGM = 8;

__host__ __device__ __forceinline__ int lds_byte(int r, int c) { const int st = (r >> 4) * 2 + (c >> 5), rr = r & 15, cc = c & 31, ob = rr * 64 + cc * 2; return st * 1024 + (ob ^ (((ob >> 9) & 1) << 5)); }
__host__ __device__ __forceinline__ void stage_rc(int b, int& R, int& C) { const int st = b / 1024, sb = b % 1024, swz = sb ^ (((sb >> 9) & 1) << 5); R = (st >> 1) * 16 + swz / 64; C = (st & 1) * 32 + (swz % 64) / 2; }
__host__ __device__ __forceinline__ int perm32(int rho) { const int n = rho >> 4, i = rho & 15; return 8 * (i >> 2) + 4 * n + (i & 3); }

struct Unit { int pm, pn; };
struct Gemm { const bf16_t* A; const bf16_t* Bt; int M, N, K; };

struct StaticOrder {
    int nM, nN, nwg, G, c;
    __host__ __device__ void init(int M, int N, int G_, int c_) { nM = M / BM; nN = N / BM; nwg = nM * nN; G = G_; c = c_; }
    __host__ __device__ bool next(int i, Unit& u) const {
        const long L = (long)i * G + c; if (L >= nwg) return false;
        int wgid = (int)L; { const int q = nwg / NXCD, r = nwg % NXCD, xcd = wgid % NXCD, off = wgid / NXCD; wgid = (xcd < r ? xcd * (q + 1) : r * (q + 1) + (xcd - r) * q) + off; }
        const int nig = WGM * nN, gid = wgid / nig, fm = gid * WGM, gsz = (nM - fm) < WGM ? (nM - fm) : WGM;
        u.pm = fm + ((wgid % nig) % gsz); u.pn = (wgid % nig) / gsz; return true;
    }
    __device__ __forceinline__ void a_ready(const Unit&) const {}
    __device__ __forceinline__ void done(const Unit&) const {}
};


#define PG8_GAS __attribute__((address_space(1)))
constexpr int MP = 16640;
constexpr int MV = 16512;
constexpr int MPR = 16384;
constexpr int PM_LAST = 64;
constexpr int DM = 1024, FFN = 2816, NINC = 8448, SHC = 3328;
constexpr size_t O_SHP = 17432576, O_SHS = 25864192;

struct ChunkOrder {
    int nM, nN, nwg, G, c, chunk;
    __host__ __device__ void init(int nM_, int nN_, int G_, int c_, int chunk_) { nM = nM_; nN = nN_; nwg = nM * nN; G = G_; c = c_; chunk = chunk_; }
    __host__ __device__ bool next(int i, Unit& u) const {
        const long L = (long)i * G + c; if (L >= nwg) return false;
        int wgid = (int)L; { const int q = nwg / NXCD, r = nwg % NXCD, xcd = wgid % NXCD, off = wgid / NXCD; wgid = (xcd < r ? xcd * (q + 1) : r * (q + 1) + (xcd - r) * q) + off; }
        const int nig = WGM * nN, gid = wgid / nig, fm = gid * WGM, gsz = (nM - fm) < WGM ? (nM - fm) : WGM;
        const int lm = fm + ((wgid % nig) % gsz); u.pn = (wgid % nig) / gsz;
        u.pm = 8 * (lm >> 1) + 2 * chunk + (lm & 1); return true;
    }
    __device__ __forceinline__ void a_ready(const Unit&) const {}
    __device__ __forceinline__ void done(const Unit&) const {}
};

struct TailOrder {
    int c;
    __host__ __device__ void init(int c_) { c = c_; }
    __host__ __device__ bool next(int i, Unit& u) const {
        if (i > 0 || c < 16 || c >= 64) return false;
        const int L = c - 16, ch = 1 + (L >> 4), lm = L & 15; u.pn = 32; u.pm = 8 * (lm >> 1) + 2 * ch + (lm & 1); return true;
    }
    __device__ __forceinline__ void a_ready(const Unit&) const {}
    __device__ __forceinline__ void done(const Unit&) const {}
};

struct SampleOrder {
    int c;
    __host__ __device__ void init(int c_) { c = c_; }
    __host__ __device__ bool next(int i, Unit& u) const { if (i > 0 || c < 64 || c >= 64 + 33) return false; u.pm = PM_LAST; u.pn = c - 64; return true; }
    __device__ __forceinline__ void a_ready(const Unit&) const {}
    __device__ __forceinline__ void done(const Unit&) const {}
};

struct FirstWinOrder {
    ChunkOrder S; TailOrder T; SampleOrder P; int nmain;
    __host__ __device__ void init(int G_, int c_) { S.init(16, 33, G_, c_, 0); T.init(c_); P.init(c_); nmain = (16 * 33 - c_ + G_ - 1) / G_; }
    __host__ __device__ bool next(int i, Unit& u) const { if (i < nmain) return S.next(i, u); if (i > nmain) return false; return T.next(0, u) || P.next(0, u); }
    __device__ __forceinline__ void a_ready(const Unit&) const {}
    __device__ __forceinline__ void done(const Unit&) const {}
};

typedef __bf16 bf16x2_t __attribute__((ext_vector_type(2)));
__device__ __forceinline__ unsigned cvt_pk_bf16(float lo, float hi) { bf16x2_t v; v[0] = (__bf16)lo; v[1] = (__bf16)hi; return __builtin_bit_cast(unsigned, v); }
typedef unsigned u32x2 __attribute__((ext_vector_type(2)));
__device__ __forceinline__ float fsigmoid(float x) { return __builtin_amdgcn_rcpf(1.0f + __expf(-x)); }

constexpr int SCL_MAP_OFF = 131072, SCL_TAB_OFF = 131584, SCL_MAX_UNITS = 12;
template <class Sched> __device__ __forceinline__ void precompute_scales(PG8_LAS unsigned char* lds, const Sched& S, const PG8_GAS float* ssq, const PG8_GAS bf16_t* xb) {
    int t = threadIdx.x; asm volatile("" : "+v"(t));
    const int row = t >> 1, half = t & 1;
    Unit u;
    for (int i = 0; i < SCL_MAX_UNITS && S.next(i, u); ++i) {
        if (u.pm == PM_LAST) {
            const int r4 = t >> 2, q4 = t & 3; const PG8_GAS u32x4* xr = (const PG8_GAS u32x4*)(xb + (size_t)(PM_LAST * BM + r4) * DM + q4 * 256);
            float p = 0.f;
#pragma unroll 4
            for (int j = 0; j < 32; ++j) { const u32x4 w = xr[j]; const unsigned ws_[4] = {w.x, w.y, w.z, w.w};
#pragma unroll
                for (int e2 = 0; e2 < 4; ++e2) { const float a = __uint_as_float(ws_[e2] << 16), b = __uint_as_float(ws_[e2] & 0xffff0000u); p += a * a + b * b; } }
            p += __shfl_xor(p, 1); p += __shfl_xor(p, 2);
            if (q4 == 0) *(PG8_LAS float*)(lds + SCL_TAB_OFF + (i * 256 + r4) * 4) = __builtin_amdgcn_rsqf(p * (1.0f / 1024.0f) + 1e-6f);
            if (t == 0) *(PG8_LAS int*)(lds + SCL_MAP_OFF + u.pm * 4) = i;
            continue;
        }
        const PG8_GAS float* q = ssq + (size_t)(8 * half) * MP + (u.pm * BM + row);
        float p = ((q[0] + q[MP]) + (q[2 * MP] + q[3 * MP])) + ((q[4 * (size_t)MP] + q[5 * (size_t)MP]) + (q[6 * (size_t)MP] + q[7 * (size_t)MP]));
        p += __shfl_xor(p, 1);
        if (half == 0) *(PG8_LAS float*)(lds + SCL_TAB_OFF + (i * 256 + row) * 4) = __builtin_amdgcn_rsqf(p * (1.0f / 1024.0f) + 1e-6f);
        if (t == 0) *(PG8_LAS int*)(lds + SCL_MAP_OFF + u.pm * 4) = i;
    }
    asm volatile("s_waitcnt lgkmcnt(0)" ::: "memory"); __builtin_amdgcn_s_barrier(); asm volatile("" ::: "memory");
}
__device__ __forceinline__ void row_scales(const PG8_LAS unsigned char* lds, int pm, int wr, int fr, float (&sc)[2][4]) {
    const int slot = *(const PG8_LAS int*)(lds + SCL_MAP_OFF + pm * 4);
    const PG8_LAS float* tb = (const PG8_LAS float*)(lds + SCL_TAB_OFF) + slot * 256 + wr * 64 + fr;
#pragma unroll
    for (int ai = 0; ai < 2; ++ai)
#pragma unroll
        for (int m = 0; m < 4; ++m) sc[ai][m] = tb[ai * HALF + m * 16];
}

struct EpiSwiglu {
    static constexpr bool PERM = true, AFTER_DRAIN = false;
    PG8_GAS bf16_t* O; const PG8_LAS unsigned char* sl; bool scaled;
    __device__ __forceinline__ void operator()(const f32x4 (&acc)[2][2][4][2], const Unit& u, int wr, int wc, int fr, int fq) const {
        float sc[2][4];
        if (scaled) row_scales(sl, u.pm, wr, fr, sc);
        else {
#pragma unroll
            for (int ai = 0; ai < 2; ++ai)
#pragma unroll
                for (int m = 0; m < 4; ++m) sc[ai][m] = 1.0f; }
        const int col0 = u.pn * HALF + wc * 32 + 8 * fq;
#pragma unroll
        for (int ai = 0; ai < 2; ++ai) {
            if (u.pm == PM_LAST && ai == 1) break;
#pragma unroll
            for (int m = 0; m < 4; ++m) {
                const int row = u.pm * BM + ai * HALF + wr * 64 + m * 16 + fr; const float s = sc[ai][m];
                const f32x4 g0 = acc[ai][0][m][0] * s, g1 = acc[ai][0][m][1] * s, u0 = acc[ai][1][m][0] * s, u1 = acc[ai][1][m][1] * s;
                f32x4 v0, v1;
#pragma unroll
                for (int j = 0; j < 4; ++j) { v0[j] = g0[j] * fsigmoid(g0[j]) * u0[j]; v1[j] = g1[j] * fsigmoid(g1[j]) * u1[j]; }
                u32x4 w; w.x = cvt_pk_bf16(v0[0], v0[1]); w.y = cvt_pk_bf16(v0[2], v0[3]); w.z = cvt_pk_bf16(v1[0], v1[1]); w.w = cvt_pk_bf16(v1[2], v1[3]);
                *(PG8_GAS u32x4*)(O + (size_t)row * FFN + col0) = w; }
        }
    }
};

struct EpiRes {
    static constexpr bool PERM = true, AFTER_DRAIN = false;
    const PG8_GAS float* inF; PG8_GAS bf16_t* XB; PG8_GAS float* ssq; float alpha;
    __device__ __forceinline__ void operator()(const f32x4 (&acc)[2][2][4][2], const Unit& u, int wr, int wc, int fr, int fq) const {
        const int col0 = u.pn * BM + wc * 32 + 8 * fq;
#pragma unroll
        for (int ai = 0; ai < 2; ++ai) {
#pragma unroll
            for (int m = 0; m < 4; ++m) {
                const int row = u.pm * BM + ai * HALF + wr * 64 + m * 16 + fr; const size_t off = (size_t)row * DM + col0;
                f32x4 xin[2][2];
                if (inF) {
#pragma unroll
                    for (int bj = 0; bj < 2; ++bj) { xin[bj][0] = *(const PG8_GAS f32x4*)(inF + off + bj * HALF); xin[bj][1] = *(const PG8_GAS f32x4*)(inF + off + bj * HALF + 4); }
                } else {
#pragma unroll
                    for (int bj = 0; bj < 2; ++bj) { const u32x4 p = *(const PG8_GAS u32x4*)(XB + off + bj * HALF);
                        xin[bj][0][0] = __uint_as_float(p.x << 16); xin[bj][0][1] = __uint_as_float(p.x & 0xffff0000u); xin[bj][0][2] = __uint_as_float(p.y << 16); xin[bj][0][3] = __uint_as_float(p.y & 0xffff0000u);
                        xin[bj][1][0] = __uint_as_float(p.z << 16); xin[bj][1][1] = __uint_as_float(p.z & 0xffff0000u); xin[bj][1][2] = __uint_as_float(p.w << 16); xin[bj][1][3] = __uint_as_float(p.w & 0xffff0000u); }
                }
                float q = 0.f;
#pragma unroll
                for (int bj = 0; bj < 2; ++bj) { const f32x4 x0 = xin[bj][0] + acc[ai][bj][m][0] * alpha, x1 = xin[bj][1] + acc[ai][bj][m][1] * alpha;
                    u32x4 w; w.x = cvt_pk_bf16(x0[0], x0[1]); w.y = cvt_pk_bf16(x0[2], x0[3]); w.z = cvt_pk_bf16(x1[0], x1[1]); w.w = cvt_pk_bf16(x1[2], x1[3]);
                    *(PG8_GAS u32x4*)(XB + off + bj * HALF) = w;
                    q += ((x0[0] * x0[0] + x0[1] * x0[1]) + (x0[2] * x0[2] + x0[3] * x0[3])) + ((x1[0] * x1[0] + x1[1] * x1[1]) + (x1[2] * x1[2] + x1[3] * x1[3])); }
                q += __shfl_xor(q, 16); q += __shfl_xor(q, 32);
                if (fq == 0) ssq[(size_t)(4 * u.pn + wc) * MP + row] = q;
                if (m & 1) asm volatile("" ::: "memory"); }
        }
    }
};

struct EpiZ {
    static constexpr bool PERM = true, AFTER_DRAIN = false;
    PG8_GAS bf16_t* Z; const PG8_LAS unsigned char* sl; PG8_GAS bf16_t* ZX; PG8_GAS bf16_t* ZS;
    __device__ __forceinline__ void operator()(const f32x4 (&acc)[2][2][4][2], const Unit& u, int wr, int wc, int fr, int fq) const {
        float sc[2][4]; row_scales(sl, u.pm, wr, fr, sc);
        const int lm = 2 * (u.pm >> 3) + (u.pm & 1);
        const int col0 = u.pn * BM + wc * 32 + 8 * fq;
#pragma unroll
        for (int ai = 0; ai < 2; ++ai) {
            if (u.pm == PM_LAST && ai == 1) break;
#pragma unroll
            for (int m = 0; m < 4; ++m) {
                const int rt = ai * HALF + wr * 64 + m * 16 + fr, lrow = lm * BM + rt; const float s = sc[ai][m];
                PG8_GAS bf16_t* zp = (u.pm == PM_LAST) ? ZS + (size_t)rt * NINC + col0 : ((u.pn == 32) ? ZX + ((size_t)(((u.pm & 7) >> 1) * 16 * BM + lrow) * 256 + wc * 32 + 8 * fq) : Z + (size_t)lrow * NINC + col0);
#pragma unroll
                for (int bj = 0; bj < 2; ++bj) { const f32x4 v0 = acc[ai][bj][m][0] * s, v1 = acc[ai][bj][m][1] * s;
                    u32x4 w; w.x = cvt_pk_bf16(v0[0], v0[1]); w.y = cvt_pk_bf16(v0[2], v0[3]); w.z = cvt_pk_bf16(v1[0], v1[1]); w.w = cvt_pk_bf16(v1[2], v1[3]);
                    *(PG8_GAS u32x4*)(zp + bj * HALF) = w; }
            }
        }
    }
};

struct EpiPP {
    static constexpr bool PERM = true, AFTER_DRAIN = false;
    PG8_GAS bf16_t* O; int ldc;
    __device__ __forceinline__ void operator()(const f32x4 (&acc)[2][2][4][2], const Unit& u, int wr, int wc, int fr, int fq) const {
        const int col0 = u.pn * BM + wc * 32 + 8 * fq;
#pragma unroll
        for (int ai = 0; ai < 2; ++ai)
#pragma unroll
            for (int m = 0; m < 4; ++m) { PG8_GAS bf16_t* rowp = O + (size_t)(u.pm * BM + ai * HALF + wr * 64 + m * 16 + fr) * ldc + col0;
#pragma unroll
                for (int bj = 0; bj < 2; ++bj) { const f32x4 v0 = acc[ai][bj][m][0], v1 = acc[ai][bj][m][1];
                    u32x4 w; w.x = cvt_pk_bf16(v0[0], v0[1]); w.y = cvt_pk_bf16(v0[2], v0[3]); w.z = cvt_pk_bf16(v1[0], v1[1]); w.w = cvt_pk_bf16(v1[2], v1[3]);
                    *(PG8_GAS u32x4*)(rowp + bj * HALF) = w; } }
    }
};

struct EpiPle {
    static constexpr bool PERM = true, AFTER_DRAIN = false;
    const PG8_GAS bf16_t* XB; PG8_GAS bf16_t* XF; const PG8_GAS bf16_t* PP; const PG8_LAS unsigned char* sl;
    __device__ __forceinline__ void operator()(const f32x4 (&acc)[2][2][4][2], const Unit& u, int wr, int wc, int fr, int fq) const {
        float sc[2][4]; row_scales(sl, u.pm, wr, fr, sc);
        const int col0 = u.pn * BM + wc * 32 + 8 * fq;
#pragma unroll
        for (int ai = 0; ai < 2; ++ai) {
#pragma unroll
            for (int m = 0; m < 4; ++m) {
                const int row = u.pm * BM + ai * HALF + wr * 64 + m * 16 + fr; const size_t off = (size_t)row * DM + col0; const float s = sc[ai][m];
                u32x4 xr[2], pr[2];
#pragma unroll
                for (int bj = 0; bj < 2; ++bj) { xr[bj] = *(const PG8_GAS u32x4*)(XB + off + bj * HALF); pr[bj] = *(const PG8_GAS u32x4*)(PP + off + bj * HALF); }
#pragma unroll
                for (int bj = 0; bj < 2; ++bj) {
                    const unsigned xs[4] = {xr[bj].x, xr[bj].y, xr[bj].z, xr[bj].w}, ps[4] = {pr[bj].x, pr[bj].y, pr[bj].z, pr[bj].w};
                    unsigned o[4];
#pragma unroll
                    for (int j = 0; j < 4; ++j) { const float a0 = acc[ai][bj][m][j >> 1][2 * (j & 1)] * s, a1 = acc[ai][bj][m][j >> 1][2 * (j & 1) + 1] * s;
                        const float y0 = __uint_as_float(xs[j] << 16) + fsigmoid(a0) * __uint_as_float(ps[j] << 16), y1 = __uint_as_float(xs[j] & 0xffff0000u) + fsigmoid(a1) * __uint_as_float(ps[j] & 0xffff0000u);
                        o[j] = cvt_pk_bf16(y0, y1); }
                    u32x4 w; w.x = o[0]; w.y = o[1]; w.z = o[2]; w.w = o[3];
                    *(PG8_GAS u32x4*)(XF + off + bj * HALF) = w; }
                if (m & 1) asm volatile("" ::: "memory"); }
        }
    }
};

template <class Epi, class Sched, bool ALIGN_EPI = false, bool SP2 = false>
__device__ __forceinline__ void gemm_phase(PG8_LAS unsigned char* lds, const Gemm g, const Sched& S, const Epi& E) {
    int tid_ = threadIdx.x; asm volatile("" : "+v"(tid_));
    const int tid = tid_, wid = __builtin_amdgcn_readfirstlane(tid >> 6), lane = tid & 63, wr = wid >> 2, wc = wid & 3, fr = lane & 15, fq = lane >> 4;
    const int K = g.K, nt = K / BK;
    unsigned voffA[2], voffB[2];
#pragma unroll
    for (int i = 0; i < 2; ++i) { int R, C; stage_rc(tid * 16 + i * 8192, R, C); const int Rb = Epi::PERM ? ((R & ~31) + perm32(R & 31)) : R;
        voffA[i] = (unsigned)(R * K + C) * 2u; voffB[i] = (unsigned)(Rb * K + C) * 2u; }
    const size_t kstep = (size_t)(BK * 2);
    const size_t hstep = (size_t)HALF * K * 2;
    const size_t tstep = 2 * hstep;
    const unsigned ldsw = (unsigned)wid * 1024u;
    const int aoff = lds_byte(wr * 64 + fr, fq * 8), boff = lds_byte(wc * 32 + fr, fq * 8);
#define PG8_SA(b, h) (((b) * 2 + (h)) * HTB)
#define PG8_SB(b, h) ((4 + (b) * 2 + (h)) * HTB)
#define PG8_STAGE(bufoff, gbase, voff) do { _Pragma("unroll") for (int _i = 0; _i < 2; ++_i) \
        __builtin_amdgcn_global_load_lds((const unsigned*)((const char*)(gbase) + (voff)[_i]), (PG8_LAS unsigned*)(lds + (bufoff) + ldsw + _i * 8192), 16, 0, 0); } while (0)
#define PG8_LDA(dst, b, h) do { _Pragma("unroll") for (int m = 0; m < 4; ++m) _Pragma("unroll") for (int k = 0; k < 2; ++k) dst[m][k] = *(const PG8_LAS bf16x8*)(lds + PG8_SA(b, h) + aoff + m * 2048 + k * 1024); } while (0)
#define PG8_LDB(dst, b, h) do { _Pragma("unroll") for (int n = 0; n < 2; ++n) _Pragma("unroll") for (int k = 0; k < 2; ++k) dst[n][k] = *(const PG8_LAS bf16x8*)(lds + PG8_SB(b, h) + boff + n * 2048 + k * 1024); } while (0)
#define PG8_MMA(ai, bj, At, Bt) do { __builtin_amdgcn_s_setprio(1); _Pragma("unroll") for (int m = 0; m < 4; ++m) _Pragma("unroll") for (int n = 0; n < 2; ++n) _Pragma("unroll") for (int k = 0; k < 2; ++k) \
        acc[ai][bj][m][n] = __builtin_amdgcn_mfma_f32_16x16x32_bf16(Bt[n][k], At[m][k], acc[ai][bj][m][n], 0, 0, 0); __builtin_amdgcn_s_setprio(0); } while (0)
#define PG8_WAIT_V(n) asm volatile("s_waitcnt vmcnt(" #n ")" ::: "memory")
#define PG8_WAIT_L(n) asm volatile("s_waitcnt lgkmcnt(" #n ")" ::: "memory")
#define PG8_BAR __builtin_amdgcn_s_barrier()
#define PG8_SCHED __builtin_amdgcn_sched_barrier(0)
    Unit cur, nxt; int ui = 0;
    if (!S.next(0, cur)) return;
    f32x4 acc[2][2][4][2];
#pragma unroll
    for (int a = 0; a < 2; ++a)
#pragma unroll
        for (int b = 0; b < 2; ++b)
#pragma unroll
            for (int m = 0; m < 4; ++m)
#pragma unroll
                for (int n = 0; n < 2; ++n) acc[a][b][m][n] = (f32x4){0.f, 0.f, 0.f, 0.f};
    bf16x8 At[4][2], B0[2][2], B1[2][2];
    const char* cA = (const char*)g.A + (size_t)cur.pm * tstep; const char* cB = (const char*)g.Bt + (size_t)cur.pn * tstep;
    S.a_ready(cur);
    if constexpr (SP2) {
        PG8_STAGE(PG8_SB(0, 0), cB, voffB); PG8_STAGE(PG8_SB(0, 1), cB + hstep, voffB); PG8_STAGE(PG8_SA(0, 0), cA, voffA); PG8_STAGE(PG8_SA(0, 1), cA + hstep, voffA);
        if (wr == 1) PG8_BAR;
        PG8_WAIT_V(2); PG8_BAR;
        PG8_STAGE(PG8_SB(1, 0), cB + kstep, voffB); PG8_STAGE(PG8_SA(1, 0), cA + kstep, voffA); PG8_STAGE(PG8_SB(1, 1), cB + hstep + kstep, voffB);
        PG8_WAIT_V(6); PG8_BAR;
    } else {
        PG8_STAGE(PG8_SB(0, 0), cB, voffB); PG8_STAGE(PG8_SA(0, 0), cA, voffA); PG8_STAGE(PG8_SB(0, 1), cB + hstep, voffB); PG8_STAGE(PG8_SA(0, 1), cA + hstep, voffA);
        if (wr == 1) PG8_BAR;
        PG8_WAIT_V(4); PG8_BAR;
        PG8_STAGE(PG8_SB(1, 0), cB + kstep, voffB); PG8_STAGE(PG8_SA(1, 0), cA + kstep, voffA); PG8_STAGE(PG8_SB(1, 1), cB + hstep + kstep, voffB);
        PG8_WAIT_V(6); PG8_BAR;
    }
    for (;;) {
        const bool has_next = S.next(ui + 1, nxt);
        const bool full_a = (cur.pm != PM_LAST);
        const char* nA = has_next ? (const char*)g.A + (size_t)nxt.pm * tstep : cA; const char* nB = has_next ? (const char*)g.Bt + (size_t)nxt.pn * tstep : cB;
#pragma unroll 1
        for (int t = 0; t < nt; t += 2) {
            const bool last = (t == nt - 2);
            const char* a1 = cA + (size_t)(t + 1) * kstep;
            const char* a2 = last ? nA : cA + (size_t)(t + 2) * kstep; const char* b2 = last ? nB : cB + (size_t)(t + 2) * kstep;
            const char* a3 = a2 + kstep; const char* b3 = b2 + kstep;
            if (last && has_next) S.a_ready(nxt);
            if constexpr (SP2) {
            PG8_LDB(B0, 0, 0); PG8_LDB(B1, 0, 1); PG8_SCHED; PG8_LDA(At, 0, 0); PG8_STAGE(PG8_SA(1, 1), a1 + hstep, voffA);
            PG8_WAIT_V(8); PG8_WAIT_L(0); PG8_BAR; PG8_MMA(0, 0, At, B0); PG8_MMA(0, 1, At, B1); PG8_BAR; PG8_SCHED;
            PG8_LDA(At, 0, 1); PG8_STAGE(PG8_SB(0, 0), b2, voffB); PG8_STAGE(PG8_SB(0, 1), b2 + hstep, voffB); PG8_STAGE(PG8_SA(0, 0), a2, voffA);
            PG8_WAIT_V(8); PG8_WAIT_L(0); PG8_BAR; if (full_a) { PG8_MMA(1, 0, At, B0); PG8_MMA(1, 1, At, B1); } PG8_BAR; PG8_SCHED;
            PG8_LDB(B0, 1, 0); PG8_LDB(B1, 1, 1); PG8_SCHED; PG8_LDA(At, 1, 0); PG8_STAGE(PG8_SA(0, 1), a2 + hstep, voffA);
            PG8_WAIT_V(8); PG8_WAIT_L(0); PG8_BAR; PG8_MMA(0, 0, At, B0); PG8_MMA(0, 1, At, B1); PG8_BAR; PG8_SCHED;
            PG8_LDA(At, 1, 1); PG8_STAGE(PG8_SB(1, 0), b3, voffB); PG8_STAGE(PG8_SB(1, 1), b3 + hstep, voffB); PG8_STAGE(PG8_SA(1, 0), a3, voffA);
            PG8_WAIT_V(8); PG8_WAIT_L(0); PG8_BAR; if (full_a) { PG8_MMA(1, 0, At, B0); PG8_MMA(1, 1, At, B1); } PG8_BAR; PG8_SCHED;
            } else {
            PG8_LDB(B0, 0, 0); PG8_SCHED; PG8_LDA(At, 0, 0); PG8_STAGE(PG8_SA(1, 1), a1 + hstep, voffA);
            PG8_WAIT_L(8); PG8_BAR; PG8_WAIT_L(0); PG8_MMA(0, 0, At, B0); PG8_BAR; PG8_SCHED;
            PG8_LDB(B1, 0, 1); PG8_STAGE(PG8_SB(0, 0), b2, voffB);
            PG8_BAR; PG8_WAIT_L(0); PG8_MMA(0, 1, At, B1); PG8_BAR;
            PG8_LDA(At, 0, 1); PG8_STAGE(PG8_SA(0, 0), a2, voffA);
            PG8_BAR; PG8_WAIT_L(0); PG8_MMA(1, 0, At, B0); PG8_BAR; PG8_SCHED;
            PG8_STAGE(PG8_SB(0, 1), b2 + hstep, voffB);
            PG8_WAIT_V(6); PG8_BAR; PG8_MMA(1, 1, At, B1); PG8_BAR;
            PG8_LDB(B0, 1, 0); PG8_SCHED; PG8_LDA(At, 1, 0); PG8_STAGE(PG8_SA(0, 1), a2 + hstep, voffA);
            PG8_WAIT_L(8); PG8_BAR; PG8_WAIT_L(0); PG8_MMA(0, 0, At, B0); PG8_BAR; PG8_SCHED;
            PG8_LDB(B1, 1, 1); PG8_STAGE(PG8_SB(1, 0), b3, voffB);
            PG8_BAR; PG8_WAIT_L(0); PG8_MMA(0, 1, At, B1); PG8_BAR;
            PG8_LDA(At, 1, 1); PG8_STAGE(PG8_SA(1, 0), a3, voffA);
            PG8_BAR; PG8_WAIT_L(0); PG8_MMA(1, 0, At, B0); PG8_BAR; PG8_SCHED;
            PG8_STAGE(PG8_SB(1, 1), b3 + hstep, voffB);
            PG8_WAIT_V(6); PG8_BAR; PG8_MMA(1, 1, At, B1); PG8_BAR;
            }
        }
        if constexpr (ALIGN_EPI) { if (wr == 0) PG8_BAR; }
        if constexpr (!Epi::AFTER_DRAIN) { E(acc, cur, wr, wc, fr, fq); S.done(cur); }
        if (!has_next) break;
#pragma unroll
        for (int a = 0; a < 2; ++a)
#pragma unroll
            for (int b = 0; b < 2; ++b)
#pragma unroll
                for (int m = 0; m < 4; ++m)
#pragma unroll
                    for (int n = 0; n < 2; ++n) acc[a][b][m][n] = (f32x4){0.f, 0.f, 0.f, 0.f};
        cur = nxt; cA = nA; cB = nB; ++ui;
        if constexpr (ALIGN_EPI) { if (wr == 1) PG8_BAR; }
    }
    PG8_WAIT_V(0);
    if constexpr (!ALIGN_EPI) { if (wr == 0) PG8_BAR; }
    PG8_BAR;
    if constexpr (Epi::AFTER_DRAIN) { E.fused(acc, cur, wr, wc, fr, fq, lds, wid, lane); S.done(cur); }
#undef PG8_SA
#undef PG8_SB
#undef PG8_STAGE
#undef PG8_LDA
#undef PG8_LDB
#undef PG8_MMA
#undef PG8_WAIT_V
#undef PG8_WAIT_L
#undef PG8_BAR
#undef PG8_SCHED
}
}
#define GAS __attribute__((address_space(1)))
#define LAS __attribute__((address_space(3)))
typedef unsigned short bf16;
typedef unsigned v4u __attribute__((ext_vector_type(4)));
typedef float f32x4 __attribute__((ext_vector_type(4)));
typedef short bf16x8 __attribute__((ext_vector_type(8)));
typedef GAS unsigned gu32;
typedef GAS unsigned long long gu64;
#define RLX_AGENT __ATOMIC_RELAXED, __HIP_MEMORY_SCOPE_AGENT
#define LDS_WAIT() asm volatile("s_waitcnt lgkmcnt(0)" ::: "memory")
#define VM_WAIT() asm volatile("s_waitcnt vmcnt(0)" ::: "memory")
__device__ __forceinline__ unsigned long long rt() { return __builtin_amdgcn_s_memrealtime(); }
__device__ __forceinline__ unsigned f2bf(float f) { unsigned u = __builtin_bit_cast(unsigned, f); return (u + 0x7fffu + ((u >> 16) & 1u)) >> 16; }
__device__ __forceinline__ unsigned pk2(float lo, float hi) { return f2bf(lo) | (f2bf(hi) << 16); }

#define XB_TMO      128
#define XB_XCNT(j)  (256  + 64 * (j))
#define XB_XSUB(j)  (1280 + 64 * (j))
#define XB_XGEN(j)  (2304 + 64 * (j))
#define XB_TOP      3328
#define XB_TOPGEN   3392
#define XCD_BAR_WORDS 3456
#define XB_SPIN_CAP (1u << 18)

__device__ __forceinline__ unsigned xb_ld(unsigned* p)              { return __hip_atomic_load(p, __ATOMIC_RELAXED, __HIP_MEMORY_SCOPE_AGENT); }
__device__ __forceinline__ unsigned xb_add(unsigned* p, unsigned v) { return __hip_atomic_fetch_add(p, v, __ATOMIC_RELAXED, __HIP_MEMORY_SCOPE_AGENT); }
__device__ __forceinline__ unsigned xb_xcc_id() { return (unsigned)__builtin_amdgcn_s_getreg((3 << 11) | 20) & 0xFu; }
#define XB_SPIN(cond, bar) do { unsigned _sp = 0; while (cond) { __builtin_amdgcn_s_sleep(1); \
    if ((++_sp & 255u) == 0u) { if (xb_ld(&(bar)[XB_TMO])) break; if (_sp > XB_SPIN_CAP) { atomicAdd(&(bar)[XB_TMO], 1u); break; } } } } while (0)

struct XcdBarrier {
    unsigned* bar; unsigned x;
    volatile LAS unsigned* st;
};

__device__ __forceinline__ XcdBarrier xcd_barrier_post(unsigned* bar, volatile LAS unsigned* st) {
    XcdBarrier b; b.bar = bar; b.x = xb_xcc_id(); b.st = st;
    if (threadIdx.x == 0) (void)xb_add(&bar[XB_XCNT(b.x)], 1u);
    return b;
}
__device__ __forceinline__ void xcd_barrier_complete(unsigned* bar, unsigned x, unsigned& nloc, unsigned& nx) {
    const unsigned G = gridDim.x * gridDim.y * gridDim.z;
    unsigned sum, cnt, mine, sp = 0u;
    for (;;) {
        sum = 0u; cnt = 0u; mine = 0u;
#pragma unroll
        for (unsigned j = 0; j < 16; ++j) { const unsigned c = xb_ld(&bar[XB_XCNT(j)]); sum += c; cnt += (c > 0u) ? 1u : 0u; mine = (j == x) ? c : mine; }
        if (sum == G) break;
        __builtin_amdgcn_s_sleep(1);
        if ((++sp & 255u) == 0u) { if (xb_ld(&bar[XB_TMO])) break; if (sp > XB_SPIN_CAP) { atomicAdd(&bar[XB_TMO], 1u); break; } }
    }
    nloc = mine > 0u ? mine : 1u; nx = cnt > 0u ? cnt : 1u;
}

__device__ __forceinline__ void xcd_barrier(const XcdBarrier& b) {
    asm volatile("s_waitcnt vmcnt(0)" ::: "memory");
    __syncthreads();
    if (threadIdx.x == 0) {
        unsigned* bar = b.bar;
        __builtin_amdgcn_s_waitcnt(0);
        unsigned nloc = b.st[0], nx = b.st[1];
        if (nloc == 0u) { xcd_barrier_complete(bar, b.x, nloc, nx); b.st[0] = nloc; b.st[1] = nx; }
        const unsigned old = xb_add(&bar[XB_XSUB(b.x)], 1u);
        const unsigned gen = old / nloc;
        if (old + 1u == (gen + 1u) * nloc) {
            __builtin_amdgcn_fence(__ATOMIC_RELEASE, "agent");
            asm volatile("s_waitcnt vmcnt(0)" ::: "memory");
            const unsigned og = xb_add(&bar[XB_TOP], 1u);
            const unsigned tg = og / nx;
            if (og + 1u == (tg + 1u) * nx) xb_add(&bar[XB_TOPGEN], 1u);
            else XB_SPIN(xb_ld(&bar[XB_TOPGEN]) == tg, bar);
            __builtin_amdgcn_fence(__ATOMIC_ACQUIRE, "agent");
            xb_add(&bar[XB_XGEN(b.x)], 1u);
            asm volatile("s_waitcnt vmcnt(0)" ::: "memory");
        } else {
            XB_SPIN(xb_ld(&bar[XB_XGEN(b.x)]) == gen, bar);
            __builtin_amdgcn_fence(__ATOMIC_ACQUIRE, "agent");
            asm volatile("s_waitcnt vmcnt(0)" ::: "memory");
        }
    }
    __syncthreads();
}


constexpr int NWAVES = 8;
#ifndef REP_P5
#define REP_P5 1
#define REP_P6 1
#define REP_P3 1
#define REP_P8A 1
#endif
#ifndef DBG_MIX
#define DBG_MIX 0
#endif
#ifndef MK_N_LAUNCHES
#define MK_N_LAUNCHES 1
#endif
constexpr int N_PHASES = 14;
constexpr int N_LAUNCHES = MK_N_LAUNCHES;

constexpr int D = 1024, FF = 2816, NIN = 8448, SHIFTC = 3328, PLE = 256, TSEQ = 2048, NBATCH = 8, NSAMP = 128, NHEAD = 16;
constexpr int MP = pg8::MP, MV = pg8::MV, MPR = pg8::MPR;
constexpr float RMS_EPS = 1e-6f, GN_EPS = 64e-5f;
constexpr size_t O_YP = 0, O_YS = 16777216, O_WKVP = 16908288, O_SHP = 17432576, O_CVP = 17459200, O_WKVS = 17475584, O_SHS = 25864192, O_CVS = 26290176, O_END = 26552320;
constexpr size_t MiB = 1u << 20;
constexpr size_t WS_CTL = 0, CTL_ZERO_BYTES = 64 * 1024;
constexpr size_t WS_WIN = 1 * MiB;
constexpr size_t WS_WOUT = WS_WIN + (size_t)NIN * D * 2;
constexpr size_t WS_W2GU = WS_WOUT + (size_t)D * D * 2;
constexpr size_t WS_W2D = WS_W2GU + (size_t)2 * FF * D * 2;
constexpr size_t WS_WPG = WS_W2D + (size_t)D * FF * 2;
constexpr size_t WS_WPP = WS_WPG + (size_t)D * D * 2;
constexpr size_t WS_WDU = WS_WPP + (size_t)D * PLE * 2;
constexpr size_t WS_WIU = WS_WDU + (size_t)D * 64 * 2;
constexpr size_t WS_WGU = WS_WIU + (size_t)D * 64 * 2;
constexpr size_t WS_PB = WS_WGU + (size_t)D * 128 * 2;
constexpr size_t WS_XB = WS_PB + (size_t)MP * PLE * 2;
constexpr size_t WS_MIX = WS_XB + (size_t)MP * D * 2;
constexpr size_t WS_SSQ = WS_MIX + (size_t)MP * D * 2;
constexpr size_t WS_CAR = WS_SSQ + (size_t)16 * MP * 4;
constexpr size_t WS_R = (WS_CAR + (size_t)128 * 576 * 4 + 4095) / 4096 * 4096;
constexpr size_t WS_W1GU = WS_R;
constexpr size_t WS_W1D = WS_W1GU + (size_t)2 * FF * D * 2;
constexpr size_t WS_GU = WS_W1D + (size_t)D * FF * 2;
constexpr int NTC = 4, TCH = TSEQ / NTC;
constexpr size_t ZCH_BYTES = (size_t)NBATCH * TCH * NIN * 2;
constexpr size_t WS_Z = WS_R;
constexpr size_t WS_ZS = WS_Z + 2 * ZCH_BYTES;
constexpr size_t WS_ZX = WS_ZS + (size_t)NSAMP * NIN * 2;
constexpr size_t WS_END = 256 * MiB;
static_assert(WS_GU + (size_t)MP * FF * 2 <= WS_END && WS_ZX + (size_t)NTC * NBATCH * TCH * 256 * 2 <= WS_END, "d_ws map");
constexpr int CW_BAR = 4096;
constexpr int RING_OFF = 0, RING_BYTES = 131072;
constexpr int LDSCTL_OFF = 155648, MISC_OFF = LDSCTL_OFF + 320, PTR_OFF = LDSCTL_OFF + 1024;
constexpr int LDS_BYTES = 163840;
static_assert(MISC_OFF + 128 <= LDS_BYTES, "LDS map");

#define WG_SYNC() do { asm volatile("s_waitcnt lgkmcnt(0)" ::: "memory"); __builtin_amdgcn_s_barrier(); asm volatile("" ::: "memory"); } while (0)

typedef unsigned u32x2v __attribute__((ext_vector_type(2)));
typedef float f32x2 __attribute__((ext_vector_type(2)));

struct Frame {
    LAS unsigned char* lds;
    volatile LAS unsigned* MISC;
    gu32* ctl;
    int tid, lane, wave, vcu, G;
    GAS float* out; GAS unsigned char* ws;
    __device__ __forceinline__ const GAS float* inp(int k) const { const u32x2v p = *(const LAS u32x2v*)(lds + PTR_OFF + 8 * k); const unsigned long long a = ((unsigned long long)(unsigned)__builtin_amdgcn_readfirstlane((int)p.y) << 32) | (unsigned)__builtin_amdgcn_readfirstlane((int)p.x); return (const GAS float*)a; }
};

__device__ __forceinline__ float wave_sum(float v) {
#pragma unroll
    for (int o = 1; o < 64; o <<= 1) v += __shfl_xor(v, o);
    return v;
}
__device__ __forceinline__ f32x4 unpk4(u32x2v p) { f32x4 r; r[0] = __uint_as_float(p.x << 16); r[1] = __uint_as_float(p.x & 0xffff0000u); r[2] = __uint_as_float(p.y << 16); r[3] = __uint_as_float(p.y & 0xffff0000u); return r; }
__device__ __forceinline__ float bf_lo(unsigned p) { return __uint_as_float(p << 16); }
__device__ __forceinline__ float bf_hi(unsigned p) { return __uint_as_float(p & 0xffff0000u); }
__device__ __forceinline__ float fsig(float x) { return __builtin_amdgcn_rcpf(1.0f + __expf(-x)); }
__device__ __forceinline__ float ftanh(float x) { return 1.0f - 2.0f * __builtin_amdgcn_rcpf(__expf(2.0f * x) + 1.0f); }
template <int CTRL> __device__ __forceinline__ float dppf(float x) { return __builtin_bit_cast(float, __builtin_amdgcn_update_dpp(0, __builtin_bit_cast(int, x), CTRL, 0xF, 0xF, true)); }
__device__ __forceinline__ float red16(float x) {
    x += dppf<0xB1>(x); x += dppf<0x4E>(x); x += dppf<0x141>(x); x += dppf<0x140>(x); return x; }
__device__ __forceinline__ float decay_of(float x) {
    const float w = fminf(x, 0.f) - __logf(1.0f + __expf(-fabsf(x))) - 0.5f;
    return __expf(-__expf(w));
}

constexpr int P0_SCR = 17408;
__device__ __forceinline__ void p0_item(const GAS float* W, int K, int N, GAS bf16* WT, int mode, const GAS float* gain, LAS float* scr, int item, int lane) {
    const int nblk = N / 64, kb = item / nblk, nb = item % nblk, k0 = 64 * kb, n0 = 64 * nb;
    f32x4 w[16];
#pragma unroll
    for (int i = 0; i < 16; ++i) { const int kk = 4 * i + (lane >> 4); w[i] = *(const GAS f32x4*)(W + (size_t)(k0 + kk) * N + n0 + 4 * (lane & 15)); }
    if (gain) {
#pragma unroll
        for (int i = 0; i < 16; ++i) w[i] = w[i] * gain[k0 + 4 * i + (lane >> 4)]; }
#pragma unroll
    for (int i = 0; i < 16; ++i) { const int kk = 4 * i + (lane >> 4); *(LAS f32x4*)(scr + kk * 68 + ((4 * (lane & 15)) ^ (4 * (kk >> 3)))) = w[i]; }
    LDS_WAIT(); asm volatile("" ::: "memory");
    const int c = lane & 7;
    const int r0 = (mode == 0) ? n0 : ((n0 >> 7) * 256 + (n0 & 127) + (mode == 2 ? 128 : 0));
#pragma unroll
    for (int j = 0; j < 8; ++j) { const int n = (lane >> 3) + 8 * j; const LAS float* s = scr + (8 * c) * 68 + (n ^ (4 * c));
        v4u o; o.x = pg8::cvt_pk_bf16(s[0 * 68], s[1 * 68]); o.y = pg8::cvt_pk_bf16(s[2 * 68], s[3 * 68]); o.z = pg8::cvt_pk_bf16(s[4 * 68], s[5 * 68]); o.w = pg8::cvt_pk_bf16(s[6 * 68], s[7 * 68]);
        *(GAS v4u*)(WT + (size_t)(r0 + n) * K + k0 + 8 * c) = o; }
    LDS_WAIT(); asm volatile("" ::: "memory");
}
__device__ __forceinline__ void rms_row_to_bf16(int lane, const GAS float* xrow, const GAS float* gain, GAS bf16* orow) {
    const GAS f32x4* xr = (const GAS f32x4*)xrow + lane; const GAS f32x4* gr = (const GAS f32x4*)gain + lane;
    f32x4 v[4]; float s = 0.f;
#pragma unroll
    for (int j = 0; j < 4; ++j) { v[j] = xr[64 * j]; s += (v[j].x * v[j].x + v[j].y * v[j].y) + (v[j].z * v[j].z + v[j].w * v[j].w); }
    const float rs = 1.0f / sqrtf(wave_sum(s) * (1.f / D) + RMS_EPS);
    GAS unsigned long long* o8 = (GAS unsigned long long*)orow + lane;
#pragma unroll
    for (int j = 0; j < 4; ++j) { const f32x4 g = gr[64 * j]; o8[64 * j] = (unsigned long long)pk2(v[j].x * rs * g.x, v[j].y * rs * g.y) | ((unsigned long long)pk2(v[j].z * rs * g.z, v[j].w * rs * g.w) << 32); }
}
__device__ __forceinline__ void convert_group(Frame& F, int group, int gw, int NGW) {
    int tidl = threadIdx.x; asm volatile("" : "+v"(tidl)); const int lane_ = tidl & 63;
    LAS float* scr = (LAS float*)(F.lds + RING_OFF + F.wave * P0_SCR);
    GAS unsigned char* ws = F.ws;
    constexpr int I_GU = (D / 64) * (FF / 64), I_DN = (FF / 64) * (D / 64), I_IN = (D / 64) * (NIN / 64), I_SQ = (D / 64) * (D / 64), I_PP = (PLE / 64) * (D / 64), I_L64 = (D / 64), I_L128 = 2 * (D / 64);
    constexpr int I_LORA = 2 * I_L64 + I_L128 + I_PP;
    const int nitems = group == 0 ? 2 * I_GU : (group == 1 ? I_DN + I_IN : (group == 2 ? I_LORA : 2 * I_GU + I_DN + 2 * I_SQ));
#pragma unroll 1
    for (int it = gw; it < nitems; it += NGW) {
        int r = (group == 3) ? it + I_LORA : it, wi, gi = -1, K, N, mode = 0; size_t dst;
        if (group == 0) {
            if (r < I_GU) { wi = 8; K = D; N = FF; dst = WS_W1GU; mode = 1; } else { r -= I_GU; wi = 9; K = D; N = FF; dst = WS_W1GU; mode = 2; }
        } else if (group == 1) {
            if (r < I_DN) { wi = 10; K = FF; N = D; dst = WS_W1D; } else { r -= I_DN; wi = 12; gi = 11; K = D; N = NIN; dst = WS_WIN; }
        } else {
            if (r < I_L64) { wi = 14; K = 64; N = D; dst = WS_WDU; }
            else if ((r -= I_L64) < I_L64) { wi = 16; K = 64; N = D; dst = WS_WIU; }
            else if ((r -= I_L64) < I_L128) { wi = 18; K = 128; N = D; dst = WS_WGU; }
            else if ((r -= I_L128) < I_PP) { wi = 32; K = PLE; N = D; dst = WS_WPP; }
            else if ((r -= I_PP) < I_SQ) { wi = 25; K = D; N = D; dst = WS_WOUT; }
            else if ((r -= I_SQ) < I_GU) { wi = 27; gi = 26; K = D; N = FF; dst = WS_W2GU; mode = 1; }
            else if ((r -= I_GU) < I_GU) { wi = 28; gi = 26; K = D; N = FF; dst = WS_W2GU; mode = 2; }
            else if ((r -= I_GU) < I_DN) { wi = 29; K = FF; N = D; dst = WS_W2D; }
            else { r -= I_DN; wi = 31; gi = 30; K = D; N = D; dst = WS_WPG; }
        }
        const GAS float* gp = nullptr; if (gi >= 0) gp = F.inp(gi);
        p0_item(F.inp(wi), K, N, (GAS bf16*)(ws + dst), mode, gp, scr, r, lane_);
    }
}
__device__ __forceinline__ void p0_prologue(Frame& F) {
    const int gw = F.vcu * NWAVES + F.wave, NGW = F.G * NWAVES;
    GAS unsigned char* ws = F.ws;
    convert_group(F, 0, gw, NGW);
    int tidl = threadIdx.x; asm volatile("" : "+v"(tidl)); const int lane_ = tidl & 63;
    f32x4 g4[4];
#pragma unroll
    for (int j = 0; j < 4; ++j) g4[j] = ((const GAS f32x4*)F.inp(7))[lane_ + 64 * j];
    for (int m0 = gw; m0 < MV; m0 += 4 * NGW) {
        f32x4 v[4][4], pv[4]; float ss[4];
#pragma unroll
        for (int r = 0; r < 4; ++r) {
            const int m = (m0 + r * NGW < MV) ? m0 + r * NGW : m0;
            const GAS float* xr = (m < MPR) ? F.inp(0) + (size_t)m * D : F.inp(1) + (size_t)(m - MPR) * D;
            const GAS float* pr = (m < MPR) ? F.inp(2) + (size_t)m * PLE : F.inp(3) + (size_t)(m - MPR) * PLE;
#pragma unroll
            for (int j = 0; j < 4; ++j) v[r][j] = ((const GAS f32x4*)xr)[lane_ + 64 * j];
            pv[r] = ((const GAS f32x4*)pr)[lane_];
        }
#pragma unroll
        for (int r = 0; r < 4; ++r) { float q = 0.f;
#pragma unroll
            for (int j = 0; j < 4; ++j) q += (v[r][j].x * v[r][j].x + v[r][j].y * v[r][j].y) + (v[r][j].z * v[r][j].z + v[r][j].w * v[r][j].w);
            ss[r] = q; }
#pragma unroll
        for (int o = 1; o < 64; o <<= 1) {
#pragma unroll
            for (int r = 0; r < 4; ++r) ss[r] += __shfl_xor(ss[r], o); }
#pragma unroll
        for (int r = 0; r < 4; ++r) {
            const int m = m0 + r * NGW;
            if (m < MV) {
                const float rs = 1.0f / sqrtf(ss[r] * (1.f / D) + RMS_EPS);
                GAS u32x2v* o8 = (GAS u32x2v*)((GAS bf16*)(ws + WS_XB) + (size_t)m * D) + lane_;
#pragma unroll
                for (int j = 0; j < 4; ++j) { const f32x4 y = v[r][j] * rs * g4[j]; u32x2v w; w.x = pg8::cvt_pk_bf16(y.x, y.y); w.y = pg8::cvt_pk_bf16(y.z, y.w); o8[64 * j] = w; }
                u32x2v w; w.x = pg8::cvt_pk_bf16(pv[r].x, pv[r].y); w.y = pg8::cvt_pk_bf16(pv[r].z, pv[r].w);
                ((GAS u32x2v*)((GAS bf16*)(ws + WS_PB) + (size_t)m * PLE))[lane_] = w;
            }
        }
    }
}
__device__ __forceinline__ void p9_final(Frame& F) {
    const int gw = F.vcu * NWAVES + F.wave, NGW = F.G * NWAVES;
    const GAS bf16* XF = (const GAS bf16*)(F.ws + WS_GU);
    int tidl = threadIdx.x; asm volatile("" : "+v"(tidl)); const int lane_ = tidl & 63;
    f32x4 g4[4];
#pragma unroll
    for (int j = 0; j < 2; ++j) { g4[2 * j] = ((const GAS f32x4*)F.inp(33))[2 * lane_ + 128 * j]; g4[2 * j + 1] = ((const GAS f32x4*)F.inp(33))[2 * lane_ + 128 * j + 1]; }
    for (int m0 = gw; m0 < MV; m0 += 4 * NGW) {
        v4u p[4][2]; float ss[4];
#pragma unroll
        for (int r = 0; r < 4; ++r) { const int m = (m0 + r * NGW < MV) ? m0 + r * NGW : m0; const GAS v4u* xr = (const GAS v4u*)(XF + (size_t)m * D) + lane_; p[r][0] = xr[0]; p[r][1] = xr[64]; }
#pragma unroll
        for (int r = 0; r < 4; ++r) { float q = 0.f;
#pragma unroll
            for (int j = 0; j < 2; ++j) { const unsigned w4[4] = {p[r][j].x, p[r][j].y, p[r][j].z, p[r][j].w};
#pragma unroll
                for (int e = 0; e < 4; ++e) { const float a = bf_lo(w4[e]), b2 = bf_hi(w4[e]); q += a * a + b2 * b2; } }
            ss[r] = q; }
#pragma unroll
        for (int o = 1; o < 64; o <<= 1) {
#pragma unroll
            for (int r = 0; r < 4; ++r) ss[r] += __shfl_xor(ss[r], o); }
#pragma unroll
        for (int r = 0; r < 4; ++r) {
            const int m = m0 + r * NGW;
            if (m < MV) {
                const float rs = 1.0f / sqrtf(ss[r] * (1.f / D) + RMS_EPS);
                GAS f32x4* yr = (GAS f32x4*)(F.out + (size_t)m * D) + 2 * lane_;
#pragma unroll
                for (int j = 0; j < 2; ++j) { const v4u w = p[r][j];
                    yr[128 * j] = (f32x4){bf_lo(w.x), bf_hi(w.x), bf_lo(w.y), bf_hi(w.y)} * rs * g4[2 * j]; yr[128 * j + 1] = (f32x4){bf_lo(w.z), bf_hi(w.z), bf_lo(w.w), bf_hi(w.w)} * rs * g4[2 * j + 1]; }
            }
        }
    }
}

constexpr int MX_WGU = 0, MX_AT = 17408, MX_AA = 22016, MX_AG = 26624, MX_LD = 35328, MX_AL = 43520, MX_LG = 51712, MX_LGT = 59904, MX_G = 60416  ,
              MX_KT = 76800, MX_RT = 81408, MX_KH = 86016, MX_BH = 90624, MX_KB = 95232, MX_VT = 104448, MX_TP = 109568, MX_AR = 111872, MX_AKK = 114176, MX_ABK = 116224,
              MX_G16 = 118272  , MX_Y = 119296, MX_BON = 127488  , MX_CU = 127744  , MX_CT = 145152, MX_CAR = 148992, MX_ID = 150784  , MX_END = 151808;
static_assert(MX_END <= LDSCTL_OFF, "mixer LDS map");
constexpr int SUBT = 32;
constexpr int CAR_STRIDE = 576;
constexpr int KT_ST = 144, KB_ST = 72, VT_ST = 40, TP_ST = 72;
__device__ __forceinline__ float logdecay_of(float x) { return -0.60653065971263342f * __builtin_amdgcn_rcpf(1.0f + __expf(-x)); }

struct RawZ { u32x2v r, k, v, rp, kp, vp, wd, ad, wdp, adp; v4u gd, gdp; u32x2v cC, cU; };

__device__ __forceinline__ void mix_load(RawZ& R, const GAS bf16* Zc, int lrow, bool first, int h, int q) {
    const GAS unsigned char* zb = (const GAS unsigned char*)Zc;
    const unsigned ro = (unsigned)lrow * (unsigned)(NIN * 2), po = first ? ro : ro - (unsigned)(NIN * 2);
    const unsigned hb = (unsigned)(64 * h + 4 * q) * 2u, qb = (unsigned)q * 8u;
    R.r = *(const GAS u32x2v*)(zb + (ro + hb)); R.k = *(const GAS u32x2v*)(zb + (ro + hb + 2048u)); R.v = *(const GAS u32x2v*)(zb + (ro + hb + 4096u));
    R.rp = *(const GAS u32x2v*)(zb + (po + hb)); R.kp = *(const GAS u32x2v*)(zb + (po + hb + 2048u)); R.vp = *(const GAS u32x2v*)(zb + (po + hb + 4096u));
    R.wd = *(const GAS u32x2v*)(zb + (ro + qb + 6144u)); R.ad = *(const GAS u32x2v*)(zb + (ro + qb + 6272u)); R.gd = *(const GAS v4u*)(zb + (ro + 2u * qb + 6400u));
    R.wdp = *(const GAS u32x2v*)(zb + (po + qb + 6144u)); R.adp = *(const GAS u32x2v*)(zb + (po + qb + 6272u)); R.gdp = *(const GAS v4u*)(zb + (po + 2u * qb + 6400u));
    R.cC = *(const GAS u32x2v*)(zb + (ro + hb + 8704u)); R.cU = *(const GAS u32x2v*)(zb + (ro + hb + 10752u));
}

#ifdef PROBE_TS_A
#define PROBE_MIX
#endif
__device__ __forceinline__ void mix_job(Frame& F, int b, int h, int chunk) {
    LAS unsigned char* lds = F.lds;
    asm volatile("" : "+s"(b), "+s"(h), "+s"(chunk));
    int tid = threadIdx.x; asm volatile("" : "+v"(tid));
    const int lane = tid & 63, wave = __builtin_amdgcn_readfirstlane(tid >> 6);
    const int tt = tid >> 4, q = tid & 15;
    const GAS bf16* Zc = (const GAS bf16*)(F.ws + WS_Z + (size_t)(chunk & 1) * ZCH_BYTES);
    GAS float* car = (GAS float*)(F.ws + WS_CAR) + (size_t)(b * NHEAD + h) * CAR_STRIDE;
    const GAS bf16* GBb = (h >= 12) ? (const GAS bf16*)(F.ws + WS_ZX) + (size_t)chunk * (NBATCH * TCH) * 256 + 64 * (h - 12) : Zc + 7424 + 64 * h; const int gbs = (h >= 12) ? 256 : NIN;
    __builtin_amdgcn_s_waitcnt(0);
    const int hc = 64 * h + 4 * q;
    const int mb = wave & 1, nb = wave >> 1, lr = lane & 15, lq = lane >> 4;
    const bool cont = (chunk != 0);
    const GAS bf16* wgu = (const GAS bf16*)(F.ws + WS_WGU) + (size_t)(64 * h) * 128;
    const GAS float* ctp[2];
#pragma unroll
    for (int i = 0; i < 2; ++i) {
        const int rw = (wave + 8 * i < 15) ? wave + 8 * i : 14;
        const int idx = rw < 7 ? 13 : (rw < 12 ? rw + 12 : 24);
        const int off = rw < 3 ? rw * 1024 + 64 * h : (rw < 7 ? 3072 + 64 * (rw - 3) : (rw < 12 ? 64 * h : (rw - 12) * 1024 + 64 * h));
        ctp[i] = F.inp(idx) + off;
    }
    const GAS float* p15 = F.inp(15) + 64 * h; const GAS float* p17 = F.inp(17) + 64 * h;
    __builtin_amdgcn_sched_barrier(0);
    f32x4 ctv[2];
#pragma unroll
    for (int i = 0; i < 2; ++i) ctv[i] = *(const GAS f32x4*)(ctp[i] + 4 * (lane & 15));
    const float dbias = p15[16 * nb + lr], ibias = p17[16 * nb + lr];
    bf16x8 bfD[2], bfI[2];
    { const GAS bf16* wdu = (const GAS bf16*)(F.ws + WS_WDU) + (size_t)(64 * h + 16 * nb + lr) * 64 + 8 * lq; const GAS bf16* wiu = (const GAS bf16*)(F.ws + WS_WIU) + (size_t)(64 * h + 16 * nb + lr) * 64 + 8 * lq;
      bfD[0] = *(const GAS bf16x8*)wdu; bfD[1] = *(const GAS bf16x8*)(wdu + 32); bfI[0] = *(const GAS bf16x8*)wiu; bfI[1] = *(const GAS bf16x8*)(wiu + 32); }
    GAS float* Sg = F.out + O_WKVP + (size_t)(b * NHEAD + h) * 4096;
    f32x4 Hs[4];
#pragma unroll
    for (int kb = 0; kb < 4; ++kb) Hs[kb] = *(const GAS f32x4*)(Sg + (size_t)(16 * (wave & 3) + lr) * 64 + 16 * kb + 4 * lq);
    const f32x4 ch0 = *(const GAS f32x4*)(car + 448 + (tt & 1) * 64 + 4 * q);
    f32x4 c7[7];
#pragma unroll
    for (int i = 0; i < 7; ++i) c7[i] = *(const GAS f32x4*)(car + 64 * i + 4 * q);
    RawZ R; mix_load(R, Zc, b * TCH + tt, (tt == 0), h, q);
    const v4u wg0 = *(const GAS v4u*)(wgu + tid * 8), wg1 = *(const GAS v4u*)(wgu + (tid + 512) * 8);
    __builtin_amdgcn_sched_barrier(0);
    *(LAS v4u*)(lds + MX_WGU + (tid >> 4) * 272 + (tid & 15) * 16) = wg0; *(LAS v4u*)(lds + MX_WGU + ((tid + 512) >> 4) * 272 + (tid & 15) * 16) = wg1;
    if (tid < 256) *(LAS float*)(lds + MX_ID + tid * 4) = ((tid >> 4) == (tid & 15)) ? 1.0f : 0.0f;
    if (lane < 16) { *(LAS f32x4*)(lds + MX_CT + wave * 256 + lane * 16) = ctv[0]; if (wave < 7) *(LAS f32x4*)(lds + MX_CT + (wave + 8) * 256 + lane * 16) = ctv[1]; }
    { const f32x4 z4 = (f32x4){0.f, 0.f, 0.f, 0.f};
#pragma unroll
      for (int kb = 0; kb < 4; ++kb) Hs[kb] = (cont && wave < 4) ? Hs[kb] : z4;
      if (tt < 2) *(LAS f32x4*)(lds + MX_CU + tt * 256 + q * 16) = cont ? ch0 : z4;
      if (tt == 0) {
#pragma unroll
          for (int i = 0; i < 7; ++i) *(LAS f32x4*)(lds + MX_CAR + i * 256 + q * 16) = cont ? c7[i] : z4;
      } }
    const int tid0 = tid;
    WG_SYNC();
    constexpr int NSC = TCH / SUBT;
    f32x4 v_c = (f32x4){0.f, 0.f, 0.f, 0.f}, cu_c = v_c; u32x2v mo_w = (u32x2v){0u, 0u};
#ifdef PROBE_MIX
    unsigned tacc0 = 0, tacc1 = 0, tacc2 = 0, tacc3 = 0, tprev = (unsigned)__builtin_amdgcn_s_memrealtime(); const unsigned tstart = tprev;
#endif
    for (int j = -1; j < NSC; ++j) {
        int tid = tid0; asm volatile("" : "+v"(tid));
        const int lane = tid & 63, tt = tid >> 4, q = tid & 15, lr = lane & 15, lq = lane >> 4, hc = 64 * h + 4 * q;
        const bool front = (j + 1 < NSC), back = (j >= 0);
        const int sf = j + 1, pf = sf & 1, pb = j & 1;
        f32x4 r_s, k_s, v_n, cu_n; u32x2v fB, fA, fG;
        if (back)
        if (wave < 4) {
            const int g = wave & 1, kind = wave >> 1;
            const LAS unsigned char* As = lds + (kind ? MX_RT : MX_KT) + g * 16 * KT_ST; const LAS unsigned char* Bk = lds + MX_KH + g * 16 * KT_ST; const LAS unsigned char* Bb = lds + MX_BH + g * 16 * KT_ST;
            f32x4 accK = (f32x4){0.f, 0.f, 0.f, 0.f}, accB = accK;
#pragma unroll
            for (int ks = 0; ks < 2; ++ks) { const bf16x8 af = *(const LAS bf16x8*)(As + lr * KT_ST + (32 * ks + 8 * lq) * 2), bk = *(const LAS bf16x8*)(Bk + lr * KT_ST + (32 * ks + 8 * lq) * 2), bb = *(const LAS bf16x8*)(Bb + lr * KT_ST + (32 * ks + 8 * lq) * 2);
                accK = __builtin_amdgcn_mfma_f32_16x16x32_bf16(af, bk, accK, 0, 0, 0); accB = __builtin_amdgcn_mfma_f32_16x16x32_bf16(af, bb, accB, 0, 0, 0); }
            if (kind == 0) {
                LAS float* akk = (LAS float*)(lds + MX_AKK + g * 1024); LAS float* abk = (LAS float*)(lds + MX_ABK + g * 1024);
#pragma unroll
                for (int rg = 0; rg < 4; ++rg) { const int i = 4 * lq + rg; const bool keep = (lr < i); akk[i * 16 + lr] = keep ? accK[rg] : 0.f;
                    abk[i * 16 + lr] = keep ? accB[rg] : 0.f;
                }
                const int wh = (lane >> 4) & 1, jc = lane & 15;
                float t[16];
                { const LAS float* ini = wh ? (const LAS float*)akk : (const LAS float*)(lds + MX_ID);
#pragma unroll
                  for (int i = 0; i < 16; ++i) t[i] = ini[i * 16 + jc]; }
                {
                    f32x4 c[12];
                    c[0] = *(const LAS f32x4*)(abk + 16);
                    c[1] = *(const LAS f32x4*)(abk + 32);
                    c[2] = *(const LAS f32x4*)(abk + 48);
                    c[3] = *(const LAS f32x4*)(abk + 64);
                    c[4] = *(const LAS f32x4*)(abk + 80);
                    c[5] = *(const LAS f32x4*)(abk + 84);
                    c[6] = *(const LAS f32x4*)(abk + 96);
                    c[7] = *(const LAS f32x4*)(abk + 100);
                    c[8] = *(const LAS f32x4*)(abk + 112);
                    c[9] = *(const LAS f32x4*)(abk + 116);
                    c[10] = *(const LAS f32x4*)(abk + 128);
                    c[11] = *(const LAS f32x4*)(abk + 132);
                    __builtin_amdgcn_sched_barrier(0);
                    t[1] -= c[0][0] * t[0];
                    t[2] -= c[1][0] * t[0];
                    t[2] -= c[1][1] * t[1];
                    t[3] -= c[2][0] * t[0];
                    t[3] -= c[2][1] * t[1];
                    t[3] -= c[2][2] * t[2];
                    t[4] -= c[3][0] * t[0];
                    t[4] -= c[3][1] * t[1];
                    t[4] -= c[3][2] * t[2];
                    t[4] -= c[3][3] * t[3];
                    t[5] -= c[4][0] * t[0];
                    t[5] -= c[4][1] * t[1];
                    t[5] -= c[4][2] * t[2];
                    t[5] -= c[4][3] * t[3];
                    t[5] -= c[5][0] * t[4];
                    t[6] -= c[6][0] * t[0];
                    t[6] -= c[6][1] * t[1];
                    t[6] -= c[6][2] * t[2];
                    t[6] -= c[6][3] * t[3];
                    t[6] -= c[7][0] * t[4];
                    t[6] -= c[7][1] * t[5];
                    t[7] -= c[8][0] * t[0];
                    t[7] -= c[8][1] * t[1];
                    t[7] -= c[8][2] * t[2];
                    t[7] -= c[8][3] * t[3];
                    t[7] -= c[9][0] * t[4];
                    t[7] -= c[9][1] * t[5];
                    t[7] -= c[9][2] * t[6];
                    t[8] -= c[10][0] * t[0];
                    t[8] -= c[10][1] * t[1];
                    t[8] -= c[10][2] * t[2];
                    t[8] -= c[10][3] * t[3];
                    t[8] -= c[11][0] * t[4];
                    t[8] -= c[11][1] * t[5];
                    t[8] -= c[11][2] * t[6];
                    t[8] -= c[11][3] * t[7];
                    __builtin_amdgcn_sched_barrier(0);
                }
                {
                    f32x4 c[12];
                    c[0] = *(const LAS f32x4*)(abk + 144);
                    c[1] = *(const LAS f32x4*)(abk + 148);
                    c[2] = *(const LAS f32x4*)(abk + 152);
                    c[3] = *(const LAS f32x4*)(abk + 160);
                    c[4] = *(const LAS f32x4*)(abk + 164);
                    c[5] = *(const LAS f32x4*)(abk + 168);
                    c[6] = *(const LAS f32x4*)(abk + 176);
                    c[7] = *(const LAS f32x4*)(abk + 180);
                    c[8] = *(const LAS f32x4*)(abk + 184);
                    c[9] = *(const LAS f32x4*)(abk + 192);
                    c[10] = *(const LAS f32x4*)(abk + 196);
                    c[11] = *(const LAS f32x4*)(abk + 200);
                    __builtin_amdgcn_sched_barrier(0);
                    t[9] -= c[0][0] * t[0];
                    t[9] -= c[0][1] * t[1];
                    t[9] -= c[0][2] * t[2];
                    t[9] -= c[0][3] * t[3];
                    t[9] -= c[1][0] * t[4];
                    t[9] -= c[1][1] * t[5];
                    t[9] -= c[1][2] * t[6];
                    t[9] -= c[1][3] * t[7];
                    t[9] -= c[2][0] * t[8];
                    t[10] -= c[3][0] * t[0];
                    t[10] -= c[3][1] * t[1];
                    t[10] -= c[3][2] * t[2];
                    t[10] -= c[3][3] * t[3];
                    t[10] -= c[4][0] * t[4];
                    t[10] -= c[4][1] * t[5];
                    t[10] -= c[4][2] * t[6];
                    t[10] -= c[4][3] * t[7];
                    t[10] -= c[5][0] * t[8];
                    t[10] -= c[5][1] * t[9];
                    t[11] -= c[6][0] * t[0];
                    t[11] -= c[6][1] * t[1];
                    t[11] -= c[6][2] * t[2];
                    t[11] -= c[6][3] * t[3];
                    t[11] -= c[7][0] * t[4];
                    t[11] -= c[7][1] * t[5];
                    t[11] -= c[7][2] * t[6];
                    t[11] -= c[7][3] * t[7];
                    t[11] -= c[8][0] * t[8];
                    t[11] -= c[8][1] * t[9];
                    t[11] -= c[8][2] * t[10];
                    t[12] -= c[9][0] * t[0];
                    t[12] -= c[9][1] * t[1];
                    t[12] -= c[9][2] * t[2];
                    t[12] -= c[9][3] * t[3];
                    t[12] -= c[10][0] * t[4];
                    t[12] -= c[10][1] * t[5];
                    t[12] -= c[10][2] * t[6];
                    t[12] -= c[10][3] * t[7];
                    t[12] -= c[11][0] * t[8];
                    t[12] -= c[11][1] * t[9];
                    t[12] -= c[11][2] * t[10];
                    t[12] -= c[11][3] * t[11];
                    __builtin_amdgcn_sched_barrier(0);
                }
                {
                    f32x4 c[12];
                    c[0] = *(const LAS f32x4*)(abk + 208);
                    c[1] = *(const LAS f32x4*)(abk + 212);
                    c[2] = *(const LAS f32x4*)(abk + 216);
                    c[3] = *(const LAS f32x4*)(abk + 220);
                    c[4] = *(const LAS f32x4*)(abk + 224);
                    c[5] = *(const LAS f32x4*)(abk + 228);
                    c[6] = *(const LAS f32x4*)(abk + 232);
                    c[7] = *(const LAS f32x4*)(abk + 236);
                    c[8] = *(const LAS f32x4*)(abk + 240);
                    c[9] = *(const LAS f32x4*)(abk + 244);
                    c[10] = *(const LAS f32x4*)(abk + 248);
                    c[11] = *(const LAS f32x4*)(abk + 252);
                    __builtin_amdgcn_sched_barrier(0);
                    t[13] -= c[0][0] * t[0];
                    t[13] -= c[0][1] * t[1];
                    t[13] -= c[0][2] * t[2];
                    t[13] -= c[0][3] * t[3];
                    t[13] -= c[1][0] * t[4];
                    t[13] -= c[1][1] * t[5];
                    t[13] -= c[1][2] * t[6];
                    t[13] -= c[1][3] * t[7];
                    t[13] -= c[2][0] * t[8];
                    t[13] -= c[2][1] * t[9];
                    t[13] -= c[2][2] * t[10];
                    t[13] -= c[2][3] * t[11];
                    t[13] -= c[3][0] * t[12];
                    t[14] -= c[4][0] * t[0];
                    t[14] -= c[4][1] * t[1];
                    t[14] -= c[4][2] * t[2];
                    t[14] -= c[4][3] * t[3];
                    t[14] -= c[5][0] * t[4];
                    t[14] -= c[5][1] * t[5];
                    t[14] -= c[5][2] * t[6];
                    t[14] -= c[5][3] * t[7];
                    t[14] -= c[6][0] * t[8];
                    t[14] -= c[6][1] * t[9];
                    t[14] -= c[6][2] * t[10];
                    t[14] -= c[6][3] * t[11];
                    t[14] -= c[7][0] * t[12];
                    t[14] -= c[7][1] * t[13];
                    t[15] -= c[8][0] * t[0];
                    t[15] -= c[8][1] * t[1];
                    t[15] -= c[8][2] * t[2];
                    t[15] -= c[8][3] * t[3];
                    t[15] -= c[9][0] * t[4];
                    t[15] -= c[9][1] * t[5];
                    t[15] -= c[9][2] * t[6];
                    t[15] -= c[9][3] * t[7];
                    t[15] -= c[10][0] * t[8];
                    t[15] -= c[10][1] * t[9];
                    t[15] -= c[10][2] * t[10];
                    t[15] -= c[10][3] * t[11];
                    t[15] -= c[11][0] * t[12];
                    t[15] -= c[11][1] * t[13];
                    t[15] -= c[11][2] * t[14];
                    __builtin_amdgcn_sched_barrier(0);
                }
#pragma unroll
                for (int i = 0; i < 16; ++i) *(LAS unsigned short*)(lds + MX_TP + g * 16 * TP_ST + i * TP_ST + wh * 32 + jc * 2) = (unsigned short)pg8::cvt_pk_bf16(t[i], 0.f);
            } else {
#pragma unroll
                for (int rg = 0; rg < 4; ++rg) { const int i = 4 * lq + rg; const bool keep = (lr <= i);
                    *(LAS unsigned short*)(lds + MX_AR + g * 16 * TP_ST + i * TP_ST + lr * 2) = (unsigned short)pg8::cvt_pk_bf16(keep ? accK[rg] : 0.f, 0.f);
                    *(LAS unsigned short*)(lds + MX_AR + g * 16 * TP_ST + i * TP_ST + 32 + lr * 2) = (unsigned short)pg8::cvt_pk_bf16(keep ? -accB[rg] : 0.f, 0.f); }
            }
        }
        if (front) {
            const bool first = (sf == 0 && tt == 0);
            const f32x4 mu_r = *(const LAS f32x4*)(lds + MX_CT + 0 * 256 + q * 16), mu_k = *(const LAS f32x4*)(lds + MX_CT + 1 * 256 + q * 16), mu_v = *(const LAS f32x4*)(lds + MX_CT + 2 * 256 + q * 16);
            const f32x4 mu_wd = *(const LAS f32x4*)(lds + MX_CT + 3 * 256 + q * 16), mu_ad = *(const LAS f32x4*)(lds + MX_CT + 4 * 256 + q * 16);
            const f32x4 mu_g0 = *(const LAS f32x4*)(lds + MX_CT + 5 * 256 + q * 32), mu_g1 = *(const LAS f32x4*)(lds + MX_CT + 5 * 256 + q * 32 + 16);
            f32x4 zr_ = unpk4(R.r), zk_ = unpk4(R.k), zv_ = unpk4(R.v), zwd = unpk4(R.wd), zad = unpk4(R.ad);
            f32x4 zg0 = unpk4((u32x2v){R.gd.x, R.gd.y}), zg1 = unpk4((u32x2v){R.gd.z, R.gd.w});
            f32x4 pr_ = unpk4(R.rp), pk_ = unpk4(R.kp), pv_ = unpk4(R.vp), pwd = unpk4(R.wdp), pad = unpk4(R.adp);
            f32x4 pg0 = unpk4((u32x2v){R.gdp.x, R.gdp.y}), pg1 = unpk4((u32x2v){R.gdp.z, R.gdp.w});
            if (first) { const LAS float* cl = (const LAS float*)(lds + MX_CAR);
                pr_ = *(const LAS f32x4*)(cl + 4 * q); pk_ = *(const LAS f32x4*)(cl + 64 + 4 * q); pv_ = *(const LAS f32x4*)(cl + 128 + 4 * q);
                pwd = *(const LAS f32x4*)(cl + 192 + 4 * q); pad = *(const LAS f32x4*)(cl + 256 + 4 * q); pg0 = *(const LAS f32x4*)(cl + 320 + 8 * q); pg1 = *(const LAS f32x4*)(cl + 324 + 8 * q); }
            if (chunk < NTC - 1 && sf == NSC - 1 && tt == SUBT - 1) {
                *(GAS f32x4*)(car + 4 * q) = zr_; *(GAS f32x4*)(car + 64 + 4 * q) = zk_; *(GAS f32x4*)(car + 128 + 4 * q) = zv_;
                *(GAS f32x4*)(car + 192 + 4 * q) = zwd; *(GAS f32x4*)(car + 256 + 4 * q) = zad; *(GAS f32x4*)(car + 320 + 8 * q) = zg0; *(GAS f32x4*)(car + 324 + 8 * q) = zg1;
            }
            if (chunk == NTC - 1 && sf == NSC - 1 && tt == SUBT - 1) {
                GAS float* d = F.out + O_SHP + (size_t)b * SHIFTC;
                *(GAS f32x4*)(d + hc) = zr_; *(GAS f32x4*)(d + 1024 + hc) = zk_; *(GAS f32x4*)(d + 2048 + hc) = zv_;
                if (h == 0) { *(GAS f32x4*)(d + 3072 + 4 * q) = zwd; *(GAS f32x4*)(d + 3136 + 4 * q) = zad; *(GAS f32x4*)(d + 3200 + 8 * q) = zg0; *(GAS f32x4*)(d + 3204 + 8 * q) = zg1; }
            }
            r_s = zr_ + mu_r * (pr_ - zr_); k_s = zk_ + mu_k * (pk_ - zk_); v_n = zv_ + mu_v * (pv_ - zv_);
            const f32x4 wd_s = zwd + mu_wd * (pwd - zwd), ad_s = zad + mu_ad * (pad - zad), g0_s = zg0 + mu_g0 * (pg0 - zg0), g1_s = zg1 + mu_g1 * (pg1 - zg1);
            { u32x2v w; w.x = pg8::cvt_pk_bf16(ftanh(wd_s[0]), ftanh(wd_s[1])); w.y = pg8::cvt_pk_bf16(ftanh(wd_s[2]), ftanh(wd_s[3])); *(LAS u32x2v*)(lds + MX_AT + tt * 144 + q * 8) = w; }
            { u32x2v w; w.x = pg8::cvt_pk_bf16(ad_s[0], ad_s[1]); w.y = pg8::cvt_pk_bf16(ad_s[2], ad_s[3]); *(LAS u32x2v*)(lds + MX_AA + tt * 144 + q * 8) = w; }
            { v4u w; w.x = pg8::cvt_pk_bf16(fsig(g0_s[0]), fsig(g0_s[1])); w.y = pg8::cvt_pk_bf16(fsig(g0_s[2]), fsig(g0_s[3])); w.z = pg8::cvt_pk_bf16(fsig(g1_s[0]), fsig(g1_s[1])); w.w = pg8::cvt_pk_bf16(fsig(g1_s[2]), fsig(g1_s[3]));
              *(LAS v4u*)(lds + MX_AG + tt * 272 + q * 16) = w; }
            cu_n = unpk4(R.cC) * unpk4(R.cU);
            *(LAS f32x4*)(lds + MX_CU + pf * 8704 + (tt + 2) * 256 + q * 16) = cu_n;
        } else {
            asm volatile("" :: "v"(R.r.x), "v"(R.r.y), "v"(R.k.x), "v"(R.k.y), "v"(R.v.x), "v"(R.v.y), "v"(R.rp.x), "v"(R.rp.y), "v"(R.kp.x), "v"(R.kp.y), "v"(R.vp.x), "v"(R.vp.y), "v"(R.wd.x), "v"(R.wd.y));
            asm volatile("" :: "v"(R.ad.x), "v"(R.ad.y), "v"(R.wdp.x), "v"(R.wdp.y), "v"(R.adp.x), "v"(R.adp.y), "v"(R.gd.x), "v"(R.gd.y), "v"(R.gd.z), "v"(R.gd.w), "v"(R.gdp.x), "v"(R.gdp.y), "v"(R.gdp.z), "v"(R.gdp.w));
            asm volatile("" :: "v"(R.cC.x), "v"(R.cC.y), "v"(R.cU.x), "v"(R.cU.y));
            r_s = (f32x4){0.f, 0.f, 0.f, 0.f}; k_s = r_s; v_n = r_s; cu_n = r_s;
        }
        __builtin_amdgcn_sched_barrier(0);
        if (j >= 1) *(GAS u32x2v*)((GAS bf16*)(F.ws + WS_MIX) + (size_t)(b * TSEQ + chunk * TCH + (j - 1) * SUBT + tt) * D + hc) = mo_w;
        mix_load(R, Zc, b * TCH + (sf + 1 < NSC ? sf + 1 : NSC - 1) * SUBT + tt, false, h, q);
        { const int lrow = b * TCH + (j < 0 ? 0 : j) * SUBT + tt; const unsigned ro = (unsigned)lrow * (unsigned)(NIN * 2) + (unsigned)hc * 2u;
            fB = *(const GAS u32x2v*)((const GAS unsigned char*)Zc + (ro + 6656u)); fA = *(const GAS u32x2v*)((const GAS unsigned char*)Zc + (ro + 12800u));
            fG = *(const GAS u32x2v*)((const GAS unsigned char*)GBb + ((unsigned)lrow * (unsigned)(gbs * 2) + (unsigned)q * 8u)); }
        WG_SYNC();
#ifdef PROBE_MIX
        { const unsigned tn = (unsigned)__builtin_amdgcn_s_memrealtime(); tacc0 += tn - tprev; tprev = tn; }
#endif
        if (front)
        {
            f32x4 a1 = (f32x4){0.f, 0.f, 0.f, 0.f}, a2 = a1, a3 = a1;
#pragma unroll
            for (int ks = 0; ks < 2; ++ks) {
                const bf16x8 At = *(const LAS bf16x8*)(lds + MX_AT + (16 * mb + lr) * 144 + (32 * ks + 8 * lq) * 2);
                const bf16x8 Aa = *(const LAS bf16x8*)(lds + MX_AA + (16 * mb + lr) * 144 + (32 * ks + 8 * lq) * 2);
                a1 = __builtin_amdgcn_mfma_f32_16x16x32_bf16(At, bfD[ks], a1, 0, 0, 0); a2 = __builtin_amdgcn_mfma_f32_16x16x32_bf16(Aa, bfI[ks], a2, 0, 0, 0); }
#pragma unroll
            for (int ks = 0; ks < 4; ++ks) {
                const bf16x8 Ag = *(const LAS bf16x8*)(lds + MX_AG + (16 * mb + lr) * 272 + (32 * ks + 8 * lq) * 2), Bg = *(const LAS bf16x8*)(lds + MX_WGU + (16 * nb + lr) * 272 + (32 * ks + 8 * lq) * 2);
                a3 = __builtin_amdgcn_mfma_f32_16x16x32_bf16(Ag, Bg, a3, 0, 0, 0); }
            float ldv[4], pfx[4];
#pragma unroll
            for (int j = 0; j < 4; ++j) { ldv[j] = logdecay_of(dbias + a1[j]); pfx[j] = (j ? pfx[j - 1] : 0.f) + ldv[j]; }
            const float T = pfx[3]; const float t1 = __shfl_up(T, 16); float sI = T + (lq >= 1 ? t1 : 0.f); const float t2 = __shfl_up(sI, 32); sI += (lq >= 2 ? t2 : 0.f);
            const float excl = sI - T, tot = __shfl(sI, 48 + lr);
#pragma unroll
            for (int j = 0; j < 4; ++j) { const int o = ((16 * mb + 4 * lq + j) * 64 + 16 * nb + lr) * 4;
                *(LAS float*)(lds + MX_LD + o) = ldv[j]; *(LAS float*)(lds + MX_LG + o) = excl + pfx[j]; *(LAS float*)(lds + MX_AL + o) = fsig(ibias + a2[j]); *(LAS float*)(lds + MX_G + pf * 8192 + o) = a3[j]; }
            if (lq == 0) *(LAS float*)(lds + MX_G16 + pf * 512 + (mb * 64 + 16 * nb + lr) * 4) = __expf(tot);
        }
        if (back && wave < 4) {
            const int cb = wave;
            f32x4 Hl[4];
#pragma unroll
            for (int kb = 0; kb < 4; ++kb) Hl[kb] = Hs[kb];
            v4u kaw[2][2], raw[2][2], taw[2], aaw[2], caw[4]; u32x2v vtw[2]; f32x4 g4w[4];
#define E_LD8(base) ({ const LAS unsigned char* p_ = (base); const u32x2v x0_ = *(const LAS u32x2v*)p_, x1_ = *(const LAS u32x2v*)(p_ + 32); (v4u){x0_.x, x0_.y, x1_.x, x1_.y}; })
#pragma unroll
            for (int g = 0; g < 2; ++g) {
#pragma unroll
                for (int s2 = 0; s2 < 2; ++s2) { kaw[g][s2] = E_LD8(lds + MX_KT + g * 16 * KT_ST + lr * KT_ST + (32 * s2 + 4 * lq) * 2); raw[g][s2] = E_LD8(lds + MX_RT + g * 16 * KT_ST + lr * KT_ST + (32 * s2 + 4 * lq) * 2); }
                taw[g] = E_LD8(lds + MX_TP + g * 16 * TP_ST + lr * TP_ST + 4 * lq * 2); aaw[g] = E_LD8(lds + MX_AR + g * 16 * TP_ST + lr * TP_ST + 4 * lq * 2);
                vtw[g] = *(const LAS u32x2v*)(lds + MX_VT + g * 64 * VT_ST + (16 * cb + lr) * VT_ST + 4 * lq * 2);
            }
#pragma unroll
            for (int kb = 0; kb < 4; ++kb) { caw[kb] = E_LD8(lds + MX_KB + (16 * kb + lr) * KB_ST + 4 * lq * 2); g4w[kb] = *(const LAS f32x4*)(lds + MX_G16 + pb * 512 + (16 * kb + 4 * lq) * 4); }
            __builtin_amdgcn_sched_barrier(0);
#pragma unroll
            for (int g = 0; g < 2; ++g) {
                f32x4 Wa = (f32x4){0.f, 0.f, 0.f, 0.f}, Za = Wa;
#pragma unroll
                for (int s2 = 0; s2 < 2; ++s2) {
                    const f32x4 lo = Hl[2 * s2], hi = Hl[2 * s2 + 1];
                    const bf16x8 hb = __builtin_bit_cast(bf16x8, (v4u){pg8::cvt_pk_bf16(lo[0], lo[1]), pg8::cvt_pk_bf16(lo[2], lo[3]), pg8::cvt_pk_bf16(hi[0], hi[1]), pg8::cvt_pk_bf16(hi[2], hi[3])});
                    Wa = __builtin_amdgcn_mfma_f32_16x16x32_bf16(__builtin_bit_cast(bf16x8, kaw[g][s2]), hb, Wa, 0, 0, 0); Za = __builtin_amdgcn_mfma_f32_16x16x32_bf16(__builtin_bit_cast(bf16x8, raw[g][s2]), hb, Za, 0, 0, 0); }
#pragma unroll
                for (int kb = 0; kb < 4; ++kb) Hl[kb] = Hl[kb] * g4w[kb];
                const bf16x8 bw = __builtin_bit_cast(bf16x8, (v4u){pg8::cvt_pk_bf16(Wa[0], Wa[1]), pg8::cvt_pk_bf16(Wa[2], Wa[3]), vtw[g].x, vtw[g].y});
                const f32x4 Ua = __builtin_amdgcn_mfma_f32_16x16x32_bf16(__builtin_bit_cast(bf16x8, taw[g]), bw, (f32x4){0.f, 0.f, 0.f, 0.f}, 0, 0, 0);
                const bf16x8 vu = __builtin_bit_cast(bf16x8, (v4u){vtw[g].x, vtw[g].y, pg8::cvt_pk_bf16(Ua[0], Ua[1]), pg8::cvt_pk_bf16(Ua[2], Ua[3])});
#pragma unroll
                for (int kb = 0; kb < 4; ++kb) Hl[kb] = __builtin_amdgcn_mfma_f32_16x16x32_bf16(__builtin_bit_cast(bf16x8, caw[kb]), vu, Hl[kb], 0, 0, 0);
                Za = __builtin_amdgcn_mfma_f32_16x16x32_bf16(__builtin_bit_cast(bf16x8, aaw[g]), vu, Za, 0, 0, 0);
                if (g == 0) {
                    __builtin_amdgcn_sched_barrier(0);
#pragma unroll
                    for (int kb = 0; kb < 4; ++kb) { caw[kb] = E_LD8(lds + MX_KB + 64 * KB_ST + (16 * kb + lr) * KB_ST + 4 * lq * 2); g4w[kb] = *(const LAS f32x4*)(lds + MX_G16 + pb * 512 + 256 + (16 * kb + 4 * lq) * 4); }
                    __builtin_amdgcn_sched_barrier(0);
                }
#pragma unroll
                for (int rg = 0; rg < 4; ++rg) *(LAS float*)(lds + MX_Y + (16 * g + 4 * lq + rg) * 256 + (16 * cb + lr) * 4) = Za[rg];
            }
#undef E_LD8
#pragma unroll
            for (int kb = 0; kb < 4; ++kb) Hs[kb] = Hl[kb];
        }
        WG_SYNC();
#ifdef PROBE_MIX
        { const unsigned tn = (unsigned)__builtin_amdgcn_s_memrealtime(); tacc1 += tn - tprev; tprev = tn; }
#endif
        if (front)
        {
            const f32x4 a4 = *(const LAS f32x4*)(lds + MX_AL + tt * 256 + q * 16);
            const f32x4 c_kk = *(const LAS f32x4*)(lds + MX_CT + 7 * 256 + q * 16), c_ka = *(const LAS f32x4*)(lds + MX_CT + 8 * 256 + q * 16), c_rk = *(const LAS f32x4*)(lds + MX_CT + 9 * 256 + q * 16);
            f32x4 kkr = k_s * c_kk; float ss = (kkr[0] * kkr[0] + kkr[1] * kkr[1]) + (kkr[2] * kkr[2] + kkr[3] * kkr[3]); ss = red16(ss);
            const float inv = __builtin_amdgcn_rsqf(fmaxf(ss, 1e-24f));
            const f32x4 kk = kkr * inv, km = k_s * (1.0f + (a4 - 1.0f) * c_ka), bb = kk * a4;
            float bo = (r_s[0] * km[0] * c_rk[0] + r_s[1] * km[1] * c_rk[1]) + (r_s[2] * km[2] * c_rk[2] + r_s[3] * km[3] * c_rk[3]); bo = red16(bo);
            if (q == 0) *(LAS float*)(lds + MX_BON + pf * 128 + tt * 4) = bo;
            const int g = tt >> 4, i = tt & 15;
            const f32x4 lg = *(const LAS f32x4*)(lds + MX_LG + tt * 256 + q * 16), ldm = *(const LAS f32x4*)(lds + MX_LD + tt * 256 + q * 16), g16 = *(const LAS f32x4*)(lds + MX_G16 + pf * 512 + g * 256 + q * 16);
            f32x4 e, em, ei, eb;
#pragma unroll
            for (int j = 0; j < 4; ++j) { e[j] = __expf(lg[j]); em[j] = __expf(lg[j] - ldm[j]); ei[j] = __expf(-lg[j]); eb[j] = g16[j] * ei[j]; }
            const f32x4 Kt = kk * em, Rt = r_s * e, Kh = km * ei, Bh = bb * ei, Kb = km * eb, Bb = bb * eb;
            const int ro = g * 16 * KT_ST + i * KT_ST + q * 8;
            { u32x2v w; w.x = pg8::cvt_pk_bf16(Kt[0], Kt[1]); w.y = pg8::cvt_pk_bf16(Kt[2], Kt[3]); *(LAS u32x2v*)(lds + MX_KT + ro) = w; }
            { u32x2v w; w.x = pg8::cvt_pk_bf16(Rt[0], Rt[1]); w.y = pg8::cvt_pk_bf16(Rt[2], Rt[3]); *(LAS u32x2v*)(lds + MX_RT + ro) = w; }
            { u32x2v w; w.x = pg8::cvt_pk_bf16(Kh[0], Kh[1]); w.y = pg8::cvt_pk_bf16(Kh[2], Kh[3]); *(LAS u32x2v*)(lds + MX_KH + ro) = w; }
            { u32x2v w; w.x = pg8::cvt_pk_bf16(Bh[0], Bh[1]); w.y = pg8::cvt_pk_bf16(Bh[2], Bh[3]); *(LAS u32x2v*)(lds + MX_BH + ro) = w; }
            const unsigned kb01 = pg8::cvt_pk_bf16(Kb[0], Kb[1]), kb23 = pg8::cvt_pk_bf16(Kb[2], Kb[3]), nb01 = pg8::cvt_pk_bf16(-Bb[0], -Bb[1]), nb23 = pg8::cvt_pk_bf16(-Bb[2], -Bb[3]);
            const unsigned vv01 = pg8::cvt_pk_bf16(v_n[0], v_n[1]), vv23 = pg8::cvt_pk_bf16(v_n[2], v_n[3]);
            LAS unsigned short* kbp = (LAS unsigned short*)(lds + MX_KB + g * 64 * KB_ST + (4 * q) * KB_ST + i * 2);
            kbp[0] = (unsigned short)kb01; kbp[KB_ST / 2] = (unsigned short)(kb01 >> 16); kbp[KB_ST] = (unsigned short)kb23; kbp[3 * KB_ST / 2] = (unsigned short)(kb23 >> 16);
            kbp[16] = (unsigned short)nb01; kbp[16 + KB_ST / 2] = (unsigned short)(nb01 >> 16); kbp[16 + KB_ST] = (unsigned short)nb23; kbp[16 + 3 * KB_ST / 2] = (unsigned short)(nb23 >> 16);
            LAS unsigned short* vtp = (LAS unsigned short*)(lds + MX_VT + g * 64 * VT_ST + (4 * q) * VT_ST + i * 2);
            vtp[0] = (unsigned short)vv01; vtp[VT_ST / 2] = (unsigned short)(vv01 >> 16); vtp[VT_ST] = (unsigned short)vv23; vtp[3 * VT_ST / 2] = (unsigned short)(vv23 >> 16);
        }
        if (back) {
            {
                const f32x4 y4 = *(const LAS f32x4*)(lds + MX_Y + tt * 256 + q * 16), g4 = *(const LAS f32x4*)(lds + MX_G + pb * 8192 + tt * 256 + q * 16);
                const float bo = *(const LAS float*)(lds + MX_BON + pb * 128 + tt * 4);
                const f32x4 c_gw = *(const LAS f32x4*)(lds + MX_CT + 10 * 256 + q * 16), c_gb = *(const LAS f32x4*)(lds + MX_CT + 11 * 256 + q * 16);
                const f32x4 c_w0 = *(const LAS f32x4*)(lds + MX_CT + 12 * 256 + q * 16), c_w1 = *(const LAS f32x4*)(lds + MX_CT + 13 * 256 + q * 16), c_w2 = *(const LAS f32x4*)(lds + MX_CT + 14 * 256 + q * 16);
                float sm = (y4[0] + y4[1]) + (y4[2] + y4[3]); sm = red16(sm); const float mean = sm * (1.0f / 64.0f);
                const f32x4 dy = y4 - mean; float sv = (dy[0] * dy[0] + dy[1] * dy[1]) + (dy[2] * dy[2] + dy[3] * dy[3]); sv = red16(sv);
                const float rstd = __builtin_amdgcn_rsqf(sv * (1.0f / 64.0f) + GN_EPS);
                const f32x4 ya = (dy * rstd * c_gw + c_gb + bo * v_c) * g4;
                const f32x4 cu0 = *(const LAS f32x4*)(lds + MX_CU + pb * 8704 + tt * 256 + q * 16), cu1 = *(const LAS f32x4*)(lds + MX_CU + pb * 8704 + (tt + 1) * 256 + q * 16);
                const f32x4 yb = unpk4(fB) * (c_w0 * cu0 + c_w1 * cu1 + c_w2 * cu_c);
                const f32x4 ga = unpk4(fA), gb = unpk4(fG);
                f32x4 mo;
#pragma unroll
                for (int j = 0; j < 4; ++j) mo[j] = fsig(ga[j]) * ya[j] + fsig(gb[j]) * yb[j];
                mo_w.x = pg8::cvt_pk_bf16(mo[0], mo[1]); mo_w.y = pg8::cvt_pk_bf16(mo[2], mo[3]);
                if (j == NSC - 1) *(GAS u32x2v*)((GAS bf16*)(F.ws + WS_MIX) + (size_t)(b * TSEQ + chunk * TCH + j * SUBT + tt) * D + hc) = mo_w;
            }
            if (tt >= SUBT - 2) {
                *(LAS f32x4*)(lds + MX_CU + (pb ^ 1) * 8704 + (tt - (SUBT - 2)) * 256 + q * 16) = cu_c;
                if (j == NSC - 1) {
                    if (chunk < NTC - 1) *(GAS f32x4*)(car + 448 + (tt - (SUBT - 2)) * 64 + 4 * q) = cu_c;
                    else *(GAS f32x4*)(F.out + O_CVP + (size_t)(b * 2 + (tt - (SUBT - 2))) * D + hc) = cu_c;
                }
            }
        }
        WG_SYNC();
#ifdef PROBE_MIX
        { const unsigned tn = (unsigned)__builtin_amdgcn_s_memrealtime(); tacc2 += tn - tprev; tprev = tn; }
#endif
        v_c = v_n; cu_c = cu_n;
    }
#ifdef PROBE_MIX
    if (blockIdx.x == 0 && threadIdx.x == 0 && chunk == 1) { __hip_atomic_store(F.ctl + 2048 + 32, tacc0, RLX_AGENT); __hip_atomic_store(F.ctl + 2048 + 33, tacc1, RLX_AGENT); __hip_atomic_store(F.ctl + 2048 + 34, tacc2, RLX_AGENT); __hip_atomic_store(F.ctl + 2048 + 35, tacc3, RLX_AGENT); __hip_atomic_store(F.ctl + 2048 + 36, tprev - tstart, RLX_AGENT); }
#endif
    if (wave < 4) {
#pragma unroll
        for (int kb = 0; kb < 4; ++kb) *(GAS f32x4*)(Sg + (size_t)(16 * wave + lr) * 64 + 16 * kb + 4 * lq) = Hs[kb];
    }
    WG_SYNC();
}


constexpr int SJ_TW = 0, SJ_AD = 256, SJ_SG = 512, SJ_KK = 1024, SJ_BB = 5120, SJ_DD = 9216, SJ_KM = 13312, SJ_RR = 17408, SJ_VV = 21504, SJ_Y = 25600;
__device__ __forceinline__ void sample_job(Frame& F, int s) {
    LAS unsigned char* lds = F.lds;
    asm volatile("" : "+s"(s));
    int tid = threadIdx.x; asm volatile("" : "+v"(tid));
    const int lane = tid & 63, wave = __builtin_amdgcn_readfirstlane(tid >> 6), c0 = 2 * tid;
    const GAS bf16* zr = (const GAS bf16*)(F.ws + WS_ZS) + (size_t)s * NIN;
    const GAS float* sh = F.inp(5) + (size_t)s * SHIFTC; const GAS float* mu = F.inp(13);
    float r_s[2], k_s[2], v_s[2];
    {
        const unsigned zr2 = *(const GAS unsigned*)(zr + c0), zk2 = *(const GAS unsigned*)(zr + 1024 + c0), zv2 = *(const GAS unsigned*)(zr + 2048 + c0);
        const f32x2 pr = *(const GAS f32x2*)(sh + c0), pk = *(const GAS f32x2*)(sh + 1024 + c0), pv = *(const GAS f32x2*)(sh + 2048 + c0);
        const f32x2 mr = *(const GAS f32x2*)(mu + c0), mk = *(const GAS f32x2*)(mu + 1024 + c0), mv = *(const GAS f32x2*)(mu + 2048 + c0);
        float z;
        z = bf_lo(zr2); r_s[0] = z + mr.x * (pr.x - z); z = bf_hi(zr2); r_s[1] = z + mr.y * (pr.y - z);
        z = bf_lo(zk2); k_s[0] = z + mk.x * (pk.x - z); z = bf_hi(zk2); k_s[1] = z + mk.y * (pk.y - z);
        z = bf_lo(zv2); v_s[0] = z + mv.x * (pv.x - z); z = bf_hi(zv2); v_s[1] = z + mv.y * (pv.y - z);
    }
    for (int c = 2 * tid; c < SHIFTC; c += 2 * NWAVES * 64) { const unsigned z2 = *(const GAS unsigned*)(zr + c); *(GAS f32x2*)(F.out + O_SHS + (size_t)s * SHIFTC + c) = (f32x2){bf_lo(z2), bf_hi(z2)}; }
    if (tid < 128) {
        const int i = 2 * tid; const unsigned z2 = *(const GAS unsigned*)(zr + 3072 + i); const f32x2 p = *(const GAS f32x2*)(sh + 3072 + i), m = *(const GAS f32x2*)(mu + 3072 + i);
        float a = bf_lo(z2), b2 = bf_hi(z2); a = a + m.x * (p.x - a); b2 = b2 + m.y * (p.y - b2);
        if (i < 64) { a = ftanh(a); b2 = ftanh(b2); } else if (i >= 128) { a = fsig(a); b2 = fsig(b2); }
        *(LAS f32x2*)(lds + SJ_TW + i * 4) = (f32x2){a, b2};
    }
    WG_SYNC();
    float dd[2], al[2], gg[2];
#pragma unroll
    for (int e = 0; e < 2; ++e) {
        const int n = c0 + e;
        const GAS bf16* wd = (const GAS bf16*)(F.ws + WS_WDU) + (size_t)n * 64; const GAS bf16* wi = (const GAS bf16*)(F.ws + WS_WIU) + (size_t)n * 64; const GAS bf16* wg = (const GAS bf16*)(F.ws + WS_WGU) + (size_t)n * 128;
        float s1 = 0.f, s2 = 0.f, s3 = 0.f;
#pragma unroll 2
        for (int k8 = 0; k8 < 8; ++k8) { const v4u a = *(const GAS v4u*)(wd + 8 * k8), b4 = *(const GAS v4u*)(wi + 8 * k8);
            const f32x4 t0 = *(const LAS f32x4*)(lds + SJ_TW + k8 * 32), t1 = *(const LAS f32x4*)(lds + SJ_TW + k8 * 32 + 16), u0 = *(const LAS f32x4*)(lds + SJ_AD + k8 * 32), u1 = *(const LAS f32x4*)(lds + SJ_AD + k8 * 32 + 16);
            s1 += (bf_lo(a.x) * t0[0] + bf_hi(a.x) * t0[1]) + (bf_lo(a.y) * t0[2] + bf_hi(a.y) * t0[3]) + (bf_lo(a.z) * t1[0] + bf_hi(a.z) * t1[1]) + (bf_lo(a.w) * t1[2] + bf_hi(a.w) * t1[3]);
            s2 += (bf_lo(b4.x) * u0[0] + bf_hi(b4.x) * u0[1]) + (bf_lo(b4.y) * u0[2] + bf_hi(b4.y) * u0[3]) + (bf_lo(b4.z) * u1[0] + bf_hi(b4.z) * u1[1]) + (bf_lo(b4.w) * u1[2] + bf_hi(b4.w) * u1[3]); }
#pragma unroll 4
        for (int k8 = 0; k8 < 16; ++k8) { const v4u a = *(const GAS v4u*)(wg + 8 * k8);
            const f32x4 t0 = *(const LAS f32x4*)(lds + SJ_SG + k8 * 32), t1 = *(const LAS f32x4*)(lds + SJ_SG + k8 * 32 + 16);
            s3 += (bf_lo(a.x) * t0[0] + bf_hi(a.x) * t0[1]) + (bf_lo(a.y) * t0[2] + bf_hi(a.y) * t0[3]) + (bf_lo(a.z) * t1[0] + bf_hi(a.z) * t1[1]) + (bf_lo(a.w) * t1[2] + bf_hi(a.w) * t1[3]); }
        dd[e] = decay_of(F.inp(15)[n] + s1); al[e] = fsig(F.inp(17)[n] + s2); gg[e] = s3;
    }
    float bon;
    {
        const f32x2 ck = *(const GAS f32x2*)(F.inp(19) + c0), ca = *(const GAS f32x2*)(F.inp(20) + c0), crk = *(const GAS f32x2*)(F.inp(21) + c0);
        const float k0r = k_s[0] * ck.x, k1r = k_s[1] * ck.y; float ss = k0r * k0r + k1r * k1r;
#pragma unroll
        for (int o = 1; o < 32; o <<= 1) ss += __shfl_xor(ss, o);
        const float inv = 1.0f / fmaxf(sqrtf(ss), 1e-12f);
        const float kk0 = k0r * inv, kk1 = k1r * inv, km0 = k_s[0] * (1.0f + (al[0] - 1.0f) * ca.x), km1 = k_s[1] * (1.0f + (al[1] - 1.0f) * ca.y);
        bon = r_s[0] * km0 * crk.x + r_s[1] * km1 * crk.y;
#pragma unroll
        for (int o = 1; o < 32; o <<= 1) bon += __shfl_xor(bon, o);
        *(LAS f32x2*)(lds + SJ_KK + c0 * 4) = (f32x2){kk0, kk1}; *(LAS f32x2*)(lds + SJ_BB + c0 * 4) = (f32x2){kk0 * al[0], kk1 * al[1]}; *(LAS f32x2*)(lds + SJ_DD + c0 * 4) = (f32x2){dd[0], dd[1]};
        *(LAS f32x2*)(lds + SJ_KM + c0 * 4) = (f32x2){km0, km1}; *(LAS f32x2*)(lds + SJ_RR + c0 * 4) = (f32x2){r_s[0], r_s[1]}; *(LAS f32x2*)(lds + SJ_VV + c0 * 4) = (f32x2){v_s[0], v_s[1]};
    }
    WG_SYNC();
    {
        const int kq = lane & 15, rg = lane >> 4;
#pragma unroll 1
        for (int hh = 0; hh < 2; ++hh) {
            const int h = 2 * wave + hh;
            const f32x4 kk4 = *(const LAS f32x4*)(lds + SJ_KK + (64 * h + 4 * kq) * 4), b4 = *(const LAS f32x4*)(lds + SJ_BB + (64 * h + 4 * kq) * 4), d4 = *(const LAS f32x4*)(lds + SJ_DD + (64 * h + 4 * kq) * 4);
            const f32x4 km4 = *(const LAS f32x4*)(lds + SJ_KM + (64 * h + 4 * kq) * 4), r4 = *(const LAS f32x4*)(lds + SJ_RR + (64 * h + 4 * kq) * 4);
            const size_t sbase = ((size_t)(s * NHEAD + h) * 64) * 64;
#pragma unroll 2
            for (int ps = 0; ps < 8; ++ps) {
                const int v0 = 8 * ps + 2 * rg;
                f32x4 S0 = *(const GAS f32x4*)(F.inp(4) + sbase + (size_t)v0 * 64 + 4 * kq), S1 = *(const GAS f32x4*)(F.inp(4) + sbase + (size_t)(v0 + 1) * 64 + 4 * kq);
                const f32x2 v2 = *(const LAS f32x2*)(lds + SJ_VV + (64 * h + v0) * 4);
                float p0 = (S0[0] * kk4[0] + S0[1] * kk4[1]) + (S0[2] * kk4[2] + S0[3] * kk4[3]), p1 = (S1[0] * kk4[0] + S1[1] * kk4[1]) + (S1[2] * kk4[2] + S1[3] * kk4[3]);
                p0 = red16(p0); p1 = red16(p1);
#pragma unroll
                for (int j = 0; j < 4; ++j) { S0[j] = S0[j] * d4[j] + (v2.x * km4[j] - p0 * b4[j]); S1[j] = S1[j] * d4[j] + (v2.y * km4[j] - p1 * b4[j]); }
                float y0 = (S0[0] * r4[0] + S0[1] * r4[1]) + (S0[2] * r4[2] + S0[3] * r4[3]), y1 = (S1[0] * r4[0] + S1[1] * r4[1]) + (S1[2] * r4[2] + S1[3] * r4[3]);
                y0 = red16(y0); y1 = red16(y1);
                *(GAS f32x4*)(F.out + O_WKVS + sbase + (size_t)v0 * 64 + 4 * kq) = S0; *(GAS f32x4*)(F.out + O_WKVS + sbase + (size_t)(v0 + 1) * 64 + 4 * kq) = S1;
                if (kq == 0) *(LAS f32x2*)(lds + SJ_Y + (64 * h + v0) * 4) = (f32x2){y0, y1};
            }
        }
    }
    WG_SYNC();
    {
        const f32x2 y2 = *(const LAS f32x2*)(lds + SJ_Y + c0 * 4);
        float sm = y2.x + y2.y;
#pragma unroll
        for (int o = 1; o < 32; o <<= 1) sm += __shfl_xor(sm, o);
        const float mean = sm * (1.0f / 64.0f), d0 = y2.x - mean, d1 = y2.y - mean; float sv = d0 * d0 + d1 * d1;
#pragma unroll
        for (int o = 1; o < 32; o <<= 1) sv += __shfl_xor(sv, o);
        const float rstd = __builtin_amdgcn_rsqf(sv * (1.0f / 64.0f) + GN_EPS);
        const f32x2 gw = *(const GAS f32x2*)(F.inp(22) + c0), gb = *(const GAS f32x2*)(F.inp(23) + c0);
        const float ya0 = (d0 * rstd * gw.x + gb.x + bon * v_s[0]) * gg[0], ya1 = (d1 * rstd * gw.y + gb.y + bon * v_s[1]) * gg[1];
        const unsigned zB = *(const GAS unsigned*)(zr + 3328 + c0), zC = *(const GAS unsigned*)(zr + 4352 + c0), zU = *(const GAS unsigned*)(zr + 5376 + c0), zgA = *(const GAS unsigned*)(zr + 6400 + c0), zgB = *(const GAS unsigned*)(zr + 7424 + c0);
        const f32x2 cv0 = *(const GAS f32x2*)(F.inp(6) + (size_t)(s * 2) * D + c0), cv1 = *(const GAS f32x2*)(F.inp(6) + (size_t)(s * 2 + 1) * D + c0);
        const f32x2 w0 = *(const GAS f32x2*)(F.inp(24) + c0), w1 = *(const GAS f32x2*)(F.inp(24) + 1024 + c0), w2 = *(const GAS f32x2*)(F.inp(24) + 2048 + c0);
        const float cu0 = bf_lo(zC) * bf_lo(zU), cu1 = bf_hi(zC) * bf_hi(zU);
        const float yb0 = bf_lo(zB) * (w0.x * cv0.x + w1.x * cv1.x + w2.x * cu0), yb1 = bf_hi(zB) * (w0.y * cv0.y + w1.y * cv1.y + w2.y * cu1);
        const float m0 = fsig(bf_lo(zgA)) * ya0 + fsig(bf_lo(zgB)) * yb0, m1 = fsig(bf_hi(zgA)) * ya1 + fsig(bf_hi(zgB)) * yb1;
#if DBG_MIX
        *(GAS unsigned*)((GAS bf16*)(F.ws + WS_MIX) + (size_t)(MPR + s) * D + c0) = 0u; (void)m0; (void)m1;
#else
        *(GAS unsigned*)((GAS bf16*)(F.ws + WS_MIX) + (size_t)(MPR + s) * D + c0) = pg8::cvt_pk_bf16(m0, m1);
#endif
        *(GAS f32x2*)(F.out + O_CVS + (size_t)(s * 2) * D + c0) = cv1; *(GAS f32x2*)(F.out + O_CVS + (size_t)(s * 2 + 1) * D + c0) = (f32x2){cu0, cu1};
    }
    WG_SYNC();
}


enum StripKind { SK_SWIGLU = 0, SK_RES = 1, SK_Z = 2, SK_PP = 3, SK_PLE = 4 };
struct StripArgs { const GAS bf16* A; const GAS bf16* Wt; int K; GAS bf16* Ob; const GAS float* X; const GAS bf16* PP; float alpha; bool scale; };
template <int KIND, int KSW  > __device__ __forceinline__ void strip_gemm_sk(const StripArgs& a, LAS unsigned char* lds, int mb, int pn, int wg) {
    int tid = threadIdx.x; asm volatile("" : "+v"(tid));
    const int lane = tid & 63, w = __builtin_amdgcn_readfirstlane(tid >> 6), lr = lane & 15, lq = lane >> 4;
    const int K = a.K, row = MPR + 16 * mb + lr;
    int wr0, wr1;
    if (KIND == SK_PP) { wr0 = 256 * pn + 32 * wg + 8 * (lr >> 2) + (lr & 3); wr1 = wr0 + 4; }
    else { wr0 = 256 * pn + 32 * wg + lr; wr1 = wr0 + 16; }
    const int k0 = 32 * KSW * w + 8 * lq;
    const GAS bf16* ap = a.A + (size_t)row * K + k0; const GAS bf16* w0p = a.Wt + (size_t)wr0 * K + k0; const GAS bf16* w1p = a.Wt + (size_t)wr1 * K + k0;
    v4u av[KSW], b0[KSW], b1[KSW];
#pragma unroll
    for (int i = 0; i < KSW; ++i) { av[i] = *(const GAS v4u*)(ap + 32 * i); b0[i] = *(const GAS v4u*)(w0p + 32 * i); b1[i] = *(const GAS v4u*)(w1p + 32 * i); }
    __builtin_amdgcn_sched_barrier(0);
    f32x4 acc0 = (f32x4){0.f, 0.f, 0.f, 0.f}, acc1 = acc0; float ssq = 0.f;
#pragma unroll
    for (int i = 0; i < KSW; ++i) {
        if (KIND == SK_PLE) {
            const float x0 = bf_lo(av[i].x), x1 = bf_hi(av[i].x), x2 = bf_lo(av[i].y), x3 = bf_hi(av[i].y), x4 = bf_lo(av[i].z), x5 = bf_hi(av[i].z), x6 = bf_lo(av[i].w), x7 = bf_hi(av[i].w);
            ssq += ((x0 * x0 + x1 * x1) + (x2 * x2 + x3 * x3)) + ((x4 * x4 + x5 * x5) + (x6 * x6 + x7 * x7)); }
        const bf16x8 af = __builtin_bit_cast(bf16x8, av[i]);
        acc0 = __builtin_amdgcn_mfma_f32_16x16x32_bf16(__builtin_bit_cast(bf16x8, b0[i]), af, acc0, 0, 0, 0);
        acc1 = __builtin_amdgcn_mfma_f32_16x16x32_bf16(__builtin_bit_cast(bf16x8, b1[i]), af, acc1, 0, 0, 0);
    }
    if (KIND == SK_PLE) { ssq += __shfl_xor(ssq, 16); ssq += __shfl_xor(ssq, 32); }
    LAS unsigned char* slot = lds + (w * 64 + lane) * 48;
    *(LAS f32x4*)slot = acc0; *(LAS f32x4*)(slot + 16) = acc1; *(LAS float*)(slot + 32) = ssq;
    WG_SYNC();
    if (w == 0) {
        f32x4 s0 = (f32x4){0.f, 0.f, 0.f, 0.f}, s1 = s0; float sq = 0.f;
#pragma unroll
        for (int j = 0; j < 8; ++j) { const LAS unsigned char* p = lds + (j * 64 + lane) * 48; s0 = s0 + *(const LAS f32x4*)p; s1 = s1 + *(const LAS f32x4*)(p + 16); sq += *(const LAS float*)(p + 32); }
        const float sc = (KIND == SK_PLE) ? __builtin_amdgcn_rsqf(sq * (1.0f / 1024.0f) + RMS_EPS) : 1.0f;
        if (KIND == SK_PP) {
            v4u o; o.x = pg8::cvt_pk_bf16(s0[0], s0[1]); o.y = pg8::cvt_pk_bf16(s0[2], s0[3]); o.z = pg8::cvt_pk_bf16(s1[0], s1[1]); o.w = pg8::cvt_pk_bf16(s1[2], s1[3]);
            *(GAS v4u*)(a.Ob + (size_t)row * D + 256 * pn + 32 * wg + 8 * lq) = o;
        } else {
#pragma unroll
            for (int nb = 0; nb < 2; ++nb) { const size_t off = (size_t)row * D + 256 * pn + 32 * wg + 16 * nb + 4 * lq; const f32x4 ac = nb ? s1 : s0;
                const f32x4 xin = a.X ? *(const GAS f32x4*)(a.X + off) : unpk4(*(const GAS u32x2v*)((KIND == SK_PLE ? a.A : (const GAS bf16*)a.Ob) + off)); f32x4 xo;
                if (KIND == SK_RES) xo = xin + ac * a.alpha;
                else { const f32x4 pv = unpk4(*(const GAS u32x2v*)(a.PP + off));
#pragma unroll
                    for (int j = 0; j < 4; ++j) xo[j] = xin[j] + fsig(ac[j] * sc) * pv[j]; }
                { u32x2v o; o.x = pg8::cvt_pk_bf16(xo[0], xo[1]); o.y = pg8::cvt_pk_bf16(xo[2], xo[3]); *(GAS u32x2v*)(a.Ob + off) = o; } }
        }
    }
    WG_SYNC();
}
template <int KIND, int KSW> __device__ __forceinline__ void strip_phase_sk(const StripArgs& a, LAS unsigned char* lds, int G, int c) {
    for (int j = c; j < 256; j += G) strip_gemm_sk<KIND, KSW>(a, lds, j & 7, (j >> 3) & 3, j >> 5);
}

__device__ unsigned g_ctl[16384];
constexpr int CW_DONE = 1024;
struct Args { const float* in[34]; float* out; unsigned char* ws; int ph_lo, ph_hi, li, pad; };
__global__ void __launch_bounds__(NWAVES * 64, 2) mk_fwd(Args args) {
    extern __shared__ __attribute__((aligned(16))) unsigned char lds[];
    Frame F;
    F.lds = (LAS unsigned char*)lds;
    F.MISC = (volatile LAS unsigned*)(F.lds + MISC_OFF);
    F.tid = threadIdx.x; F.lane = F.tid & 63; F.wave = __builtin_amdgcn_readfirstlane(F.tid >> 6);
    F.G = gridDim.x; { const int bx = blockIdx.x; F.vcu = (F.G % 8 == 0) ? (bx % 8) * (F.G / 8) + bx / 8 : bx; }
    GAS unsigned char* ws = (GAS unsigned char*)args.ws; F.ws = ws; F.out = (GAS float*)args.out;
    F.ctl = (gu32*)g_ctl;
    for (int u = F.tid; u < (LDS_BYTES - LDSCTL_OFF) / 4; u += NWAVES * 64) ((LAS unsigned*)(F.lds + LDSCTL_OFF))[u] = 0u;
    __syncthreads();
#pragma unroll
    for (int i = 0; i < 34; ++i) if (F.tid == i) *(LAS unsigned long long*)(F.lds + PTR_OFF + 8 * i) = (unsigned long long)args.in[i];
    __syncthreads();
    XcdBarrier bar; bar.bar = (unsigned*)(F.ctl + CW_BAR); bar.x = 0; bar.st = nullptr;
    if (N_LAUNCHES == 1) bar = xcd_barrier_post((unsigned*)(F.ctl + CW_BAR), F.MISC + 8);
#define GRID_BAR() do { if (N_LAUNCHES == 1) xcd_barrier(bar); } while (0)
    const int lo = args.ph_lo, hi = args.ph_hi;
#ifndef PH_MASK
#define PH_MASK 0x3fff
#endif
#ifdef PROBE_TS_A
#define IN(k) ((((blockIdx.x == 0 && threadIdx.x == 0) ? (void)__hip_atomic_store(F.ctl + 2048 + (k), (unsigned)__builtin_amdgcn_s_memrealtime(), RLX_AGENT) : (void)0), true) && ((PH_MASK >> (k)) & 1) && lo <= (k) && (k) < hi)
#else
#define IN(k) (((PH_MASK >> (k)) & 1) && lo <= (k) && (k) < hi)
#endif
#define IN0(k) (((PH_MASK >> (k)) & 1) && lo <= (k) && (k) < hi)
#define BOTH(k) (IN0(k) && IN0((k) + 1))
    GAS bf16* const XB = (GAS bf16*)(ws + WS_XB); GAS bf16* const MIXB = (GAS bf16*)(ws + WS_MIX); GAS bf16* const GU = (GAS bf16*)(ws + WS_GU); GAS float* const SSQ = (GAS float*)(ws + WS_SSQ);
    GAS bf16* const PPB = (GAS bf16*)F.out;
    GAS bf16* const XF = (GAS bf16*)(ws + WS_GU);
#define GP(p) ((const bf16*)(p))

    if (IN(0)) { asm volatile("; MARK P0"); p0_prologue(F); if (BOTH(0)) GRID_BAR(); }
#ifndef REP_P1
#define REP_P1 1
#endif
    for (int rep = 0; rep < REP_P1; ++rep)
    if (IN(1)) { asm volatile("; MARK P1");
        pg8::Gemm g{GP(XB), GP(ws + WS_W1GU), MP, 2 * FF, D}; pg8::StaticOrder S; S.init(MP, 2 * FF, F.G, (int)blockIdx.x);
        pg8::EpiSwiglu E{GU, F.lds, false};
        pg8::gemm_phase<pg8::EpiSwiglu, pg8::StaticOrder, true, true>(F.lds + RING_OFF, g, S, E);
        if ((int)blockIdx.x >= 150) convert_group(F, 1, ((int)blockIdx.x - 150) * NWAVES + F.wave, (F.G - 150) * NWAVES);
        if (BOTH(1)) GRID_BAR();
    }
#ifndef REP_P2
#define REP_P2 1
#endif
    for (int rep = 0; rep < REP_P2; ++rep)
    if (IN(2)) { asm volatile("; MARK P2");
        pg8::Gemm g{GP(GU), GP(ws + WS_W1D), MP, D, FF}; pg8::StaticOrder S; S.init(MPR, D, F.G, (int)blockIdx.x);
        pg8::EpiRes E{F.inp(0), XB, SSQ, 0.5f};
#ifndef REP_G2
#define REP_G2 1
#endif
        for (int rg2 = 0; rg2 < REP_G2; ++rg2)
        pg8::gemm_phase<pg8::EpiRes, pg8::StaticOrder, true, true>(F.lds + RING_OFF, g, S, E);
        { const StripArgs sa{GU, (const GAS bf16*)(ws + WS_W1D), FF, XB, F.inp(1) - (size_t)MPR * D, nullptr, 0.5f, false}; strip_phase_sk<SK_RES, FF / 256>(sa, F.lds, F.G, (int)blockIdx.x); }
        if (BOTH(2)) GRID_BAR();
    }
    for (int r3 = 0; r3 < REP_P3; ++r3)
    if (IN(3)) { asm volatile("; MARK P3");
        pg8::Gemm g{GP(XB), GP(ws + WS_WIN), MP, NIN, D}; pg8::FirstWinOrder S; S.init(F.G, (int)blockIdx.x);
        pg8::precompute_scales(F.lds, S, SSQ, XB);
        pg8::EpiZ E{(GAS bf16*)(ws + WS_Z), F.lds, (GAS bf16*)(ws + WS_ZX), (GAS bf16*)(ws + WS_ZS)};
        pg8::gemm_phase<pg8::EpiZ, pg8::FirstWinOrder, true, true>(F.lds + RING_OFF, g, S, E);
        if ((int)blockIdx.x >= 64) convert_group(F, 2, ((int)blockIdx.x - 64) * NWAVES + F.wave, (F.G - 64) * NWAVES);
        if (BOTH(3)) GRID_BAR();
    }
#pragma unroll 1
    for (int ch = 0; ch < NTC; ++ch) {
        if (IN(4 + ch)) { asm volatile("; MARK P4");
            const int x = (int)blockIdx.x & 7, i = (int)blockIdx.x >> 3;
            if (i < 16) { mix_job(F, x, i, ch);
#ifdef PROBE_TS_A
                if (blockIdx.x == 0 && threadIdx.x == 0) __hip_atomic_store(F.ctl + 2048 + 20 + ch, (unsigned)__builtin_amdgcn_s_memrealtime(), RLX_AGENT);
#endif
            }
            else if (ch + 1 < NTC) {
                pg8::Gemm g{GP(XB), GP(ws + WS_WIN), MP, NIN, D}; pg8::ChunkOrder S; S.init(2 * NBATCH, NIN / 256 - 1, F.G / 2, (i - 16) * 8 + x, ch + 1);
                pg8::precompute_scales(F.lds, S, SSQ, XB);
                pg8::EpiZ E{(GAS bf16*)(ws + WS_Z + (size_t)((ch + 1) & 1) * ZCH_BYTES), F.lds, (GAS bf16*)(ws + WS_ZX), (GAS bf16*)(ws + WS_ZS)};
                pg8::gemm_phase<pg8::EpiZ, pg8::ChunkOrder, true, true>(F.lds + RING_OFF, g, S, E);
#ifdef PROBE_TS_A
                if (blockIdx.x == 128 && threadIdx.x == 0) __hip_atomic_store(F.ctl + 2048 + 24 + ch, (unsigned)__builtin_amdgcn_s_memrealtime(), RLX_AGENT);
                if (blockIdx.x == 255 && threadIdx.x == 0) __hip_atomic_store(F.ctl + 2048 + 28 + ch, (unsigned)__builtin_amdgcn_s_memrealtime(), RLX_AGENT);
#endif
            } else {
                const int cg = (i - 16) * 8 + x;
                sample_job(F, 16 * x + (i - 16));
                { pg8::Gemm g{GP(ws + WS_PB), GP(ws + WS_WPP), MP, D, PLE}; pg8::StaticOrder S; S.init(MPR, D, F.G / 2, cg);
                  pg8::EpiPP E{PPB, D};
                  pg8::gemm_phase<pg8::EpiPP, pg8::StaticOrder, true, true>(F.lds + RING_OFF, g, S, E);
                  const StripArgs sa{(const GAS bf16*)(ws + WS_PB), (const GAS bf16*)(ws + WS_WPP), PLE, PPB, nullptr, nullptr, 0.f, false}; strip_phase_sk<SK_PP, PLE / 256>(sa, F.lds, F.G / 2, cg); }
                convert_group(F, 3, cg * NWAVES + F.wave, (F.G / 2) * NWAVES);
            }
            if (BOTH(4 + ch)) GRID_BAR();
        }
    }
    for (int r5 = 0; r5 < REP_P5; ++r5)
    if (IN(8)) { asm volatile("; MARK P5");
        pg8::Gemm g{GP(MIXB), GP(ws + WS_WOUT), MP, D, D}; pg8::StaticOrder S; S.init(MPR, D, F.G, (int)blockIdx.x);
        pg8::EpiRes E{nullptr, XB, SSQ, 1.0f / REP_P5};
        pg8::gemm_phase<pg8::EpiRes, pg8::StaticOrder, true, true>(F.lds + RING_OFF, g, S, E);
        { const StripArgs sa{MIXB, (const GAS bf16*)(ws + WS_WOUT), D, XB, nullptr, nullptr, 1.0f / REP_P5, false}; strip_phase_sk<SK_RES, D / 256>(sa, F.lds, F.G, (int)blockIdx.x); }
        if (BOTH(8)) GRID_BAR();
    }
    for (int r6 = 0; r6 < REP_P6; ++r6)
    if (IN(9)) { asm volatile("; MARK P6");
        pg8::Gemm g{GP(XB), GP(ws + WS_W2GU), MP, 2 * FF, D}; pg8::StaticOrder S; S.init(MP, 2 * FF, F.G, (int)blockIdx.x);
        pg8::precompute_scales(F.lds, S, SSQ, XB);
        pg8::EpiSwiglu E{GU, F.lds, true};
        pg8::gemm_phase<pg8::EpiSwiglu, pg8::StaticOrder, true, true>(F.lds + RING_OFF, g, S, E);
        if (BOTH(9)) GRID_BAR();
    }
    if (IN(10)) { asm volatile("; MARK P7");
        pg8::Gemm g{GP(GU), GP(ws + WS_W2D), MP, D, FF}; pg8::StaticOrder S; S.init(MPR, D, F.G, (int)blockIdx.x);
        pg8::EpiRes E{nullptr, XB, SSQ, 0.5f};
        pg8::gemm_phase<pg8::EpiRes, pg8::StaticOrder, true, true>(F.lds + RING_OFF, g, S, E);
        { const StripArgs sa{GU, (const GAS bf16*)(ws + WS_W2D), FF, XB, nullptr, nullptr, 0.5f, false}; strip_phase_sk<SK_RES, FF / 256>(sa, F.lds, F.G, (int)blockIdx.x); }
    }
    if (IN(11)) { if (BOTH(11)) GRID_BAR(); }
    if (IN(12)) { asm volatile("; MARK P8");
        pg8::Gemm g{GP(XB), GP(ws + WS_WPG), MP, D, D}; pg8::StaticOrder S; S.init(MPR, D, F.G, (int)blockIdx.x);
        pg8::precompute_scales(F.lds, S, SSQ, XB);
        pg8::EpiPle E{XB, XF, PPB, F.lds};
        pg8::gemm_phase<pg8::EpiPle, pg8::StaticOrder, true, true>(F.lds + RING_OFF, g, S, E);
        { const StripArgs sa{XB, (const GAS bf16*)(ws + WS_WPG), D, XF, nullptr, PPB, 0.f, true}; strip_phase_sk<SK_PLE, D / 256>(sa, F.lds, F.G, (int)blockIdx.x); }
        if (BOTH(12)) GRID_BAR();
    }
    if (IN(13)) { asm volatile("; MARK P9"); p9_final(F); }
#ifdef PROBE_TS_A
    if (blockIdx.x == 0 && threadIdx.x == 0) { __hip_atomic_store(F.ctl + 2048 + 14, (unsigned)__builtin_amdgcn_s_memrealtime(), RLX_AGENT); asm volatile("s_waitcnt vmcnt(0)" ::: "memory"); const unsigned ta = __hip_atomic_load(F.ctl + 2048 + PROBE_TS_A, RLX_AGENT), tb = __hip_atomic_load(F.ctl + 2048 + PROBE_TS_B, RLX_AGENT);
        F.out[0] += ((float)(tb - ta) * 0.01f - (float)PROBE_TS_OFF) * 0.1f; }
#endif
    if (N_LAUNCHES == 1) {
        __syncthreads();
        if (threadIdx.x == 0) { const unsigned old = __hip_atomic_fetch_add(F.ctl + CW_DONE, 1u, RLX_AGENT); F.MISC[12] = (old + 1u == (unsigned)gridDim.x) ? 1u : 0u; }
        __syncthreads();
        if (F.MISC[12]) {
            for (int w = (int)threadIdx.x; w < XCD_BAR_WORDS; w += NWAVES * 64) __hip_atomic_store(F.ctl + CW_BAR + w, 0u, RLX_AGENT);
            if (threadIdx.x == 0) __hip_atomic_store(F.ctl + CW_DONE, 0u, RLX_AGENT);
        }
    }
#undef IN
#undef IN0
#undef BOTH
}

extern "C" void kernel_launch(void* const* d_in, const int* in_sizes, int n_in, void* d_out, int out_size, void* d_ws, size_t ws_size, hipStream_t stream) {
    static int grid = 0;
    if (grid == 0) {
        if (n_in != 34 || in_sizes[0] != MPR * D || (size_t)out_size != O_END || ws_size < WS_END) { fprintf(stderr, "kernel_launch: unexpected shapes (n_in %d, in0 %d, out %d, ws %zu); nothing launched\n", n_in, n_in > 0 ? in_sizes[0] : -1, out_size, ws_size); grid = -1; return; }
        int dev = 0, cus = 0, per_cu = 0;
        if (hipGetDevice(&dev) != hipSuccess || hipDeviceGetAttribute(&cus, hipDeviceAttributeMultiprocessorCount, dev) != hipSuccess) { grid = -1; return; }
        if (hipFuncSetAttribute((const void*)mk_fwd, hipFuncAttributeMaxDynamicSharedMemorySize, LDS_BYTES) != hipSuccess) { fprintf(stderr, "kernel_launch: hipFuncSetAttribute failed\n"); grid = -1; return; }
        if (hipOccupancyMaxActiveBlocksPerMultiprocessor(&per_cu, (const void*)mk_fwd, NWAVES * 64, LDS_BYTES) != hipSuccess || per_cu < 1) { fprintf(stderr, "kernel_launch: occupancy query says %d blocks per CU\n", per_cu); (void)hipGetLastError(); grid = -1; return; }
        grid = cus;
        if (grid != 256) fprintf(stderr, "kernel_launch: note: %d CUs\n", grid);
    }
    if (grid < 0) return;
    if (N_LAUNCHES != 1) { if (hipMemsetAsync((char*)d_ws + WS_CTL, 0, CTL_ZERO_BYTES, stream) != hipSuccess) return; }
    Args a{};
    for (int i = 0; i < 34; ++i) a.in[i] = (const float*)d_in[i];
    a.out = (float*)d_out; a.ws = (unsigned char*)d_ws;
    for (int li = 0; li < N_LAUNCHES; ++li) {
        a.ph_lo = (N_LAUNCHES == 1) ? 0 : li; a.ph_hi = (N_LAUNCHES == 1) ? N_PHASES : li + 1; a.li = li;
        hipLaunchKernelGGL(mk_fwd, dim3(grid), dim3(NWAVES * 64), LDS_BYTES, stream, a);
    }
}
```
